# Optimizing an MI355X kernel written in HIP

```python
import jax, jax.numpy as jnp
from jax import lax
import numpy as np

D_MODEL = 1024
BATCH = 8
SEQ = 4096
DEPTH = 2

GDN_HEADS = D_MODEL // 256
GDN_DK = 128
GDN_DV = 128
GDN_CONV = 4
GDN_CHUNK = 64
MOBA_HEADS = D_MODEL // 128
MOBA_DH = 64
MOBA_BLOCK = 256
MOBA_TOPK = 3
MOBA_QCHUNK = 32
ROPE_DIMS = MOBA_DH // 4
ROPE_THETA = 500000.0
GDN_QK_W = GDN_HEADS * GDN_DK
GDN_V_W = GDN_HEADS * GDN_DV
MOBA_W = MOBA_HEADS * MOBA_DH
D_MIX = GDN_V_W + MOBA_W
IN_SPLITS = (GDN_QK_W, GDN_QK_W, GDN_V_W, GDN_HEADS, GDN_HEADS, GDN_V_W, MOBA_W, MOBA_W, MOBA_W)
N_IN = sum(IN_SPLITS)
D_FF = 256 * ((8 * D_MODEL // 3 + 255) // 256)
FFN_CONV = 3
DEEPNORM_ALPHA = (2 * DEPTH) ** 0.25
DEEPNORM_BETA = (8 * DEPTH) ** -0.25
LN_EPS = 1e-5
NORM_EPS = 1e-6

kernel_name = 'hybrid_gdn_moba_deepnorm_convffn'


def layer_norm(x, g, b):
    xf = x.astype(jnp.float32)
    mu = xf.mean(-1, keepdims=True)
    var = jnp.square(xf - mu).mean(-1, keepdims=True)
    return ((xf - mu) * lax.rsqrt(var + LN_EPS) * g + b).astype(x.dtype)


def causal_dwconv(x, w):
    k_w = w.shape[0]
    s = x.shape[1]
    xp = jnp.pad(x, ((0, 0), (k_w - 1, 0), (0, 0)))
    return sum(xp[:, j:j + s, :] * w[j] for j in range(k_w))


def l2norm(x):
    return x * lax.rsqrt(jnp.sum(x * x, -1, keepdims=True) + NORM_EPS)


def split_heads(t, n_heads):
    b, s, _ = t.shape
    return t.reshape(b, s, n_heads, -1).transpose(0, 2, 1, 3)


def partial_rotary(x, pos):
    half = ROPE_DIMS // 2
    inv = ROPE_THETA ** (-jnp.arange(half, dtype=jnp.float32) / half)
    ang = pos.astype(jnp.float32)[:, None] * inv[None, :]
    cos = jnp.cos(ang).astype(x.dtype)
    sin = jnp.sin(ang).astype(x.dtype)
    x1, x2, rest = x[..., :half], x[..., half:ROPE_DIMS], x[..., ROPE_DIMS:]
    return jnp.concatenate([x1 * cos - x2 * sin, x2 * cos + x1 * sin, rest], -1)


def gated_delta_rule(q, k, v, g, beta):
    b_, h, s, dk = q.shape
    dv = v.shape[-1]
    c = GDN_CHUNK
    n = s // c
    q = q * dk ** -0.5
    resh = lambda t: t.reshape(b_, h, n, c, *t.shape[3:])
    q, k, v, g, beta = map(resh, (q, k, v, g, beta))
    g = jnp.cumsum(g, axis=-1)
    idx = jnp.arange(c)
    lower_incl = idx[:, None] >= idx[None, :]
    decay = jnp.exp(jnp.where(lower_incl, g[..., :, None] - g[..., None, :], -jnp.inf))
    k_beta = k * beta[..., None]
    a_strict = jnp.where(idx[:, None] > idx[None, :],
                         jnp.einsum('bhncd,bhnmd->bhncm', k_beta, k) * decay, 0.0)
    t_mat = a_strict + jnp.eye(c, dtype=q.dtype)
    rhs = jnp.concatenate([v * beta[..., None], k_beta * jnp.exp(g)[..., None]], -1)
    sol = lax.linalg.triangular_solve(t_mat, rhs, left_side=True, lower=True, unit_diagonal=True)
    u, w = sol[..., :dv], sol[..., dv:]
    attn_intra = jnp.einsum('bhncd,bhnmd->bhncm', q, k) * decay
    q_dec = q * jnp.exp(g)[..., None]
    g_last = g[..., -1]
    k_dec = k * jnp.exp(g_last[..., None] - g)[..., None]

    def step(state, xs):
        q_c, k_c, u_c, w_c, a_c, gl = xs
        v_new = u_c - jnp.einsum('bhcd,bhde->bhce', w_c, state)
        o = jnp.einsum('bhcd,bhde->bhce', q_c, state) + jnp.einsum('bhcm,bhme->bhce', a_c, v_new)
        state = state * jnp.exp(gl)[..., None, None] + jnp.einsum('bhcd,bhce->bhde', k_c, v_new)
        return state, o

    xs = tuple(jnp.moveaxis(t, 2, 0) for t in (q_dec, k_dec, u, w, attn_intra, g_last))
    s0 = jnp.zeros((b_, h, dk, dv), q.dtype)
    _, o = lax.scan(step, s0, xs)
    return jnp.moveaxis(o, 0, 2).reshape(b_, h, s, dv)


def gdn_mixer(q, k, v, a_logit, b_logit, z, conv_w, a_log, dt_bias, norm_g):
    b_, s, _ = q.shape
    qkv = jax.nn.silu(causal_dwconv(jnp.concatenate([q, k, v], -1), conv_w))
    q, k, v = jnp.split(qkv, [GDN_QK_W, 2 * GDN_QK_W], -1)
    f32 = jnp.float32
    qh = l2norm(split_heads(q, GDN_HEADS).astype(f32))
    kh = l2norm(split_heads(k, GDN_HEADS).astype(f32))
    vh = split_heads(v, GDN_HEADS).astype(f32)
    beta = jax.nn.sigmoid(b_logit.astype(f32)).transpose(0, 2, 1)
    g = (-jnp.exp(a_log.astype(f32)) * jax.nn.softplus(a_logit.astype(f32) + dt_bias.astype(f32))).transpose(0, 2, 1)
    o = gated_delta_rule(qh, kh, vh, g, beta).transpose(0, 2, 1, 3)
    o = o * lax.rsqrt(jnp.mean(o * o, -1, keepdims=True) + NORM_EPS) * norm_g.astype(f32)
    o = o * jax.nn.silu(z.reshape(b_, s, GDN_HEADS, GDN_DV).astype(f32))
    return o.reshape(b_, s, GDN_V_W).astype(q.dtype)


def moba_mixer(q, k, v, pos):
    b_, s, _ = q.shape
    h, dh, blk, qc_len = MOBA_HEADS, MOBA_DH, MOBA_BLOCK, MOBA_QCHUNK
    qh = partial_rotary(split_heads(q, h), pos)
    kh = partial_rotary(split_heads(k, h), pos)
    vh = split_heads(v, h)
    nb = -(-s // blk)
    pad = nb * blk - s
    n_sel = min(MOBA_TOPK, nb)
    kb = jnp.pad(kh, ((0, 0), (0, 0), (0, pad), (0, 0))).reshape(b_, h, nb, blk, dh)
    vb = jnp.pad(vh, ((0, 0), (0, 0), (0, pad), (0, 0))).reshape(b_, h, nb, blk, dh)
    k_mean = kb.mean(axis=3)
    nq = s // qc_len
    q_chunks = jnp.moveaxis(qh.reshape(b_, h, nq, qc_len, dh), 2, 0)
    scale = dh ** -0.5
    bi = jnp.arange(b_)[:, None, None, None]
    hi = jnp.arange(h)[None, :, None, None]
    blk_ids = jnp.arange(nb)
    sel_rank = jnp.arange(n_sel)

    def attend(args):
        q_c, ci = args
        t = ci * qc_len + jnp.arange(qc_len)
        own = (ci * qc_len) // blk
        gate = jnp.einsum('bhqd,bhnd->bhqn', q_c, k_mean).astype(jnp.float32)
        gate = jnp.where(blk_ids < own, gate, -jnp.inf)
        _, sel = lax.top_k(gate, n_sel)
        sel_valid = sel_rank < own
        k_sel = kb[bi, hi, sel]
        v_sel = vb[bi, hi, sel]
        s_sel = jnp.einsum('bhqd,bhqjkd->bhqjk', q_c, k_sel).astype(jnp.float32) * scale
        s_sel = jnp.where(sel_valid[:, None], s_sel, -jnp.inf).reshape(b_, h, qc_len, n_sel * blk)
        k_own = lax.dynamic_index_in_dim(kb, own, axis=2, keepdims=False)
        v_own = lax.dynamic_index_in_dim(vb, own, axis=2, keepdims=False)
        s_own = jnp.einsum('bhqd,bhkd->bhqk', q_c, k_own).astype(jnp.float32) * scale
        key_pos = own * blk + jnp.arange(blk)
        s_own = jnp.where(key_pos[None, :] <= t[:, None], s_own, -jnp.inf)
        p = jax.nn.softmax(jnp.concatenate([s_own, s_sel], -1), axis=-1).astype(v_sel.dtype)
        p_own = p[..., :blk]
        p_sel = p[..., blk:].reshape(b_, h, qc_len, n_sel, blk)
        return (jnp.einsum('bhqk,bhkd->bhqd', p_own, v_own)
                + jnp.einsum('bhqjk,bhqjkd->bhqd', p_sel, v_sel))

    o = lax.map(attend, (q_chunks, jnp.arange(nq)))
    o = jnp.moveaxis(o, 0, 2).reshape(b_, h, s, dh)
    return o.transpose(0, 2, 1, 3).reshape(b_, s, MOBA_W)


def hybrid_layer(x, w_in, gdn_conv_w, gdn_a_log, gdn_dt_bias, gdn_norm_g, w_out,
                 ln1_g, ln1_b, w_up, ffn_conv_w, ffn_conv_b, w_down, ln2_g, ln2_b, pos):
    proj = x @ w_in
    offs = np.cumsum(IN_SPLITS)[:-1].tolist()
    q_a, k_a, v_a, a_logit, b_logit, z, q_b, k_b, v_b = jnp.split(proj, offs, -1)
    o_a = gdn_mixer(q_a, k_a, v_a, a_logit, b_logit, z, gdn_conv_w, gdn_a_log, gdn_dt_bias, gdn_norm_g)
    o_b = moba_mixer(q_b, k_b, v_b, pos)
    mix = jnp.concatenate([o_a, o_b], -1) @ w_out
    x = layer_norm(DEEPNORM_ALPHA * x + mix, ln1_g, ln1_b)
    hid = causal_dwconv(x @ w_up, ffn_conv_w) + ffn_conv_b
    gate, val = jnp.split(hid, 2, -1)
    ffn = (jax.nn.silu(gate) * val) @ w_down
    return layer_norm(DEEPNORM_ALPHA * x + ffn, ln2_g, ln2_b)


def setup_inputs(seed: int = 0) -> dict:
    key = jax.random.key(seed)
    ks = jax.random.split(key, 16)
    f = jnp.float32
    nrm = lambda k, shape, scale: jax.random.normal(k, shape, f) * scale
    x = jax.random.normal(ks[0], (BATCH, SEQ, D_MODEL), f)
    w_in = nrm(ks[1], (DEPTH, D_MODEL, N_IN), D_MODEL ** -0.5)
    gdn_conv_w = nrm(ks[2], (DEPTH, GDN_CONV, 2 * GDN_QK_W + GDN_V_W), GDN_CONV ** -0.5)
    gdn_a_log = jnp.log(jax.random.uniform(ks[3], (DEPTH, GDN_HEADS), f, 1.0, 16.0))
    dt = jnp.exp(jax.random.uniform(ks[4], (DEPTH, GDN_HEADS), f, float(np.log(1e-3)), float(np.log(1e-1))))
    gdn_dt_bias = dt + jnp.log(-jnp.expm1(-dt))
    gdn_norm_g = 1.0 + nrm(ks[5], (DEPTH, GDN_DV), 0.02)
    w_out = nrm(ks[6], (DEPTH, D_MIX, D_MODEL), DEEPNORM_BETA * D_MIX ** -0.5)
    ln1_g = 1.0 + nrm(ks[7], (DEPTH, D_MODEL), 0.02)
    ln1_b = nrm(ks[8], (DEPTH, D_MODEL), 0.02)
    w_up = nrm(ks[9], (DEPTH, D_MODEL, 2 * D_FF), D_MODEL ** -0.5)
    ffn_conv_w = nrm(ks[10], (DEPTH, FFN_CONV, 2 * D_FF), FFN_CONV ** -0.5)
    ffn_conv_b = nrm(ks[11], (DEPTH, 2 * D_FF), 0.01)
    w_down = nrm(ks[12], (DEPTH, D_FF, D_MODEL), DEEPNORM_BETA * D_FF ** -0.5)
    ln2_g = 1.0 + nrm(ks[13], (DEPTH, D_MODEL), 0.02)
    ln2_b = nrm(ks[14], (DEPTH, D_MODEL), 0.02)
    return {'x': x, 'w_in': w_in, 'gdn_conv_w': gdn_conv_w, 'gdn_a_log': gdn_a_log,
            'gdn_dt_bias': gdn_dt_bias, 'gdn_norm_g': gdn_norm_g, 'w_out': w_out,
            'ln1_g': ln1_g, 'ln1_b': ln1_b, 'w_up': w_up, 'ffn_conv_w': ffn_conv_w,
            'ffn_conv_b': ffn_conv_b, 'w_down': w_down, 'ln2_g': ln2_g, 'ln2_b': ln2_b}


def reference(x, w_in, gdn_conv_w, gdn_a_log, gdn_dt_bias, gdn_norm_g, w_out,
              ln1_g, ln1_b, w_up, ffn_conv_w, ffn_conv_b, w_down, ln2_g, ln2_b):
    pos = jnp.arange(x.shape[1], dtype=jnp.int32)
    for l in range(DEPTH):
        x = hybrid_layer(x, w_in[l], gdn_conv_w[l], gdn_a_log[l], gdn_dt_bias[l], gdn_norm_g[l],
                         w_out[l], ln1_g[l], ln1_b[l], w_up[l], ffn_conv_w[l], ffn_conv_b[l],
                         w_down[l], ln2_g[l], ln2_b[l], pos)
    return x
```

```cpp
#include <hip/hip_runtime.h>
#include <hip/hip_cooperative_groups.h>
#include <hip/hip_bf16.h>
#include <cstdio>
#include <cstdint>
#include <cmath>
namespace cg = cooperative_groups;
__device__ __forceinline__ int opaque_tid() { int t = threadIdx.x; asm volatile("" : "+v"(t)); return t; }
namespace pg8 {
#define PG8_LAS __attribute__((address_space(3)))
typedef unsigned short bf16_t;
typedef short bf16x8 __attribute__((ext_vector_type(8)));
typedef float f32x4 __attribute__((ext_vector_type(4)));
typedef unsigned u32x4 __attribute__((ext_vector_type(4)));
constexpr int BM = 256, BK = 64, HALF = 128, HTB = HALF * BK * 2  , STAGE_BYTES = 8 * HTB, NXCD = 8, WGM = 8;

__host__ __device__ __forceinline__ int lds_byte(int r, int c) { const int st = (r >> 4) * 2 + (c >> 5), rr = r & 15, cc = c & 31, ob = rr * 64 + cc * 2; return st * 1024 + (ob ^ (((ob >> 9) & 1) << 5)); }
__host__ __device__ __forceinline__ void stage_rc(int b, int& R, int& C) { const int st = b / 1024, sb = b % 1024, swz = sb ^ (((sb >> 9) & 1) << 5); R = (st >> 1) * 16 + swz / 64; C = (st & 1) * 32 + (swz % 64) / 2; }
__host__ __device__ __forceinline__ int perm32(int rho) { const int n = rho >> 4, i = rho & 15; return 8 * (i >> 2) + 4 * n + (i & 3); }

struct Unit { int pm, pn; };
struct Gemm { const bf16_t* A; const bf16_t* Bt; int M, N, K; };

struct StaticOrder {
    int nM, nN, nwg, G, c;
    __host__ __device__ void init(int M, int N, int G_, int c_) { nM = M / BM; nN = N / BM; nwg = nM * nN; G = G_; c = c_; }
    __host__ __device__ bool next(int i, Unit& u) const {
        const long L = (long)i * G + c; if (L >= nwg) return false;
        int wgid = (int)L; { const int q = nwg / NXCD, r = nwg % NXCD, xcd = wgid % NXCD, off = wgid / NXCD; wgid = (xcd < r ? xcd * (q + 1) : r * (q + 1) + (xcd - r) * q) + off; }
        const int nig = WGM * nN, gid = wgid / nig, fm = gid * WGM, gsz = (nM - fm) < WGM ? (nM - fm) : WGM;
        u.pm = fm + ((wgid % nig) % gsz); u.pn = (wgid % nig) / gsz; return true;
    }
    __device__ __forceinline__ void a_ready(const Unit&) const {}
    __device__ __forceinline__ void done(const Unit&) const {}
};

__device__ __forceinline__ unsigned cvt_pk_bf16(float lo, float hi) { unsigned r; asm volatile("v_cvt_pk_bf16_f32 %0, %1, %2" : "=v"(r) : "v"(lo), "v"(hi)); return r; }
typedef float f32x2 __attribute__((ext_vector_type(2)));
typedef unsigned u32x2 __attribute__((ext_vector_type(2)));
struct EpiBf16 {
    static constexpr bool PERM = true, AFTER_DRAIN = false;
    bf16_t* O; int ldc;
    __device__ __forceinline__ void operator()(const f32x4 (&acc)[2][2][4][2], const Unit& u, int wr, int wc, int fr, int fq) const {
        const int row0 = u.pm * BM + wr * 64 + fr; const int col0 = u.pn * BM + wc * 32 + 8 * fq;
#pragma unroll
        for (int ai = 0; ai < 2; ++ai)
#pragma unroll
            for (int m = 0; m < 4; ++m) { bf16_t* rowp = O + (size_t)(row0 + ai * HALF + m * 16) * ldc + col0;
#pragma unroll
                for (int bj = 0; bj < 2; ++bj) { const f32x4 v0 = acc[ai][bj][m][0], v1 = acc[ai][bj][m][1];
                    u32x4 w; w.x = cvt_pk_bf16(v0[0], v0[1]); w.y = cvt_pk_bf16(v0[2], v0[3]); w.z = cvt_pk_bf16(v1[0], v1[1]); w.w = cvt_pk_bf16(v1[2], v1[3]);
                    *(u32x4*)(rowp + bj * HALF) = w; } }
    }
};
struct EpiResF32 {
    static constexpr bool PERM = false, AFTER_DRAIN = false;
    const float* res; float* out; int ldc; float alpha;
    __device__ __forceinline__ void operator()(const f32x4 (&acc)[2][2][4][2], const Unit& u, int wr, int wc, int fr, int fq) const {
        const int row0 = u.pm * BM + wr * 64 + fr; const int col0 = u.pn * BM + wc * 32 + 4 * fq;
#pragma unroll
        for (int ai = 0; ai < 2; ++ai)
#pragma unroll
            for (int m = 0; m < 4; ++m) { const size_t off = (size_t)(row0 + ai * HALF + m * 16) * ldc + col0;
                f32x4 rv[2][2];
#pragma unroll
                for (int bj = 0; bj < 2; ++bj)
#pragma unroll
                    for (int n = 0; n < 2; ++n) rv[bj][n] = *(const f32x4*)(res + off + bj * HALF + n * 16);
#pragma unroll
                for (int bj = 0; bj < 2; ++bj)
#pragma unroll
                    for (int n = 0; n < 2; ++n) *(f32x4*)(out + off + bj * HALF + n * 16) = rv[bj][n] * alpha + acc[ai][bj][m][n]; }
    }
};
__device__ __forceinline__ float dpp_ror1(float v) { return __builtin_bit_cast(float, __builtin_amdgcn_update_dpp(0, __builtin_bit_cast(int, v), 0x121, 0xf, 0xf, false)); }
__device__ __forceinline__ float dpp_ror2(float v) { return __builtin_bit_cast(float, __builtin_amdgcn_update_dpp(0, __builtin_bit_cast(int, v), 0x122, 0xf, 0xf, false)); }
__device__ __forceinline__ float silu_f(float x) { return x * __builtin_amdgcn_rcpf(1.0f + __expf(-x)); }
struct EpiUpConv {
    static constexpr bool PERM = true, AFTER_DRAIN = false;
    bf16_t* act; float* edge; const float* cw; const float* cb;
    __device__ __forceinline__ void operator()(const f32x4 (&acc)[2][2][4][2], const Unit& u, int wr, int wc, int fr, int fq) const {
        const int ch0 = u.pn * 128 + wc * 32 + 8 * fq;
#pragma unroll
        for (int n = 0; n < 2; ++n) {
            const int ch = ch0 + 4 * n;
            f32x4 w0[2], w1[2], w2[2], bb[2];
#pragma unroll
            for (int bj = 0; bj < 2; ++bj) { const int col = bj * 2816 + ch; w0[bj] = *(const f32x4*)(cw + col); w1[bj] = *(const f32x4*)(cw + 5632 + col); w2[bj] = *(const f32x4*)(cw + 2 * 5632 + col); bb[bj] = *(const f32x4*)(cb + col); }
#pragma unroll
            for (int ai = 0; ai < 2; ++ai) {
                const int slab = u.pm * 4 + ai * 2 + wr;
#pragma unroll
                for (int m = 0; m < 4; ++m) {
                    f32x4 hv[2];
#pragma unroll
                    for (int bj = 0; bj < 2; ++bj) {
                        const f32x4 cur = acc[ai][bj][m][n]; const f32x4 prv = acc[ai][bj][m > 0 ? m - 1 : 0][n];
                        f32x4 p1, p2;
#pragma unroll
                        for (int e = 0; e < 4; ++e) { const float s1 = (fr == 15) ? prv[e] : cur[e]; const float s2 = (fr >= 14) ? prv[e] : cur[e]; p1[e] = dpp_ror1(s1); p2[e] = dpp_ror2(s2); }
                        hv[bj] = w2[bj] * cur + w1[bj] * p1 + w0[bj] * p2 + bb[bj];
                        if (m == 0 && fr < 2) *(f32x4*)(edge + ((size_t)slab * 4 + fr) * 5632 + bj * 2816 + ch) = cur;
                        if (m == 3 && fr >= 14) *(f32x4*)(edge + ((size_t)slab * 4 + 2 + (fr - 14)) * 5632 + bj * 2816 + ch) = cur;
                    }
                    if (!(m == 0 && fr < 2)) {
                        const size_t row = (size_t)u.pm * BM + ai * HALF + wr * 64 + m * 16 + fr;
                        u32x2 o; o.x = cvt_pk_bf16(silu_f(hv[0][0]) * hv[1][0], silu_f(hv[0][1]) * hv[1][1]); o.y = cvt_pk_bf16(silu_f(hv[0][2]) * hv[1][2], silu_f(hv[0][3]) * hv[1][3]);
                        *(u32x2*)(act + row * 2816 + ch) = o;
                    }
                }
            }
        }
    }
};
template <class Epi, class Sched, bool ALIGN_EPI = false, bool SP2 = false>
__device__ __forceinline__ void gemm_phase(PG8_LAS unsigned char* lds, const Gemm g, const Sched& S, const Epi& E) {
    const int tid = opaque_tid(), wid = __builtin_amdgcn_readfirstlane(tid >> 6), lane = tid & 63, wr = wid >> 2, wc = wid & 3, fr = lane & 15, fq = lane >> 4;
    const int K = g.K, nt = K / BK;
    unsigned voffA[2], voffB[2];
#pragma unroll
    for (int i = 0; i < 2; ++i) { int R, C; stage_rc(tid * 16 + i * 8192, R, C); const int Rb = Epi::PERM ? ((R & ~31) + perm32(R & 31)) : R;
        voffA[i] = (unsigned)(R * K + C) * 2u; voffB[i] = (unsigned)(Rb * K + C) * 2u; }
    const size_t kstep = (size_t)(BK * 2);
    const size_t hstep = (size_t)HALF * K * 2;
    const size_t tstep = 2 * hstep;
    const unsigned ldsw = (unsigned)wid * 1024u;
    const int aoff = lds_byte(wr * 64 + fr, fq * 8), boff = lds_byte(wc * 32 + fr, fq * 8);
#define PG8_SA(b, h) (((b) * 2 + (h)) * HTB)
#define PG8_SB(b, h) ((4 + (b) * 2 + (h)) * HTB)
#define PG8_STAGE(bufoff, gbase, voff) do { _Pragma("unroll") for (int _i = 0; _i < 2; ++_i) \
        __builtin_amdgcn_global_load_lds((const unsigned*)((const char*)(gbase) + (voff)[_i]), (PG8_LAS unsigned*)(lds + (bufoff) + ldsw + _i * 8192), 16, 0, 0); } while (0)
#define PG8_LDA(dst, b, h) do { _Pragma("unroll") for (int m = 0; m < 4; ++m) _Pragma("unroll") for (int k = 0; k < 2; ++k) dst[m][k] = *(const PG8_LAS bf16x8*)(lds + PG8_SA(b, h) + aoff + m * 2048 + k * 1024); } while (0)
#define PG8_LDB(dst, b, h) do { _Pragma("unroll") for (int n = 0; n < 2; ++n) _Pragma("unroll") for (int k = 0; k < 2; ++k) dst[n][k] = *(const PG8_LAS bf16x8*)(lds + PG8_SB(b, h) + boff + n * 2048 + k * 1024); } while (0)
#define PG8_MMA(ai, bj, At, Bt) do { __builtin_amdgcn_s_setprio(1); _Pragma("unroll") for (int m = 0; m < 4; ++m) _Pragma("unroll") for (int n = 0; n < 2; ++n) _Pragma("unroll") for (int k = 0; k < 2; ++k) \
        acc[ai][bj][m][n] = __builtin_amdgcn_mfma_f32_16x16x32_bf16(Bt[n][k], At[m][k], acc[ai][bj][m][n], 0, 0, 0); __builtin_amdgcn_s_setprio(0); } while (0)
#define PG8_WAIT_V(n) asm volatile("s_waitcnt vmcnt(" #n ")" ::: "memory")
#define PG8_WAIT_L(n) asm volatile("s_waitcnt lgkmcnt(" #n ")" ::: "memory")
#define PG8_BAR __builtin_amdgcn_s_barrier()
#define PG8_SCHED __builtin_amdgcn_sched_barrier(0)
    Unit cur, nxt; int ui = 0;
    if (!S.next(0, cur)) return;
    f32x4 acc[2][2][4][2];
#pragma unroll
    for (int a = 0; a < 2; ++a)
#pragma unroll
        for (int b = 0; b < 2; ++b)
#pragma unroll
            for (int m = 0; m < 4; ++m)
#pragma unroll
                for (int n = 0; n < 2; ++n) acc[a][b][m][n] = (f32x4){0.f, 0.f, 0.f, 0.f};
    bf16x8 At[4][2], B0[2][2], B1[2][2];
    const char* cA = (const char*)g.A + (size_t)cur.pm * tstep; const char* cB = (const char*)g.Bt + (size_t)cur.pn * tstep;
    S.a_ready(cur);
    if constexpr (SP2) {
        PG8_STAGE(PG8_SB(0, 0), cB, voffB); PG8_STAGE(PG8_SB(0, 1), cB + hstep, voffB); PG8_STAGE(PG8_SA(0, 0), cA, voffA); PG8_STAGE(PG8_SA(0, 1), cA + hstep, voffA);
        if (wr == 1) PG8_BAR;
        PG8_WAIT_V(2); PG8_BAR;
        PG8_STAGE(PG8_SB(1, 0), cB + kstep, voffB); PG8_STAGE(PG8_SA(1, 0), cA + kstep, voffA); PG8_STAGE(PG8_SB(1, 1), cB + hstep + kstep, voffB);
        PG8_WAIT_V(6); PG8_BAR;
    } else {
        PG8_STAGE(PG8_SB(0, 0), cB, voffB); PG8_STAGE(PG8_SA(0, 0), cA, voffA); PG8_STAGE(PG8_SB(0, 1), cB + hstep, voffB); PG8_STAGE(PG8_SA(0, 1), cA + hstep, voffA);
        if (wr == 1) PG8_BAR;
        PG8_WAIT_V(4); PG8_BAR;
        PG8_STAGE(PG8_SB(1, 0), cB + kstep, voffB); PG8_STAGE(PG8_SA(1, 0), cA + kstep, voffA); PG8_STAGE(PG8_SB(1, 1), cB + hstep + kstep, voffB);
        PG8_WAIT_V(6); PG8_BAR;
    }
    for (;;) {
        const bool has_next = S.next(ui + 1, nxt);
        const char* nA = has_next ? (const char*)g.A + (size_t)nxt.pm * tstep : cA; const char* nB = has_next ? (const char*)g.Bt + (size_t)nxt.pn * tstep : cB;
        for (int t = 0; t < nt; t += 2) {
            const bool last = (t == nt - 2);
            const char* a1 = cA + (size_t)(t + 1) * kstep;
            const char* a2 = last ? nA : cA + (size_t)(t + 2) * kstep; const char* b2 = last ? nB : cB + (size_t)(t + 2) * kstep;
            const char* a3 = a2 + kstep; const char* b3 = b2 + kstep;
            if (last && has_next) S.a_ready(nxt);
            if constexpr (SP2) {
            PG8_LDB(B0, 0, 0); PG8_LDB(B1, 0, 1); PG8_SCHED; PG8_LDA(At, 0, 0); PG8_STAGE(PG8_SA(1, 1), a1 + hstep, voffA);
            PG8_WAIT_V(8); PG8_WAIT_L(0); PG8_BAR; PG8_MMA(0, 0, At, B0); PG8_MMA(0, 1, At, B1); PG8_BAR; PG8_SCHED;
            PG8_LDA(At, 0, 1); PG8_STAGE(PG8_SB(0, 0), b2, voffB); PG8_STAGE(PG8_SB(0, 1), b2 + hstep, voffB); PG8_STAGE(PG8_SA(0, 0), a2, voffA);
            PG8_WAIT_V(8); PG8_WAIT_L(0); PG8_BAR; PG8_MMA(1, 0, At, B0); PG8_MMA(1, 1, At, B1); PG8_BAR; PG8_SCHED;
            PG8_LDB(B0, 1, 0); PG8_LDB(B1, 1, 1); PG8_SCHED; PG8_LDA(At, 1, 0); PG8_STAGE(PG8_SA(0, 1), a2 + hstep, voffA);
            PG8_WAIT_V(8); PG8_WAIT_L(0); PG8_BAR; PG8_MMA(0, 0, At, B0); PG8_MMA(0, 1, At, B1); PG8_BAR; PG8_SCHED;
            PG8_LDA(At, 1, 1); PG8_STAGE(PG8_SB(1, 0), b3, voffB); PG8_STAGE(PG8_SB(1, 1), b3 + hstep, voffB); PG8_STAGE(PG8_SA(1, 0), a3, voffA);
            PG8_WAIT_V(8); PG8_WAIT_L(0); PG8_BAR; PG8_MMA(1, 0, At, B0); PG8_MMA(1, 1, At, B1); PG8_BAR; PG8_SCHED;
            } else {
            PG8_LDB(B0, 0, 0); PG8_SCHED; PG8_LDA(At, 0, 0); PG8_STAGE(PG8_SA(1, 1), a1 + hstep, voffA);
            PG8_WAIT_L(8); PG8_BAR; PG8_WAIT_L(0); PG8_MMA(0, 0, At, B0); PG8_BAR; PG8_SCHED;
            PG8_LDB(B1, 0, 1); PG8_STAGE(PG8_SB(0, 0), b2, voffB);
            PG8_BAR; PG8_WAIT_L(0); PG8_MMA(0, 1, At, B1); PG8_BAR;
            PG8_LDA(At, 0, 1); PG8_STAGE(PG8_SA(0, 0), a2, voffA);
            PG8_BAR; PG8_WAIT_L(0); PG8_MMA(1, 0, At, B0); PG8_BAR; PG8_SCHED;
            PG8_STAGE(PG8_SB(0, 1), b2 + hstep, voffB);
            PG8_WAIT_V(6); PG8_BAR; PG8_MMA(1, 1, At, B1); PG8_BAR;
            PG8_LDB(B0, 1, 0); PG8_SCHED; PG8_LDA(At, 1, 0); PG8_STAGE(PG8_SA(0, 1), a2 + hstep, voffA);
            PG8_WAIT_L(8); PG8_BAR; PG8_WAIT_L(0); PG8_MMA(0, 0, At, B0); PG8_BAR; PG8_SCHED;
            PG8_LDB(B1, 1, 1); PG8_STAGE(PG8_SB(1, 0), b3, voffB);
            PG8_BAR; PG8_WAIT_L(0); PG8_MMA(0, 1, At, B1); PG8_BAR;
            PG8_LDA(At, 1, 1); PG8_STAGE(PG8_SA(1, 0), a3, voffA);
            PG8_BAR; PG8_WAIT_L(0); PG8_MMA(1, 0, At, B0); PG8_BAR; PG8_SCHED;
            PG8_STAGE(PG8_SB(1, 1), b3 + hstep, voffB);
            PG8_WAIT_V(6); PG8_BAR; PG8_MMA(1, 1, At, B1); PG8_BAR;
            }
        }
        if constexpr (ALIGN_EPI) { if (wr == 0) PG8_BAR; }
        if constexpr (!Epi::AFTER_DRAIN) { E(acc, cur, wr, wc, fr, fq); S.done(cur); }
        if (!has_next) break;
#pragma unroll
        for (int a = 0; a < 2; ++a)
#pragma unroll
            for (int b = 0; b < 2; ++b)
#pragma unroll
                for (int m = 0; m < 4; ++m)
#pragma unroll
                    for (int n = 0; n < 2; ++n) acc[a][b][m][n] = (f32x4){0.f, 0.f, 0.f, 0.f};
        cur = nxt; cA = nA; cB = nB; ++ui;
        if constexpr (ALIGN_EPI) { if (wr == 1) PG8_BAR; }
    }
    PG8_WAIT_V(0);
    if constexpr (!ALIGN_EPI) { if (wr == 0) PG8_BAR; }
    PG8_BAR;
    if constexpr (Epi::AFTER_DRAIN) { E.fused(acc, cur, wr, wc, fr, fq, lds, wid, lane); S.done(cur); }
#undef PG8_SA
#undef PG8_SB
#undef PG8_STAGE
#undef PG8_LDA
#undef PG8_LDB
#undef PG8_MMA
#undef PG8_WAIT_V
#undef PG8_WAIT_L
#undef PG8_BAR
#undef PG8_SCHED
}
}
#include <hip/hip_bf16.h>
#include <cmath>
namespace attn_body {
using bf16=__hip_bfloat16;
using bf16x8=__attribute__((ext_vector_type(8)))short;
using s16x4=__attribute__((ext_vector_type(4)))short;
using f32x16=__attribute__((ext_vector_type(16)))float;
using u32x4=__attribute__((ext_vector_type(4)))unsigned;
constexpr int BATCH=8,NHEAD=8,SEQ=4096,D=64,PQ=3840,PO=1024;
constexpr int NW=8,QBLK=32,QB=QBLK*NW,KVBLK=64,NQB=SEQ/QB;
constexpr int ATTN_UNIT_ROWS=QB;
__device__ __forceinline__ int crow(int r,int hi){return (r&3)+8*(r>>2)+4*hi;}
#define SBAR() __builtin_amdgcn_sched_barrier(0)
__device__ __forceinline__ void cmask(f32x16&p0,f32x16&p1,int jb,int qrel,int hi){
  const float NEG=-INFINITY; int kb=64*jb+4*hi;
  #pragma unroll
  for(int r=0;r<16;++r){int kv=kb+(r&3)+8*(r>>2); if(kv>qrel)p0[r]=NEG; if(kv+32>qrel)p1[r]=NEG;}
}

constexpr int NSLOT=3, SLOTB=8192, SEL_OFF=90112+64;
constexpr int LDS_K=0, LDS_V=NSLOT*SLOTB, LDS_WS=2*NSLOT*SLOTB, LDS_OST=LDS_WS+NW*64*4, LDS_BYTES=LDS_OST+NW*4096;
constexpr float C2=0.125f*1.4426950408889634f;
__device__ __forceinline__ void glds16(const void*gsrc,unsigned lds_dst){unsigned keep;
  asm volatile("s_mov_b32 %0, m0\n\ts_mov_b32 m0, %2\n\ts_nop 0\n\tglobal_load_lds_dwordx4 %1, off\n\ts_mov_b32 m0, %0":"=&s"(keep):"v"(gsrc),"s"(lds_dst):"memory");}
__device__ __forceinline__ float max3f(float a,float b,float c){float r;asm("v_max3_f32 %0, %1, %2, %3":"=v"(r):"v"(a),"v"(b),"v"(c));return r;}
__device__ __forceinline__ float max2f(float a,float b){float r;asm("v_max_f32_e32 %0, %1, %2":"=v"(r):"v"(a),"v"(b));return r;}
__device__ __forceinline__ float fadd_s(float a,float b){float r;asm("v_add_f32_e32 %0, %1, %2":"=v"(r):"v"(a),"v"(b));return r;}
__device__ __forceinline__ float fsub_s(float a,float b){float r;asm("v_sub_f32_e32 %0, %1, %2":"=v"(r):"v"(a),"v"(b));return r;}
typedef float f32x2_t __attribute__((ext_vector_type(2))); typedef __bf16 bf16x2_t __attribute__((ext_vector_type(2)));
__device__ __forceinline__ unsigned cvtpk_s(float lo,float hi){f32x2_t v={lo,hi};bf16x2_t b=__builtin_convertvector(v,bf16x2_t);return __builtin_bit_cast(unsigned,b);}
#define WAIT_BAR(N) asm volatile("s_waitcnt vmcnt(" #N ") lgkmcnt(0)\n\ts_barrier":::"memory")

__device__ __forceinline__ void qkt(f32x16&p0,f32x16&p1,const char*Kslot,const bf16x8*qr,const f32x16&negm,int r32,int hi){
  const char*kb=Kslot+hi*1024+r32*16;
  #pragma unroll
  for(int d0=0;d0<4;++d0){
    const bf16x8 b0=*reinterpret_cast<const bf16x8*>(kb+d0*2048);
    const bf16x8 b1=*reinterpret_cast<const bf16x8*>(kb+d0*2048+512);
    if(d0==0){p0=__builtin_amdgcn_mfma_f32_32x32x16_bf16(b0,qr[0],negm,0,0,0);p1=__builtin_amdgcn_mfma_f32_32x32x16_bf16(b1,qr[0],negm,0,0,0);}
    else{p0=__builtin_amdgcn_mfma_f32_32x32x16_bf16(b0,qr[d0],p0,0,0,0);p1=__builtin_amdgcn_mfma_f32_32x32x16_bf16(b1,qr[d0],p1,0,0,0);}}
}
typedef __attribute__((address_space(3))) const char* lds_cptr;
typedef short v4i16_t __attribute__((ext_vector_type(4)));
__device__ __forceinline__ void kload8(bf16x8*kf,lds_cptr kp){
  kf[0]=*(const __attribute__((address_space(3))) bf16x8*)(kp);      kf[1]=*(const __attribute__((address_space(3))) bf16x8*)(kp+512);
  kf[2]=*(const __attribute__((address_space(3))) bf16x8*)(kp+2048); kf[3]=*(const __attribute__((address_space(3))) bf16x8*)(kp+2560);
  kf[4]=*(const __attribute__((address_space(3))) bf16x8*)(kp+4096); kf[5]=*(const __attribute__((address_space(3))) bf16x8*)(kp+4608);
  kf[6]=*(const __attribute__((address_space(3))) bf16x8*)(kp+6144); kf[7]=*(const __attribute__((address_space(3))) bf16x8*)(kp+6656);
}
__device__ __forceinline__ void kload2(bf16x8*kf,lds_cptr kp,int j){ kf[2*j]=*(const __attribute__((address_space(3))) bf16x8*)(kp+j*2048); kf[2*j+1]=*(const __attribute__((address_space(3))) bf16x8*)(kp+j*2048+512); }
__device__ __forceinline__ s16x4 vtr(lds_cptr p){ return __builtin_bit_cast(s16x4,__builtin_amdgcn_ds_read_tr16_b64_v4i16((__attribute__((address_space(3))) v4i16_t*)p)); }
__device__ __forceinline__ float rowmax(const f32x16&p0,const f32x16&p1){
  float a=max3f(p0[0],p0[1],p1[0]),b=max3f(p0[2],p0[3],p1[1]);a=max3f(a,p1[2],p1[3]);
  #pragma unroll
  for(int r=4;r<16;r+=4){a=max3f(a,p0[r],p0[r+1]);b=max3f(b,p0[r+2],p0[r+3]);a=max3f(a,p1[r],p1[r+1]);b=max3f(b,p1[r+2],p1[r+3]);}
  const float m=max2f(a,b);
  auto rr=__builtin_amdgcn_permlane32_swap(__float_as_uint(m),__float_as_uint(m),false,false);
  return max2f(__uint_as_float(rr[0]),__uint_as_float(rr[1]));
}
__device__ __forceinline__ void pv(f32x16*o,int vb,bf16x8 pa0,bf16x8 pa1,bf16x8 pa2,bf16x8 pa3){
  #pragma unroll
  for(int d0=0;d0<2;++d0){s16x4 lo[4],hi[4];
    #pragma unroll
    for(int ks=0;ks<4;++ks){
      asm volatile("ds_read_b64_tr_b16 %0,%1 offset:%c2":"=&v"(lo[ks]):"v"(vb),"i"(d0*4096+ks*1024):"memory");
      asm volatile("ds_read_b64_tr_b16 %0,%1 offset:%c2":"=&v"(hi[ks]):"v"(vb),"i"(d0*4096+ks*1024+512):"memory");}
    asm volatile("s_waitcnt lgkmcnt(0)":::"memory");SBAR();
    #define PK(k) (bf16x8){lo[k][0],lo[k][1],lo[k][2],lo[k][3],hi[k][0],hi[k][1],hi[k][2],hi[k][3]}
    o[d0]=__builtin_amdgcn_mfma_f32_32x32x16_bf16(pa0,PK(0),o[d0],0,0,0);
    o[d0]=__builtin_amdgcn_mfma_f32_32x32x16_bf16(pa1,PK(1),o[d0],0,0,0);
    o[d0]=__builtin_amdgcn_mfma_f32_32x32x16_bf16(pa2,PK(2),o[d0],0,0,0);
    o[d0]=__builtin_amdgcn_mfma_f32_32x32x16_bf16(pa3,PK(3),o[d0],0,0,0);
    #undef PK
  }
}

#ifndef ATTN_STORE16
#define ATTN_STORE16(p,v) (*(u32x4*)(p)=(v))
#endif
template<int THRL> __device__ __forceinline__ void attn_unit(int b,int h,int qb,const bf16*Q,const bf16*__restrict__ K,const bf16*__restrict__ V,bf16*O,char*shm){
  const int tid=opaque_tid(),lane=tid&63,r32=lane&31,hi=lane>>5; const int wid=__builtin_amdgcn_readfirstlane(tid>>6);
  const long rowbase=(long)b*SEQ; const int q0=qb*QB;
  const bf16*Qw=Q+(rowbase+q0+wid*QBLK)*PQ+h*D;
  const bf16*Kh=K+rowbase*PQ+h*D,*Vh=V+rowbase*PQ+h*D;
  const unsigned lds0=(unsigned)(uintptr_t)shm;
  float*wsf=(float*)(shm+LDS_WS)+wid*64;
  const bf16*ksrc=Kh+(long)lane*PQ+wid*8;
  const bf16*vsrc=Vh+(long)(16*(wid&3)+(lane>>2))*PQ+(wid>>2)*32+(lane&3)*8;
  const unsigned kdst=lds0+LDS_K+wid*1024, vdst=lds0+LDS_V+wid*1024;
  #define KT(t) (((t)<4)?(NT-4+(t)):((t)-4))
  #define DMA_K(t,slot) glds16(ksrc+(long)KT(t)*KVBLK*PQ,(unsigned)__builtin_amdgcn_readfirstlane(kdst+(slot)))
  #define DMA_V(t,slot) glds16(vsrc+(long)KT(t)*KVBLK*PQ,(unsigned)__builtin_amdgcn_readfirstlane(vdst+(slot)))
  const int vb0=(int)(lds0+LDS_V)+((lane>>4)&1)*32+(lane&3)*8+(4*hi+((lane&15)>>2))*64;
  const char*Kbase=shm+LDS_K; bf16x8 kf[8];
  const lds_cptr shm3=(lds_cptr)shm; const lds_cptr kp0=shm3+LDS_K+hi*1024+r32*16; const lds_cptr vp0=shm3+LDS_V+((lane>>4)&1)*32+(lane&3)*8+(4*hi+((lane&15)>>2))*64;
  const int NT=(q0+QB)/KVBLK;
  DMA_K(0,0);DMA_V(0,0);DMA_K(1,SLOTB);
  bf16x8 qr[4];
  #pragma unroll
  for(int d0=0;d0<4;++d0)qr[d0]=*reinterpret_cast<const bf16x8*>(&Qw[(long)r32*PQ+d0*16+hi*8]);
  const unsigned selmask=((const unsigned*)(shm+SEL_OFF))[wid*QBLK+r32];
  float mhat=0.f,l_reg=0.f;f32x16 o[2];o[0]=f32x16{};o[1]=f32x16{};const f32x16 negm=f32x16{};
  const int qrel=wid*QBLK+r32;
  #define CMASK(P0,P1,t) do{const int t_=(t); if(t_<4){cmask(P0,P1,t_,qrel,hi);} else if(!((selmask>>((t_-4)>>2))&1u)){ _Pragma("unroll") for(int r_=0;r_<16;++r_){P0[r_]=-INFINITY;P1[r_]=-INFINITY;} } }while(0)
  bool resc=false;
  #define START(P0,P1) do{ const float rm=rowmax(P0,P1); resc=false; \
    { const float dl=rm; mhat=fadd_s(mhat,dl); \
      _Pragma("unroll") for(int r=0;r<16;++r){P0[r]=fsub_s(P0[r],dl);P1[r]=fsub_s(P1[r],dl);} \
      } \
    _Pragma("unroll") for(int r=0;r<16;++r)P0[r]=__builtin_amdgcn_exp2f(P0[r]); }while(0)
  #define RESC() do{ if(resc){ asm volatile("s_waitcnt lgkmcnt(0)":::"memory"); \
      _Pragma("unroll") for(int d_=0;d_<2;++d_) _Pragma("unroll") for(int r=0;r<16;++r)o[d_][r]*=wsf[crow(r,hi)]; } }while(0)
  f32x16 pA0,pA1,pB0,pB1;
  int sl_prev=0,sl_cur=0,sl_next=SLOTB;
  #define ROT() do{sl_prev=sl_cur;sl_cur=sl_next;sl_next=(sl_next==(NSLOT-1)*SLOTB)?0:sl_next+SLOTB;}while(0)
  DMA_K(2,2*SLOTB);
  WAIT_BAR(3);
  qkt(pA0,pA1,Kbase,qr,negm,r32,hi);asm volatile("s_nop 15\n\ts_nop 7":"+v"(pA0),"+v"(pA1));CMASK(pA0,pA1,0);
  START(pA0,pA1);
  _Pragma("unroll") for(int r=0;r<16;++r)pA1[r]=__builtin_amdgcn_exp2f(pA1[r]);
  WAIT_BAR(0);
  DMA_K(3,0);DMA_V(1,SLOTB);
  ROT();
  kload8(kf,kp0+sl_cur);
  WAIT_BAR(2);
  s16x4 vlo[8],vhi[8]; u32x4 pw0,pw1,pw2,pw3;
  #define PKW(P,B) cvtpk_s(P[B],P[B+1])
  #define PAF(k) __builtin_bit_cast(bf16x8,pw##k)
  #define VFR(i) (bf16x8){vlo[i][0],vlo[i][1],vlo[i][2],vlo[i][3],vhi[i][0],vhi[i][1],vhi[i][2],vhi[i][3]}
  #define PIN(x) asm volatile("":"+v"(x))
  #define MX3(a,b,c) __builtin_fmaxf(__builtin_fmaxf((a),(b)),(c))
  #define GAPA(MF,A0,A1,A2,A3,W0,W1,PW) do{ MF; sacc+=A0; sacc+=A1; sacc+=A2; sacc+=A3; PIN(sacc); W0; W1; PIN(PW); SBAR(); }while(0)
  #define EX(v) __builtin_amdgcn_exp2f(v)
  #define GAPB(MF,X,B) do{ MF; X[B]=EX(X[B]); X[B+1]=EX(X[B+1]); X[B+2]=EX(X[B+2]); X[B+3]=EX(X[B+3]); PIN(X); SBAR(); }while(0)
  #define VRD(i) do{ vlo[i]=vtr(vp_+(((i)>>2)*4096+((i)&3)*1024)); vhi[i]=vtr(vp_+(((i)>>2)*4096+((i)&3)*1024+512)); }while(0)
  #define KRD(G,j) do{ if(G){ kload2(kf,kp0+sl_next,j); SBAR(); } }while(0)
  #define STEP(C0,C1,P0,P1,t,GK,GV,GL) do{ SBAR(); \
    const lds_cptr vp_=vp0+sl_prev; \
    VRD(0); SBAR(); float sacc=(P0[0]+P0[1]); \
    GAPA(C0=__builtin_amdgcn_mfma_f32_32x32x16_bf16(kf[0],qr[0],negm,0,0,0), P0[2],P0[3],P0[4],P0[5],     pw0[0]=PKW(P0,0), pw0[1]=PKW(P0,2), pw0); \
    VRD(4); SBAR(); GAPA(C1=__builtin_amdgcn_mfma_f32_32x32x16_bf16(kf[1],qr[0],negm,0,0,0), P0[6],P0[7],P0[8],P0[9],     pw0[2]=PKW(P0,4), pw0[3]=PKW(P0,6), pw0); \
    VRD(1); SBAR(); GAPA(C0=__builtin_amdgcn_mfma_f32_32x32x16_bf16(kf[2],qr[1],C0,0,0,0),   P0[10],P0[11],P0[12],P0[13], pw1[0]=PKW(P0,8), pw1[1]=PKW(P0,10), pw1); \
    VRD(5); SBAR(); GAPA(C1=__builtin_amdgcn_mfma_f32_32x32x16_bf16(kf[3],qr[1],C1,0,0,0),   P0[14],P0[15],P1[0],P1[1],   pw1[2]=PKW(P0,12),pw1[3]=PKW(P0,14), pw1); \
    VRD(2); SBAR(); GAPA(C0=__builtin_amdgcn_mfma_f32_32x32x16_bf16(kf[4],qr[2],C0,0,0,0),   P1[2],P1[3],P1[4],P1[5],     pw2[0]=PKW(P1,0), pw2[1]=PKW(P1,2), pw2); \
    VRD(6); SBAR(); GAPA(C1=__builtin_amdgcn_mfma_f32_32x32x16_bf16(kf[5],qr[2],C1,0,0,0),   P1[6],P1[7],P1[8],P1[9],     pw2[2]=PKW(P1,4), pw2[3]=PKW(P1,6), pw2); \
    VRD(3); SBAR(); GAPA(C0=__builtin_amdgcn_mfma_f32_32x32x16_bf16(kf[6],qr[3],C0,0,0,0),   P1[10],P1[11],P1[12],P1[13], pw3[0]=PKW(P1,8), pw3[1]=PKW(P1,10), pw3); \
    VRD(7); SBAR(); GAPA(C1=__builtin_amdgcn_mfma_f32_32x32x16_bf16(kf[7],qr[3],C1,0,0,0),   P1[14],P1[15],0.f,0.f,       pw3[2]=PKW(P1,12),pw3[3]=PKW(P1,14), pw3); \
    l_reg+=sacc; \
    _Pragma("unroll") for(int r=0;r<16;++r){C0[r]-=mhat;C1[r]-=mhat;} \
    if(GK){DMA_K((t)+3,sl_cur);} if(GV){DMA_V((t)+1,sl_next);} \
    CMASK(C0,C1,t); \
    { float a=MX3(C0[0],C0[1],C1[0]),b=MX3(C0[2],C0[3],C1[1]); a=MX3(a,C1[2],C1[3]); \
      _Pragma("unroll") for(int r=4;r<16;r+=4){a=MX3(a,C0[r],C0[r+1]);b=MX3(b,C0[r+2],C0[r+3]);a=MX3(a,C1[r],C1[r+1]);b=MX3(b,C1[r+2],C1[r+3]);} \
      float rm=__builtin_fmaxf(a,b); { auto rr=__builtin_amdgcn_permlane32_swap(__float_as_uint(rm),__float_as_uint(rm),false,false); rm=__builtin_fmaxf(__uint_as_float(rr[0]),__uint_as_float(rr[1])); } \
      resc=false; \
      if(__builtin_expect(__any(rm>(float)THRL),0)){ const float dl=__builtin_fmaxf(rm,0.f); mhat+=dl; \
        _Pragma("unroll") for(int r=0;r<16;++r){C0[r]-=dl;C1[r]-=dl;} \
        const float f=__builtin_amdgcn_exp2f(-dl); l_reg*=f; if(hi==0)wsf[r32]=f; resc=true; } } \
    SBAR(); \
    GAPB(o[0]=__builtin_amdgcn_mfma_f32_32x32x16_bf16(PAF(0),VFR(0),o[0],0,0,0), C0,0); \
    GAPB(o[1]=__builtin_amdgcn_mfma_f32_32x32x16_bf16(PAF(0),VFR(4),o[1],0,0,0), C0,4); \
    KRD(GL,0); GAPB(o[0]=__builtin_amdgcn_mfma_f32_32x32x16_bf16(PAF(1),VFR(1),o[0],0,0,0), C0,8); \
    KRD(GL,1); GAPB(o[1]=__builtin_amdgcn_mfma_f32_32x32x16_bf16(PAF(1),VFR(5),o[1],0,0,0), C0,12); \
    KRD(GL,2); GAPB(o[0]=__builtin_amdgcn_mfma_f32_32x32x16_bf16(PAF(2),VFR(2),o[0],0,0,0), C1,0); \
    KRD(GL,3); GAPB(o[1]=__builtin_amdgcn_mfma_f32_32x32x16_bf16(PAF(2),VFR(6),o[1],0,0,0), C1,4); \
    GAPB(o[0]=__builtin_amdgcn_mfma_f32_32x32x16_bf16(PAF(3),VFR(3),o[0],0,0,0), C1,8); \
    GAPB(o[1]=__builtin_amdgcn_mfma_f32_32x32x16_bf16(PAF(3),VFR(7),o[1],0,0,0), C1,12); \
    }while(0)
  int t=1;
  for(;t+5<NT;t+=2){
    STEP(pB0,pB1,pA0,pA1,t,true,true,true);     WAIT_BAR(2); RESC(); ROT();
    STEP(pA0,pA1,pB0,pB1,t+1,true,true,true);   WAIT_BAR(2); RESC(); ROT();
  }
  #define ENDW(tt) do{ if((tt)+3<NT){WAIT_BAR(2);} else if((tt)+2<NT){WAIT_BAR(1);} else {WAIT_BAR(0);} }while(0)
  for(;t+1<NT;t+=2){
    STEP(pB0,pB1,pA0,pA1,t,(t+3<NT),(t+1<NT),(t+1<NT));       ENDW(t);   RESC(); ROT();
    STEP(pA0,pA1,pB0,pB1,t+1,(t+4<NT),(t+2<NT),(t+2<NT));     ENDW(t+1); RESC(); ROT();
  }
  STEP(pB0,pB1,pA0,pA1,NT-1,false,false,false); RESC();
  { float sacc=pB0[0]+pB0[1]; _Pragma("unroll") for(int r=2;r<16;++r)sacc+=pB0[r]; _Pragma("unroll") for(int r=0;r<16;++r)sacc+=pB1[r]; l_reg+=sacc;
    pw0=(u32x4){PKW(pB0,0),PKW(pB0,2),PKW(pB0,4),PKW(pB0,6)};pw1=(u32x4){PKW(pB0,8),PKW(pB0,10),PKW(pB0,12),PKW(pB0,14)};pw2=(u32x4){PKW(pB1,0),PKW(pB1,2),PKW(pB1,4),PKW(pB1,6)};pw3=(u32x4){PKW(pB1,8),PKW(pB1,10),PKW(pB1,12),PKW(pB1,14)};
    SBAR(); pv(o,vb0+sl_cur,PAF(0),PAF(1),PAF(2),PAF(3)); }
  #undef PKW
  #undef PAF
  #undef VFR
  #undef PIN
  #undef MX3
  #undef GAPA
  #undef GAPB
  #undef EX
  #undef VRD
  #undef KRD
  #undef STEP
  #undef ENDW
  {auto rr=__builtin_amdgcn_permlane32_swap(__float_as_uint(l_reg),__float_as_uint(l_reg),false,false);l_reg=__uint_as_float(rr[0])+__uint_as_float(rr[1]);}
  if(hi==0)wsf[32+r32]=l_reg;asm volatile("s_waitcnt lgkmcnt(0)":::"memory");
  float rli[16];
  #pragma unroll
  for(int r=0;r<16;++r)rli[r]=__builtin_amdgcn_rcpf(wsf[32+crow(r,hi)]);
  bf16*Ow=O+(rowbase+q0+wid*QBLK)*PO+h*D;
  { bf16*stg=(bf16*)(shm+LDS_OST)+wid*2048;
    #pragma unroll
    for(int r=0;r<16;++r){const int orow=crow(r,hi);
      #pragma unroll
      for(int d0=0;d0<2;++d0)stg[orow*64+d0*32+r32]=__float2bfloat16(o[d0][r]*rli[r]);}
    asm volatile("s_waitcnt lgkmcnt(0)":::"memory");
    #pragma unroll
    for(int i=0;i<4;++i){const int row=i*8+(lane>>3),ch=lane&7; const u32x4 v=*(const u32x4*)(stg+row*64+ch*8); ATTN_STORE16(Ow+(long)row*PO+ch*8,v);} }
  asm volatile("s_waitcnt lgkmcnt(0)\n\ts_barrier":::"memory");
  #undef DMA_K
  #undef KT
  #undef DMA_V
  #undef CMASK
  #undef START
  #undef RESC
  #undef ROT
}
constexpr int ATTN_LDS_BYTES=LDS_BYTES;
struct AttnTensors { const bf16* Q; const bf16* K; const bf16* V; bf16* O; };
#undef SBAR
#undef WAIT_BAR
}
typedef unsigned short bf16;
typedef unsigned v4u __attribute__((ext_vector_type(4)));
typedef unsigned v2u __attribute__((ext_vector_type(2)));
typedef float f32x4 __attribute__((ext_vector_type(4)));
typedef short bf16x8 __attribute__((ext_vector_type(8)));
constexpr int NB = 8, SEQL = 4096, DMODEL = 1024, NLAYER = 2, MTOK = NB * SEQL;
constexpr int NIN = 3592, NINP = 3840, DFF = 2816, NUP = 5632;
constexpr int C_QA = 0, C_KA = 512, C_VA = 1024, C_Z = 1536, C_QB = 2048, C_KB = 2560, C_VB = 3072, C_AL = 3584, C_BL = 3588;
constexpr float ALPHA = 1.4142135623730951f, LN_EPS = 1e-5f, NORM_EPS = 1e-6f;
constexpr size_t MiB = 1u << 20;
constexpr size_t WS_CTL = 0, WS_KMEAN = 256 * 1024, WS_GLAST = 512 * 1024;
constexpr size_t WS_W = 1 * MiB, W_LAYER = 26 * MiB, W_IN = 0, W_OUT = 7864320, W_UP = W_OUT + 2 * MiB, W_DOWN = W_UP + 11 * MiB;
constexpr size_t WS_XBF = 53 * MiB;
constexpr size_t WS_PROJ = 117 * MiB;
constexpr size_t WS_GDN = 357 * MiB;
constexpr size_t WS_YX = WS_PROJ;
constexpr size_t WS_ACT = 245 * MiB;
constexpr size_t WS_EDGE = 421 * MiB;
constexpr size_t WS_END = 501 * MiB;
constexpr int CHUNK_REC = 73728;
constexpr int LDS_BYTES = 155648;
constexpr int NTHREADS = 512;

__device__ __forceinline__ float bf2f(unsigned short u) { return __uint_as_float(((unsigned)u) << 16); }
__device__ __forceinline__ unsigned f2bf(float f) { unsigned u = __float_as_uint(f); return (u + 0x7fffu + ((u >> 16) & 1u)) >> 16; }
__device__ __forceinline__ unsigned pk2(float lo, float hi) { return f2bf(lo) | (f2bf(hi) << 16); }
__device__ __forceinline__ float wave_sum(float v) {
#pragma unroll
    for (int o = 1; o < 64; o <<= 1) v += __shfl_xor(v, o);
    return v;
}
__device__ __forceinline__ f32x4 mfma16(bf16x8 a, bf16x8 b, f32x4 c) { return __builtin_amdgcn_mfma_f32_16x16x32_bf16(a, b, c, 0, 0, 0); }

template <int MAPID> __device__ __forceinline__ int wmap(int n) {
    if (MAPID == 0) return n;
    if (MAPID == 1) { if (n < 1536) return n; if (n < 3584) return n + 8; if (n < 3592) return n - 3584 + 1536; return -1; }
    { const int pn = n >> 8, rem = n & 255; return (rem >> 7) * DFF + pn * 128 + (rem & 127); }
}
template <int MAPID> __device__ __forceinline__ void transpose_item(const float* W, int K, int N, int NP, bf16* WT, float* scr, int item, int lane) {
    const int nblk = NP / 32, kb = item / nblk, nb = item % nblk, k0 = 64 * kb, n0 = 32 * nb;
    const int src = wmap<MAPID>(n0 + (lane & 31));
#pragma unroll 8
    for (int i = 0; i < 32; ++i) { const int kk = 2 * i + (lane >> 5); scr[kk * 33 + (lane & 31)] = (src >= 0) ? W[(size_t)(k0 + kk) * N + src] : 0.f; }
    asm volatile("s_waitcnt lgkmcnt(0)" ::: "memory");
    const int c = lane & 7;
#pragma unroll
    for (int j = 0; j < 4; ++j) { const int n = (lane >> 3) + 8 * j; const float* s = scr + (8 * c) * 33 + n;
        v4u o; o.x = pk2(s[0 * 33], s[1 * 33]); o.y = pk2(s[2 * 33], s[3 * 33]); o.z = pk2(s[4 * 33], s[5 * 33]); o.w = pk2(s[6 * 33], s[7 * 33]);
        *(v4u*)(WT + (size_t)(n0 + n) * K + k0 + 8 * c) = o; }
    asm volatile("s_waitcnt lgkmcnt(0)" ::: "memory");
}
struct Ptrs {
    const float *x, *w_in, *conv_w, *a_log, *dt_bias, *norm_g, *w_out, *ln1_g, *ln1_b, *w_up, *fconv_w, *fconv_b, *w_down, *ln2_g, *ln2_b;
    float* out; unsigned char* ws;
};
__device__ __forceinline__ void p0_prologue(const Ptrs& P, unsigned char* lds, int G) {
    const int tid = opaque_tid(), lane = tid & 63, wave = tid >> 6;
    float* scr = (float*)(lds + wave * 16384);
    const int gw = blockIdx.x * 8 + wave, NGW = G * 8;
    constexpr int I_IN = 16 * (NINP / 32), I_OUT = 16 * 32, I_UP = 16 * (NUP / 32), I_DN = (DFF / 64) * 32, I_L = I_IN + I_OUT + I_UP + I_DN;
    for (int it = gw; it < NLAYER * I_L; it += NGW) {
        const int l = it / I_L; int r = it % I_L;
        unsigned char* wb = P.ws + WS_W + (size_t)l * W_LAYER;
        if (r < I_IN) { transpose_item<1>(P.w_in + (size_t)l * DMODEL * NIN, DMODEL, NIN, NINP, (bf16*)(wb + W_IN), scr, r, lane); continue; } r -= I_IN;
        if (r < I_OUT) { transpose_item<0>(P.w_out + (size_t)l * DMODEL * DMODEL, DMODEL, DMODEL, DMODEL, (bf16*)(wb + W_OUT), scr, r, lane); continue; } r -= I_OUT;
        if (r < I_UP) { transpose_item<2>(P.w_up + (size_t)l * DMODEL * NUP, DMODEL, NUP, NUP, (bf16*)(wb + W_UP), scr, r, lane); continue; } r -= I_UP;
        transpose_item<0>(P.w_down + (size_t)l * DFF * DMODEL, DFF, DMODEL, DMODEL, (bf16*)(wb + W_DOWN), scr, r, lane);
    }
    bf16* xb = (bf16*)(P.ws + WS_XBF);
    const size_t nvec = (size_t)MTOK * DMODEL / 8;
    for (size_t v = (size_t)blockIdx.x * NTHREADS + tid; v < nvec; v += (size_t)G * NTHREADS) {
        const f32x4 a = *(const f32x4*)(P.x + v * 8), b = *(const f32x4*)(P.x + v * 8 + 4);
        v4u o; o.x = pk2(a[0], a[1]); o.y = pk2(a[2], a[3]); o.z = pk2(b[0], b[1]); o.w = pk2(b[2], b[3]);
        *(v4u*)(xb + v * 8) = o;
    }
}

__device__ __forceinline__ void ln_phase(const float* y, float* outf, bf16* outb, const float* gam, const float* bet, int G) {
    const int tid = opaque_tid(), lane = tid & 63, wave = tid >> 6;
    f32x4 gv[4], bv[4];
#pragma unroll
    for (int j = 0; j < 4; ++j) { gv[j] = *(const f32x4*)(gam + 4 * lane + 256 * j); bv[j] = *(const f32x4*)(bet + 4 * lane + 256 * j); }
    for (int m = blockIdx.x * 8 + wave; m < MTOK; m += G * 8) {
        const f32x4* xr = (const f32x4*)(y + (size_t)m * DMODEL) + lane;
        f32x4 v[4]; float s = 0.f;
#pragma unroll
        for (int j = 0; j < 4; ++j) { v[j] = xr[64 * j]; s += (v[j][0] + v[j][1]) + (v[j][2] + v[j][3]); }
        const float mean = wave_sum(s) * (1.f / DMODEL); float s2 = 0.f;
#pragma unroll
        for (int j = 0; j < 4; ++j) { v[j] = v[j] - mean; s2 += (v[j][0] * v[j][0] + v[j][1] * v[j][1]) + (v[j][2] * v[j][2] + v[j][3] * v[j][3]); }
        const float rstd = 1.f / sqrtf(wave_sum(s2) * (1.f / DMODEL) + LN_EPS);
        f32x4* of = (f32x4*)(outf + (size_t)m * DMODEL) + lane;
        v2u* ob = (v2u*)(outb + (size_t)m * DMODEL) + lane;
#pragma unroll
        for (int j = 0; j < 4; ++j) { const f32x4 o = v[j] * rstd * gv[j] + bv[j]; of[64 * j] = o; v2u w; w.x = pk2(o[0], o[1]); w.y = pk2(o[2], o[3]); ob[64 * j] = w; }
    }
}

__device__ __forceinline__ void fix_phase(const float* edge, bf16* act, const float* cw, const float* cb, int G) {
    const int total = 512 * 2 * (DFF / 4);
    const int tid = opaque_tid();
    for (int it = blockIdx.x * NTHREADS + tid; it < total; it += G * NTHREADS) {
        const int c4 = it % (DFF / 4), rr = (it / (DFF / 4)) & 1, s = it / (DFF / 2);
        const int ch = 4 * c4; const bool first = (s % 64) == 0;
        f32x4 h[2];
#pragma unroll
        for (int bj = 0; bj < 2; ++bj) {
            const int col = bj * DFF + ch;
            const f32x4 z4 = (f32x4){0.f, 0.f, 0.f, 0.f};
            const f32x4 cur = *(const f32x4*)(edge + ((size_t)s * 4 + rr) * NUP + col);
            f32x4 p1, p2;
            if (rr == 1) { p1 = *(const f32x4*)(edge + ((size_t)s * 4 + 0) * NUP + col); p2 = first ? z4 : *(const f32x4*)(edge + ((size_t)(s - 1) * 4 + 3) * NUP + col); }
            else { p1 = first ? z4 : *(const f32x4*)(edge + ((size_t)(s - 1) * 4 + 3) * NUP + col); p2 = first ? z4 : *(const f32x4*)(edge + ((size_t)(s - 1) * 4 + 2) * NUP + col); }
            h[bj] = *(const f32x4*)(cw + 2 * NUP + col) * cur + *(const f32x4*)(cw + NUP + col) * p1 + *(const f32x4*)(cw + col) * p2 + *(const f32x4*)(cb + col);
        }
        v2u o; o.x = pk2(pg8::silu_f(h[0][0]) * h[1][0], pg8::silu_f(h[0][1]) * h[1][1]); o.y = pk2(pg8::silu_f(h[0][2]) * h[1][2], pg8::silu_f(h[0][3]) * h[1][3]);
        *(v2u*)(act + ((size_t)s * 64 + rr) * DFF + ch) = o;
    }
}

__device__ __forceinline__ void moba_prep_item(bf16* proj, float* kmean, int item, unsigned char* lds) {
    const int tid = opaque_tid(); const int j = item & 15, h = (item >> 4) & 7, b = item >> 7;
    const int r = tid >> 1, part = tid & 1;
    float* tile = (float*)lds;
    float* psum = (float*)(lds + 256 * 65 * 4);
    const int pos = 256 * j + r;
    bf16* qp = proj + ((size_t)b * SEQL + pos) * NINP + C_QB + h * 64 + 32 * part;
    bf16* kp = proj + ((size_t)b * SEQL + pos) * NINP + C_KB + h * 64 + 32 * part;
    float q[32], k[32];
#pragma unroll
    for (int v = 0; v < 4; ++v) { const v4u a = *(const v4u*)(qp + 8 * v), c = *(const v4u*)(kp + 8 * v);
#pragma unroll
        for (int e = 0; e < 4; ++e) { q[8 * v + 2 * e] = bf2f((unsigned short)(a[e] & 0xffffu)); q[8 * v + 2 * e + 1] = bf2f((unsigned short)(a[e] >> 16));
                                      k[8 * v + 2 * e] = bf2f((unsigned short)(c[e] & 0xffffu)); k[8 * v + 2 * e + 1] = bf2f((unsigned short)(c[e] >> 16)); } }
    if (part == 0) {
#pragma unroll
        for (int i = 0; i < 8; ++i) {
            const float inv = powf(500000.0f, -(float)i / 8.0f);
            const float ang = (float)pos * inv; float sn, cs; sincosf(ang, &sn, &cs);
            const float q1 = q[i], q2 = q[i + 8], k1 = k[i], k2 = k[i + 8];
            q[i] = q1 * cs - q2 * sn; q[i + 8] = q2 * cs + q1 * sn; k[i] = k1 * cs - k2 * sn; k[i + 8] = k2 * cs + k1 * sn;
        }
    }
    const float C2 = 0.125f * 1.4426950408889634f;
#pragma unroll
    for (int v = 0; v < 4; ++v) { v4u a, c;
#pragma unroll
        for (int e = 0; e < 4; ++e) { a[e] = pk2(q[8 * v + 2 * e] * C2, q[8 * v + 2 * e + 1] * C2); c[e] = pk2(k[8 * v + 2 * e], k[8 * v + 2 * e + 1]); }
        *(v4u*)(qp + 8 * v) = a; *(v4u*)(kp + 8 * v) = c; }
#pragma unroll
    for (int i = 0; i < 32; ++i) tile[r * 65 + 32 * part + i] = k[i];
    __syncthreads();
    { const int d = tid & 63, seg = tid >> 6; float s = 0.f;
#pragma unroll 8
      for (int rr = 0; rr < 32; ++rr) s += tile[(seg * 32 + rr) * 65 + d];
      psum[seg * 64 + d] = s; }
    __syncthreads();
    if (tid < 64) { float s = 0.f;
#pragma unroll
        for (int w = 0; w < 8; ++w) s += psum[w * 64 + tid];
        kmean[((size_t)(b * 8 + h) * 16 + j) * 64 + tid] = s * (1.0f / 256.0f); }
    __syncthreads();
}

__device__ __forceinline__ void moba_select(int b, int h, int qb, const bf16* proj, const float* kmean_bh, unsigned char* lds) {
    const int tid = opaque_tid(), r = tid >> 1, half = tid & 1;
    const bf16* qp = proj + ((size_t)b * SEQL + qb * 256 + r) * NINP + C_QB + h * 64 + 32 * half;
    float q[32];
#pragma unroll
    for (int v = 0; v < 4; ++v) { const v4u a = *(const v4u*)(qp + 8 * v);
#pragma unroll
        for (int e = 0; e < 4; ++e) { q[8 * v + 2 * e] = bf2f((unsigned short)(a[e] & 0xffffu)); q[8 * v + 2 * e + 1] = bf2f((unsigned short)(a[e] >> 16)); } }
    float gate[16];
#pragma unroll
    for (int j = 0; j < 16; ++j) { float sg = -INFINITY;
        if (j < qb) { const float* km = kmean_bh + j * 64 + 32 * half; float a_ = 0.f;
#pragma unroll
            for (int v = 0; v < 8; ++v) { const f32x4 k4 = *(const f32x4*)(km + 4 * v); a_ += q[4 * v] * k4[0] + q[4 * v + 1] * k4[1] + q[4 * v + 2] * k4[2] + q[4 * v + 3] * k4[3]; }
            a_ += __shfl_xor(a_, 1); sg = a_; }
        gate[j] = sg; }
    unsigned selmask = 0u;
#pragma unroll
    for (int rk = 0; rk < 3; ++rk) { float best = -INFINITY; int bi = -1;
#pragma unroll
        for (int j = 0; j < 16; ++j) { const bool ok = (j < qb) && !((selmask >> j) & 1u) && (gate[j] > best); if (ok) { best = gate[j]; bi = j; } }
        if (bi >= 0) selmask |= (1u << bi); }
    if (half == 0) ((unsigned*)(lds + attn_body::SEL_OFF))[r] = selmask;
}
namespace gdn {
constexpr int LQN = 0, LQD = 17408, LKN = 34816, LVBT = 52224, LKBG = 70656, LKDT = 89088, LAF = 107520, LTINV = 124928, LATT = 134144, LGATE = 143360;
constexpr int SQ = 136, ST = 72, SA = 68;
__device__ __forceinline__ bf16x8 ld16(const unsigned char* p) { return *(const bf16x8*)p; }

__device__ __forceinline__ void prep_item(const bf16* proj, unsigned char* rec, float* glast_out, const float* cw, float a_log_h, float dt_bias_h, int b, int h, int n, unsigned char* lds) {
    const int tid = opaque_tid(), lane = tid & 63, wid = tid >> 6, g = lane >> 4, ln = lane & 15;
    bf16* Qn = (bf16*)(lds + LQN); bf16* Qd = (bf16*)(lds + LQD); bf16* Kn = (bf16*)(lds + LKN);
    bf16* VbT = (bf16*)(lds + LVBT); bf16* KbgT = (bf16*)(lds + LKBG); bf16* KdT = (bf16*)(lds + LKDT);
    float* Af = (float*)(lds + LAF); bf16* Wl = (bf16*)(lds + LAF); bf16* Tinv = (bf16*)(lds + LTINV); bf16* Att = (bf16*)(lds + LATT);
    float* gcum = (float*)(lds + LGATE); float* beta = gcum + 64; float* expg = gcum + 128; float* kdf = gcum + 192;
    const int t0 = n * 64; const size_t rowb = (size_t)b * SEQL;
    if (wid == 0) {
        const bf16* pr = proj + (rowb + t0 + lane) * NINP;
        const float al = bf2f(pr[C_AL + h]), bl = bf2f(pr[C_BL + h]);
        const float xx = al + dt_bias_h; const float sp = (xx > 20.f) ? xx : log1pf(expf(xx));
        float gv = -expf(a_log_h) * sp;
#pragma unroll
        for (int o = 1; o < 64; o <<= 1) { const float t = __shfl_up(gv, o); if (lane >= o) gv += t; }
        const float gl = __shfl(gv, 63);
        gcum[lane] = gv; beta[lane] = 1.0f / (1.0f + expf(-bl)); expg[lane] = expf(gv); kdf[lane] = expf(gl - gv);
        if (lane == 0) *glast_out = gl;
    }
    __syncthreads();
    {
        const int r = tid >> 3, part = tid & 7;
        const float be = beta[r], eg = expg[r], kd = kdf[r];
#pragma unroll
        for (int sec = 0; sec < 3; ++sec) {
            const int cb = sec * 512 + h * 128 + part * 16;
            float y[16];
#pragma unroll
            for (int i = 0; i < 16; ++i) y[i] = 0.f;
#pragma unroll
            for (int off = 0; off < 4; ++off) {
                const int t = t0 + r - 3 + off;
                v4u x0 = (v4u){0u, 0u, 0u, 0u}, x1 = x0;
                if (t >= 0) { const bf16* xp = proj + (rowb + t) * NINP + cb; x0 = *(const v4u*)xp; x1 = *(const v4u*)(xp + 8); }
                const float* wp = cw + off * 1536 + cb;
#pragma unroll
                for (int v = 0; v < 4; ++v) { const f32x4 w4 = *(const f32x4*)(wp + 4 * v);
                    const unsigned ua = (v < 2) ? x0[2 * v] : x1[2 * v - 4], ub = (v < 2) ? x0[2 * v + 1] : x1[2 * v - 3];
                    y[4 * v + 0] += w4[0] * bf2f((unsigned short)(ua & 0xffffu)); y[4 * v + 1] += w4[1] * bf2f((unsigned short)(ua >> 16));
                    y[4 * v + 2] += w4[2] * bf2f((unsigned short)(ub & 0xffffu)); y[4 * v + 3] += w4[3] * bf2f((unsigned short)(ub >> 16)); }
            }
            float ssq = 0.f;
#pragma unroll
            for (int i = 0; i < 16; ++i) { y[i] = y[i] / (1.0f + expf(-y[i])); ssq += y[i] * y[i]; }
            if (sec < 2) { ssq += __shfl_xor(ssq, 1); ssq += __shfl_xor(ssq, 2); ssq += __shfl_xor(ssq, 4); }
            const float rs = rsqrtf(ssq + NORM_EPS);
            if (sec == 0) {
                const float sc = rs * 0.08838834764831845f;
                v4u a0, a1, d0, d1;
#pragma unroll
                for (int e = 0; e < 4; ++e) { a0[e] = pk2(y[2 * e] * sc, y[2 * e + 1] * sc); a1[e] = pk2(y[8 + 2 * e] * sc, y[9 + 2 * e] * sc);
                                              d0[e] = pk2(y[2 * e] * sc * eg, y[2 * e + 1] * sc * eg); d1[e] = pk2(y[8 + 2 * e] * sc * eg, y[9 + 2 * e] * sc * eg); }
                *(v4u*)(Qn + r * SQ + part * 16) = a0; *(v4u*)(Qn + r * SQ + part * 16 + 8) = a1;
                *(v4u*)(Qd + r * SQ + part * 16) = d0; *(v4u*)(Qd + r * SQ + part * 16 + 8) = d1;
            } else if (sec == 1) {
                v4u a0, a1;
#pragma unroll
                for (int e = 0; e < 4; ++e) { a0[e] = pk2(y[2 * e] * rs, y[2 * e + 1] * rs); a1[e] = pk2(y[8 + 2 * e] * rs, y[9 + 2 * e] * rs); }
                *(v4u*)(Kn + r * SQ + part * 16) = a0; *(v4u*)(Kn + r * SQ + part * 16 + 8) = a1;
#pragma unroll
                for (int i = 0; i < 16; ++i) { const float kn = y[i] * rs; const int d = part * 16 + i;
                    KbgT[d * ST + r] = (bf16)f2bf(kn * be * eg); KdT[d * ST + r] = (bf16)f2bf(kn * kd); }
            } else {
#pragma unroll
                for (int i = 0; i < 16; ++i) VbT[(part * 16 + i) * ST + r] = (bf16)f2bf(y[i] * be);
            }
        }
    }
    __syncthreads();
    {
        const int Ti = wid >> 1;
#pragma unroll
        for (int tt = 0; tt < 2; ++tt) {
            const int Tj = 2 * (wid & 1) + tt;
            if (Tj > Ti) {
#pragma unroll
                for (int j = 0; j < 4; ++j) { Att[(16 * Ti + 4 * g + j) * ST + 16 * Tj + ln] = 0; Af[(16 * Ti + 4 * g + j) * SA + 16 * Tj + ln] = 0.f; }
            } else {
                f32x4 aK = (f32x4){0.f, 0.f, 0.f, 0.f}, aQ = aK;
#pragma unroll
                for (int kk = 0; kk < 4; ++kk) {
                    const bf16x8 fk = ld16((const unsigned char*)(Kn + (16 * Ti + ln) * SQ + 32 * kk + 8 * g));
                    const bf16x8 fq = ld16((const unsigned char*)(Qn + (16 * Ti + ln) * SQ + 32 * kk + 8 * g));
                    const bf16x8 fb = ld16((const unsigned char*)(Kn + (16 * Tj + ln) * SQ + 32 * kk + 8 * g));
                    aK = mfma16(fk, fb, aK); aQ = mfma16(fq, fb, aQ);
                }
                const int jj = 16 * Tj + ln; const float gj = gcum[jj];
#pragma unroll
                for (int j = 0; j < 4; ++j) { const int i = 16 * Ti + 4 * g + j; const float dcy = expf(fminf(gcum[i] - gj, 0.f));
                    Af[i * SA + jj] = (i > jj) ? beta[i] * aK[j] * dcy : 0.f;
                    Att[i * ST + jj] = (bf16)f2bf((i >= jj) ? aQ[j] * dcy : 0.f); }
            }
        }
    }
    __syncthreads();
    if (wid == 0) {
        float x[64];
        int zv = 0; asm volatile("" : "+v"(zv));
        const float* Afz = Af + zv;
#pragma unroll
        for (int i = 0; i < 64; ++i) {
            const float* ar = Afz + i * SA;
            float s = -Af[i * SA + lane];
#pragma unroll
            for (int j = 0; j < i; ++j) s -= ar[j] * x[j];
            x[i] = s;
            Tinv[i * ST + lane] = (bf16)f2bf(s);
        }
        asm volatile("s_waitcnt lgkmcnt(0)" ::: "memory");
        Tinv[lane * ST + lane] = (bf16)0x3F80u;
    }
    __syncthreads();
    {
        f32x4 aU[4], aW[4];
#pragma unroll
        for (int T = 0; T < 4; ++T) { aU[T] = (f32x4){0.f, 0.f, 0.f, 0.f}; aW[T] = aU[T]; }
#pragma unroll
        for (int kk = 0; kk < 2; ++kk) {
            const bf16x8 bU = ld16((const unsigned char*)(VbT + (16 * wid + ln) * ST + 32 * kk + 8 * g));
            const bf16x8 bW = ld16((const unsigned char*)(KbgT + (16 * wid + ln) * ST + 32 * kk + 8 * g));
#pragma unroll
            for (int T = 0; T < 4; ++T) { const bf16x8 a = ld16((const unsigned char*)(Tinv + (16 * T + ln) * ST + 32 * kk + 8 * g)); aU[T] = mfma16(a, bU, aU[T]); aW[T] = mfma16(a, bW, aW[T]); }
        }
        v4u u0, u1;
        u0[0] = pk2(aU[0][0], aU[0][1]); u0[1] = pk2(aU[0][2], aU[0][3]); u0[2] = pk2(aU[1][0], aU[1][1]); u0[3] = pk2(aU[1][2], aU[1][3]);
        u1[0] = pk2(aU[2][0], aU[2][1]); u1[1] = pk2(aU[2][2], aU[2][3]); u1[2] = pk2(aU[3][0], aU[3][1]); u1[3] = pk2(aU[3][2], aU[3][3]);
        *(v4u*)(rec + (wid * 64 + lane) * 32) = u0; *(v4u*)(rec + (wid * 64 + lane) * 32 + 16) = u1;
#pragma unroll
        for (int T = 0; T < 4; ++T)
#pragma unroll
            for (int j = 0; j < 4; ++j) Wl[(16 * T + 4 * g + j) * SQ + 16 * wid + ln] = (bf16)f2bf(aW[T][j]);
    }
    __syncthreads();
#pragma unroll
    for (int it = 0; it < 7; ++it) {
        const int p = tid + 512 * it;
        const bf16* src; int stride, T, kk, idx; int dst;
        if (p < 1024) { idx = p; src = Wl; stride = SQ; T = idx >> 8; kk = (idx >> 6) & 3; dst = 16384 + idx * 16; }
        else if (p < 2048) { idx = p - 1024; src = Qd; stride = SQ; T = idx >> 8; kk = (idx >> 6) & 3; dst = 32768 + idx * 16; }
        else if (p < 2560) { idx = p - 2048; src = Att; stride = ST; T = idx >> 7; kk = (idx >> 6) & 1; dst = 49152 + idx * 16; }
        else { idx = p - 2560; src = KdT; stride = ST; T = idx >> 7; kk = (idx >> 6) & 1; dst = 57344 + idx * 16; }
        const int l = idx & 63, gg = l >> 4, m = l & 15;
        const bf16* sp = src + (16 * T + m) * stride + 32 * kk + 4 * gg;
        const v2u lo = *(const v2u*)sp, hi = *(const v2u*)(sp + 16);
        v4u o; o[0] = lo[0]; o[1] = lo[1]; o[2] = hi[0]; o[3] = hi[1];
        *(v4u*)(rec + dst) = o;
    }
    __syncthreads();
}

constexpr int SBUF = 57344, SRED = 2 * SBUF;
__device__ __forceinline__ bf16x8 packS(const f32x4& a, const f32x4& b) {
    v4u r; r[0] = pg8::cvt_pk_bf16(a[0], a[1]); r[1] = pg8::cvt_pk_bf16(a[2], a[3]); r[2] = pg8::cvt_pk_bf16(b[0], b[1]); r[3] = pg8::cvt_pk_bf16(b[2], b[3]);
    return __builtin_bit_cast(bf16x8, r);
}
__device__ __forceinline__ void scan_bh(int bh, const unsigned char* gdnbase, const float* glast, const bf16* proj, bf16* concat, const float* normg, unsigned char* lds) {
    const int tid = opaque_tid(), lane = tid & 63, wid = tid >> 6, g = lane >> 4, ln = lane & 15;
    const int b = bh >> 2, h = bh & 3;
    f32x4 S[8];
#pragma unroll
    for (int T = 0; T < 8; ++T) S[T] = (f32x4){0.f, 0.f, 0.f, 0.f};
    const unsigned char* rec0 = gdnbase + (size_t)bh * 64 * CHUNK_REC;
    float* red = (float*)(lds + SRED);
    const float ng = normg[16 * wid + ln];
    v4u st[7];
#pragma unroll
    for (int i = 0; i < 7; ++i) st[i] = *(const v4u*)(rec0 + 16384 + (size_t)(tid + 512 * i) * 16);
#pragma unroll
    for (int i = 0; i < 7; ++i) *(v4u*)(lds + (tid + 512 * i) * 16) = st[i];
    __syncthreads();
    for (int c = 0; c < 64; ++c) {
        const unsigned char* rec = rec0 + (size_t)c * CHUNK_REC;
        const unsigned char* buf = lds + (c & 1) * SBUF;
        if (c + 1 < 64) {
#pragma unroll
            for (int i = 0; i < 7; ++i) st[i] = *(const v4u*)(rec + CHUNK_REC + 16384 + (size_t)(tid + 512 * i) * 16);
        }
        const v4u u0 = *(const v4u*)(rec + (wid * 64 + lane) * 32), u1 = *(const v4u*)(rec + (wid * 64 + lane) * 32 + 16);
        const size_t tokb = (size_t)b * SEQL + c * 64;
        unsigned short zz[16];
#pragma unroll
        for (int T = 0; T < 4; ++T)
#pragma unroll
            for (int j = 0; j < 4; ++j) zz[4 * T + j] = proj[(tokb + 16 * T + 4 * g + j) * NINP + C_Z + h * 128 + 16 * wid + ln];
        const float dec = expf(glast[bh * 64 + c]);
        bf16x8 bS[4];
#pragma unroll
        for (int kk = 0; kk < 4; ++kk) bS[kk] = packS(S[2 * kk], S[2 * kk + 1]);
        f32x4 Vn[4];
#pragma unroll
        for (int T = 0; T < 4; ++T) {
            f32x4 p = (f32x4){0.f, 0.f, 0.f, 0.f};
#pragma unroll
            for (int kk = 0; kk < 4; ++kk) p = mfma16(ld16(buf + ((T * 4 + kk) * 64 + lane) * 16), bS[kk], p);
            const unsigned ua = (T < 2) ? u0[2 * T] : u1[2 * T - 4], ub = (T < 2) ? u0[2 * T + 1] : u1[2 * T - 3];
            Vn[T][0] = bf2f((unsigned short)(ua & 0xffffu)) - p[0]; Vn[T][1] = bf2f((unsigned short)(ua >> 16)) - p[1];
            Vn[T][2] = bf2f((unsigned short)(ub & 0xffffu)) - p[2]; Vn[T][3] = bf2f((unsigned short)(ub >> 16)) - p[3];
        }
        bf16x8 bV[2];
        bV[0] = packS(Vn[0], Vn[1]); bV[1] = packS(Vn[2], Vn[3]);
        f32x4 O[4];
#pragma unroll
        for (int T = 0; T < 4; ++T) {
            f32x4 a = (f32x4){0.f, 0.f, 0.f, 0.f};
#pragma unroll
            for (int kk = 0; kk < 4; ++kk) a = mfma16(ld16(buf + 16384 + ((T * 4 + kk) * 64 + lane) * 16), bS[kk], a);
#pragma unroll
            for (int kk = 0; kk < 2; ++kk) a = mfma16(ld16(buf + 32768 + ((T * 2 + kk) * 64 + lane) * 16), bV[kk], a);
            O[T] = a;
        }
#pragma unroll
        for (int T = 0; T < 8; ++T) {
            f32x4 a = S[T] * dec;
#pragma unroll
            for (int kk = 0; kk < 2; ++kk) a = mfma16(ld16(buf + 40960 + ((T * 2 + kk) * 64 + lane) * 16), bV[kk], a);
            S[T] = a;
        }
#pragma unroll
        for (int T = 0; T < 4; ++T)
#pragma unroll
            for (int j = 0; j < 4; ++j) { float s = O[T][j] * O[T][j]; s += __shfl_xor(s, 1); s += __shfl_xor(s, 2); s += __shfl_xor(s, 4); s += __shfl_xor(s, 8);
                if (ln == 0) red[wid * 64 + 16 * T + 4 * g + j] = s; }
        __syncthreads();
#pragma unroll
        for (int T = 0; T < 4; ++T)
#pragma unroll
            for (int j = 0; j < 4; ++j) { const int row = 16 * T + 4 * g + j; float tot = 0.f;
#pragma unroll
                for (int w = 0; w < 8; ++w) tot += red[w * 64 + row];
                const float rstd = rsqrtf(tot * (1.0f / 128.0f) + NORM_EPS);
                const float z = bf2f(zz[4 * T + j]);
                const float val = O[T][j] * rstd * ng * (z / (1.0f + expf(-z)));
                concat[(tokb + row) * DMODEL + h * 128 + 16 * wid + ln] = (bf16)f2bf(val); }
        if (c + 1 < 64) {
#pragma unroll
            for (int i = 0; i < 7; ++i) *(v4u*)(lds + ((c + 1) & 1) * SBUF + (tid + 512 * i) * 16) = st[i];
        }
        __syncthreads();
    }
}
}
struct Args { Ptrs p; int pad0, pad1; };
#define LP() (&args.p)
#define WSP(off) (LP()->ws + (off))
template <int l> __device__ __forceinline__ void layer_body(const Args& args, cg::grid_group& grid, unsigned char* lds, PG8_LAS unsigned char* ldsl, const int G) {
        { pg8::Gemm gm{(const bf16*)WSP(WS_XBF), (const bf16*)(WSP(WS_W) + (size_t)l * W_LAYER + W_IN), MTOK, NINP, DMODEL}; pg8::StaticOrder S; S.init(MTOK, NINP, G, (int)blockIdx.x);
          pg8::EpiBf16 E{(bf16*)WSP(WS_PROJ), NINP};
          pg8::gemm_phase<pg8::EpiBf16, pg8::StaticOrder, true, true>(ldsl, gm, S, E); }
        grid.sync();
        if (blockIdx.x == 0 && threadIdx.x == 0) ((unsigned*)WSP(WS_CTL))[64 + l] = 0u;
        for (int it = blockIdx.x; it < 2048; it += G) {
            const int n = it & 63, h = (it >> 6) & 3, b = it >> 8;
            const Ptrs* pp = LP();
            gdn::prep_item((const bf16*)(pp->ws + WS_PROJ), pp->ws + WS_GDN + (size_t)it * CHUNK_REC, (float*)(pp->ws + WS_GLAST) + it, pp->conv_w + (size_t)l * 4 * 1536, pp->a_log[l * 4 + h], pp->dt_bias[l * 4 + h], b, h, n, lds);
        }
        for (int it = blockIdx.x; it < 1024; it += G) moba_prep_item((bf16*)WSP(WS_PROJ), (float*)WSP(WS_KMEAN), it, lds);
        grid.sync();
        if (blockIdx.x < 32) { const Ptrs* pp = LP(); gdn::scan_bh((int)blockIdx.x, pp->ws + WS_GDN, (const float*)(pp->ws + WS_GLAST), (const bf16*)(pp->ws + WS_PROJ), (bf16*)(pp->ws + WS_XBF), pp->norm_g + l * 128, lds); }
        {
            volatile unsigned* sh_u = (volatile unsigned*)(lds + 90112);
            for (;;) {
                __syncthreads();
                if (threadIdx.x == 0) *sh_u = atomicAdd((unsigned*)WSP(WS_CTL) + 64 + l, 1u);
                __syncthreads();
                const unsigned u = (unsigned)__builtin_amdgcn_readfirstlane((int)*sh_u);
                if (u >= 1024u) break;
                const int qb = 15 - (int)(u >> 6), bh = (int)(u & 63u), b = bh >> 3, h = bh & 7;
                const bf16* proj = (const bf16*)WSP(WS_PROJ);
                moba_select(b, h, qb, proj, (const float*)WSP(WS_KMEAN) + (size_t)bh * 16 * 64, lds);
                __syncthreads();
                attn_body::attn_unit<8>(b, h, qb, (const attn_body::bf16*)(proj + C_QB), (const attn_body::bf16*)(proj + C_KB), (const attn_body::bf16*)(proj + C_VB),
                                        (attn_body::bf16*)((bf16*)WSP(WS_XBF) + 512), (char*)lds);
            }
        }
        grid.sync();
        { const Ptrs* pp = LP();
          pg8::Gemm gm{(const bf16*)(pp->ws + WS_XBF), (const bf16*)(pp->ws + WS_W + (size_t)l * W_LAYER + W_OUT), MTOK, DMODEL, DMODEL}; pg8::StaticOrder S; S.init(MTOK, DMODEL, G, (int)blockIdx.x);
          pg8::EpiResF32 E{(l == 0) ? pp->x : (const float*)pp->out, (float*)(pp->ws + WS_YX), DMODEL, ALPHA};
          pg8::gemm_phase<pg8::EpiResF32, pg8::StaticOrder, true, true>(ldsl, gm, S, E); }
        grid.sync();
        { const Ptrs* pp = LP(); ln_phase((const float*)(pp->ws + WS_YX), (float*)(pp->ws + WS_YX), (bf16*)(pp->ws + WS_XBF), pp->ln1_g + l * DMODEL, pp->ln1_b + l * DMODEL, G); }
        grid.sync();
        { const Ptrs* pp = LP();
          pg8::Gemm gm{(const bf16*)(pp->ws + WS_XBF), (const bf16*)(pp->ws + WS_W + (size_t)l * W_LAYER + W_UP), MTOK, NUP, DMODEL}; pg8::StaticOrder S; S.init(MTOK, NUP, G, (int)blockIdx.x);
          pg8::EpiUpConv E{(bf16*)(pp->ws + WS_ACT), (float*)(pp->ws + WS_EDGE), pp->fconv_w + (size_t)l * 3 * NUP, pp->fconv_b + (size_t)l * NUP};
          pg8::gemm_phase<pg8::EpiUpConv, pg8::StaticOrder, true, true>(ldsl, gm, S, E); }
        grid.sync();
        { const Ptrs* pp = LP(); fix_phase((const float*)(pp->ws + WS_EDGE), (bf16*)(pp->ws + WS_ACT), pp->fconv_w + (size_t)l * 3 * NUP, pp->fconv_b + (size_t)l * NUP, G); }
        grid.sync();
        { const Ptrs* pp = LP();
          pg8::Gemm gm{(const bf16*)(pp->ws + WS_ACT), (const bf16*)(pp->ws + WS_W + (size_t)l * W_LAYER + W_DOWN), MTOK, DMODEL, DFF}; pg8::StaticOrder S; S.init(MTOK, DMODEL, G, (int)blockIdx.x);
          pg8::EpiResF32 E{(const float*)(pp->ws + WS_YX), (float*)(pp->ws + WS_YX), DMODEL, ALPHA};
          pg8::gemm_phase<pg8::EpiResF32, pg8::StaticOrder, true, true>(ldsl, gm, S, E); }
        grid.sync();
        { const Ptrs* pp = LP(); ln_phase((const float*)(pp->ws + WS_YX), pp->out, (bf16*)(pp->ws + WS_XBF), pp->ln2_g + l * DMODEL, pp->ln2_b + l * DMODEL, G); }
        if (l + 1 < NLAYER) grid.sync();
}
__global__ void __launch_bounds__(NTHREADS, 2) hybrid_fwd(Args args) {
    extern __shared__ __attribute__((aligned(16))) unsigned char lds[];
    cg::grid_group grid = cg::this_grid();
    const int G = gridDim.x;
    PG8_LAS unsigned char* ldsl = (PG8_LAS unsigned char*)lds;

    { const Ptrs P = *LP(); p0_prologue(P, lds, G); }
    grid.sync();

    layer_body<0>(args, grid, lds, ldsl, G);
    layer_body<1>(args, grid, lds, ldsl, G);
}

extern "C" void kernel_launch(void* const* d_in, const int* in_sizes, int n_in, void* d_out, int out_size, void* d_ws, size_t ws_size, hipStream_t stream) {
    static int grid = 0;
    if (grid == 0) {
        if (n_in != 15 || ws_size < WS_END) { fprintf(stderr, "kernel_launch: unexpected inputs (n_in %d, ws %zu)\n", n_in, ws_size); grid = -1; return; }
        int dev = 0, cus = 0, per_cu = 0;
        hipGetDevice(&dev); hipDeviceGetAttribute(&cus, hipDeviceAttributeMultiprocessorCount, dev);
        if (hipFuncSetAttribute((const void*)hybrid_fwd, hipFuncAttributeMaxDynamicSharedMemorySize, LDS_BYTES) != hipSuccess) { fprintf(stderr, "kernel_launch: hipFuncSetAttribute failed\n"); grid = -1; return; }
        if (hipOccupancyMaxActiveBlocksPerMultiprocessor(&per_cu, (const void*)hybrid_fwd, NTHREADS, LDS_BYTES) != hipSuccess || per_cu < 1) { fprintf(stderr, "kernel_launch: occupancy query says %d\n", per_cu); per_cu = 1; }
        (void)hipGetLastError();
        grid = cus;
        if (grid < 64) grid = 64;
    }
    if (grid < 0) return;
    Args a{};
    const float* const* in = (const float* const*)d_in;
    a.p.x = in[0]; a.p.w_in = in[1]; a.p.conv_w = in[2]; a.p.a_log = in[3]; a.p.dt_bias = in[4]; a.p.norm_g = in[5]; a.p.w_out = in[6];
    a.p.ln1_g = in[7]; a.p.ln1_b = in[8]; a.p.w_up = in[9]; a.p.fconv_w = in[10]; a.p.fconv_b = in[11]; a.p.w_down = in[12]; a.p.ln2_g = in[13]; a.p.ln2_b = in[14];
    a.p.out = (float*)d_out; a.p.ws = (unsigned char*)d_ws;
    void* kargs[] = {&a};
    hipError_t e = hipLaunchCooperativeKernel((const void*)hybrid_fwd, dim3(grid), dim3(NTHREADS), kargs, LDS_BYTES, stream);
    if (e != hipSuccess) fprintf(stderr, "kernel_launch: cooperative launch failed: %s (grid %d)\n", hipGetErrorString(e), grid);
}
```

```cpp
#include <hip/hip_runtime.h>
#include <hip/hip_cooperative_groups.h>
#include <hip/hip_bf16.h>
#include <cstdio>
#include <cstdint>
#include <cmath>
namespace cg = cooperative_groups;
#ifndef PROBE_MASK
#define PROBE_MASK 0
#endif
__device__ __forceinline__ int opaque_tid() { int t = threadIdx.x; asm volatile("" : "+v"(t)); return t; }
namespace pg8 {
#define PG8_LAS __attribute__((address_space(3)))
typedef unsigned short bf16_t;
typedef short bf16x8 __attribute__((ext_vector_type(8)));
typedef float f32x4 __attribute__((ext_vector_type(4)));
typedef unsigned u32x4 __attribute__((ext_vector_type(4)));
constexpr int BM = 256, BK = 64, HALF = 128, HTB = HALF * BK * 2  , STAGE_BYTES = 8 * HTB, NXCD = 8, WGM = 8;

__host__ __device__ __forceinline__ int lds_byte(int r, int c) { const int st = (r >> 4) * 2 + (c >> 5), rr = r & 15, cc = c & 31, ob = rr * 64 + cc * 2; return st * 1024 + (ob ^ (((ob >> 9) & 1) << 5)); }
__host__ __device__ __forceinline__ void stage_rc(int b, int& R, int& C) { const int st = b / 1024, sb = b % 1024, swz = sb ^ (((sb >> 9) & 1) << 5); R = (st >> 1) * 16 + swz / 64; C = (st & 1) * 32 + (swz % 64) / 2; }
__host__ __device__ __forceinline__ int perm32(int rho) { const int n = rho >> 4, i = rho & 15; return 8 * (i >> 2) + 4 * n + (i & 3); }

struct Unit { int pm, pn; };
struct Gemm { const bf16_t* A; const bf16_t* Bt; int M, N, K; };

struct StaticOrder {
    int nM, nN, nwg, G, c;
    __host__ __device__ void init(int M, int N, int G_, int c_) { nM = M / BM; nN = N / BM; nwg = nM * nN; G = G_; c = c_; }
    __host__ __device__ bool next(int i, Unit& u) const {
        const long L = (long)i * G + c; if (L >= nwg) return false;
        int wgid = (int)L; { const int q = nwg / NXCD, r = nwg % NXCD, xcd = wgid % NXCD, off = wgid / NXCD; wgid = (xcd < r ? xcd * (q + 1) : r * (q + 1) + (xcd - r) * q) + off; }
        const int nig = WGM * nN, gid = wgid / nig, fm = gid * WGM, gsz = (nM - fm) < WGM ? (nM - fm) : WGM;
        u.pm = fm + ((wgid % nig) % gsz); u.pn = (wgid % nig) / gsz; return true;
    }
    __device__ __forceinline__ void a_ready(const Unit&) const {}
    __device__ __forceinline__ void done(const Unit&) const {}
};

__device__ __forceinline__ unsigned cvt_pk_bf16(float lo, float hi) { unsigned r; asm volatile("v_cvt_pk_bf16_f32 %0, %1, %2" : "=v"(r) : "v"(lo), "v"(hi)); return r; }
typedef float f32x2 __attribute__((ext_vector_type(2)));
typedef unsigned u32x2 __attribute__((ext_vector_type(2)));
struct EpiBf16 {
    static constexpr bool PERM = true, AFTER_DRAIN = false;
    bf16_t* O; int ldc;
    __device__ __forceinline__ void operator()(const f32x4 (&acc)[2][2][4][2], const Unit& u, int wr, int wc, int fr, int fq) const {
        const int row0 = u.pm * BM + wr * 64 + fr; const int col0 = u.pn * BM + wc * 32 + 8 * fq;
#pragma unroll
        for (int ai = 0; ai < 2; ++ai)
#pragma unroll
            for (int m = 0; m < 4; ++m) { bf16_t* rowp = O + (size_t)(row0 + ai * HALF + m * 16) * ldc + col0;
#pragma unroll
                for (int bj = 0; bj < 2; ++bj) { const f32x4 v0 = acc[ai][bj][m][0], v1 = acc[ai][bj][m][1];
                    u32x4 w; w.x = cvt_pk_bf16(v0[0], v0[1]); w.y = cvt_pk_bf16(v0[2], v0[3]); w.z = cvt_pk_bf16(v1[0], v1[1]); w.w = cvt_pk_bf16(v1[2], v1[3]);
                    *(u32x4*)(rowp + bj * HALF) = w; } }
    }
};
struct EpiResF32 {
    static constexpr bool PERM = false, AFTER_DRAIN = false;
    const float* res; float* out; int ldc; float alpha;
    __device__ __forceinline__ void operator()(const f32x4 (&acc)[2][2][4][2], const Unit& u, int wr, int wc, int fr, int fq) const {
        const int row0 = u.pm * BM + wr * 64 + fr; const int col0 = u.pn * BM + wc * 32 + 4 * fq;
#pragma unroll
        for (int ai = 0; ai < 2; ++ai)
#pragma unroll
            for (int m = 0; m < 4; ++m) { const size_t off = (size_t)(row0 + ai * HALF + m * 16) * ldc + col0;
                f32x4 rv[2][2];
#pragma unroll
                for (int bj = 0; bj < 2; ++bj)
#pragma unroll
                    for (int n = 0; n < 2; ++n) rv[bj][n] = *(const f32x4*)(res + off + bj * HALF + n * 16);
#pragma unroll
                for (int bj = 0; bj < 2; ++bj)
#pragma unroll
                    for (int n = 0; n < 2; ++n) *(f32x4*)(out + off + bj * HALF + n * 16) = rv[bj][n] * alpha + acc[ai][bj][m][n]; }
    }
};
__device__ __forceinline__ float dpp_ror1(float v) { return __builtin_bit_cast(float, __builtin_amdgcn_update_dpp(0, __builtin_bit_cast(int, v), 0x121, 0xf, 0xf, false)); }
__device__ __forceinline__ float dpp_ror2(float v) { return __builtin_bit_cast(float, __builtin_amdgcn_update_dpp(0, __builtin_bit_cast(int, v), 0x122, 0xf, 0xf, false)); }
__device__ __forceinline__ float silu_f(float x) { return x * __builtin_amdgcn_rcpf(1.0f + __expf(-x)); }
struct EpiUpConv {
    static constexpr bool PERM = true, AFTER_DRAIN = false;
    bf16_t* act; float* edge; const float* cw; const float* cb;
    __device__ __forceinline__ void operator()(const f32x4 (&acc)[2][2][4][2], const Unit& u, int wr, int wc, int fr, int fq) const {
        const int ch0 = u.pn * 128 + wc * 32 + 8 * fq;
#pragma unroll
        for (int n = 0; n < 2; ++n) {
            const int ch = ch0 + 4 * n;
            f32x4 w0[2], w1[2], w2[2], bb[2];
#pragma unroll
            for (int bj = 0; bj < 2; ++bj) { const int col = bj * 2816 + ch; w0[bj] = *(const f32x4*)(cw + col); w1[bj] = *(const f32x4*)(cw + 5632 + col); w2[bj] = *(const f32x4*)(cw + 2 * 5632 + col); bb[bj] = *(const f32x4*)(cb + col); }
#pragma unroll
            for (int ai = 0; ai < 2; ++ai) {
                const int slab = u.pm * 4 + ai * 2 + wr;
#pragma unroll
                for (int m = 0; m < 4; ++m) {
                    f32x4 hv[2];
#pragma unroll
                    for (int bj = 0; bj < 2; ++bj) {
                        const f32x4 cur = acc[ai][bj][m][n]; const f32x4 prv = acc[ai][bj][m > 0 ? m - 1 : 0][n];
                        f32x4 p1, p2;
#pragma unroll
                        for (int e = 0; e < 4; ++e) { const float s1 = (fr == 15) ? prv[e] : cur[e]; const float s2 = (fr >= 14) ? prv[e] : cur[e]; p1[e] = dpp_ror1(s1); p2[e] = dpp_ror2(s2); }
                        hv[bj] = w2[bj] * cur + w1[bj] * p1 + w0[bj] * p2 + bb[bj];
                        if (m == 0 && fr < 2) *(f32x4*)(edge + ((size_t)slab * 4 + fr) * 5632 + bj * 2816 + ch) = cur;
                        if (m == 3 && fr >= 14) *(f32x4*)(edge + ((size_t)slab * 4 + 2 + (fr - 14)) * 5632 + bj * 2816 + ch) = cur;
                    }
                    if (!(m == 0 && fr < 2)) {
                        const size_t row = (size_t)u.pm * BM + ai * HALF + wr * 64 + m * 16 + fr;
                        u32x2 o; o.x = cvt_pk_bf16(silu_f(hv[0][0]) * hv[1][0], silu_f(hv[0][1]) * hv[1][1]); o.y = cvt_pk_bf16(silu_f(hv[0][2]) * hv[1][2], silu_f(hv[0][3]) * hv[1][3]);
                        *(u32x2*)(act + row * 2816 + ch) = o;
                    }
                }
            }
        }
    }
};
template <class Epi, class Sched, bool ALIGN_EPI = false, bool SP2 = false>
__device__ __forceinline__ void gemm_phase(PG8_LAS unsigned char* lds, const Gemm g, const Sched& S, const Epi& E) {
    const int tid = opaque_tid(), wid = __builtin_amdgcn_readfirstlane(tid >> 6), lane = tid & 63, wr = wid >> 2, wc = wid & 3, fr = lane & 15, fq = lane >> 4;
    const int K = g.K, nt = K / BK;
    unsigned voffA[2], voffB[2];
#pragma unroll
    for (int i = 0; i < 2; ++i) { int R, C; stage_rc(tid * 16 + i * 8192, R, C); const int Rb = Epi::PERM ? ((R & ~31) + perm32(R & 31)) : R;
        voffA[i] = (unsigned)(R * K + C) * 2u; voffB[i] = (unsigned)(Rb * K + C) * 2u; }
    const size_t kstep = (size_t)(BK * 2);
    const size_t hstep = (size_t)HALF * K * 2;
    const size_t tstep = 2 * hstep;
    const unsigned ldsw = (unsigned)wid * 1024u;
    const int aoff = lds_byte(wr * 64 + fr, fq * 8), boff = lds_byte(wc * 32 + fr, fq * 8);
#define PG8_SA(b, h) (((b) * 2 + (h)) * HTB)
#define PG8_SB(b, h) ((4 + (b) * 2 + (h)) * HTB)
#define PG8_STAGE(bufoff, gbase, voff) do { _Pragma("unroll") for (int _i = 0; _i < 2; ++_i) \
        __builtin_amdgcn_global_load_lds((const unsigned*)((const char*)(gbase) + (voff)[_i]), (PG8_LAS unsigned*)(lds + (bufoff) + ldsw + _i * 8192), 16, 0, 0); } while (0)
#define PG8_LDA(dst, b, h) do { _Pragma("unroll") for (int m = 0; m < 4; ++m) _Pragma("unroll") for (int k = 0; k < 2; ++k) dst[m][k] = *(const PG8_LAS bf16x8*)(lds + PG8_SA(b, h) + aoff + m * 2048 + k * 1024); } while (0)
#define PG8_LDB(dst, b, h) do { _Pragma("unroll") for (int n = 0; n < 2; ++n) _Pragma("unroll") for (int k = 0; k < 2; ++k) dst[n][k] = *(const PG8_LAS bf16x8*)(lds + PG8_SB(b, h) + boff + n * 2048 + k * 1024); } while (0)
#define PG8_MMA(ai, bj, At, Bt) do { __builtin_amdgcn_s_setprio(1); _Pragma("unroll") for (int m = 0; m < 4; ++m) _Pragma("unroll") for (int n = 0; n < 2; ++n) _Pragma("unroll") for (int k = 0; k < 2; ++k) \
        acc[ai][bj][m][n] = __builtin_amdgcn_mfma_f32_16x16x32_bf16(Bt[n][k], At[m][k], acc[ai][bj][m][n], 0, 0, 0); __builtin_amdgcn_s_setprio(0); } while (0)
#define PG8_WAIT_V(n) asm volatile("s_waitcnt vmcnt(" #n ")" ::: "memory")
#define PG8_WAIT_L(n) asm volatile("s_waitcnt lgkmcnt(" #n ")" ::: "memory")
#define PG8_BAR __builtin_amdgcn_s_barrier()
#define PG8_SCHED __builtin_amdgcn_sched_barrier(0)
    Unit cur, nxt; int ui = 0;
    if (!S.next(0, cur)) return;
    f32x4 acc[2][2][4][2];
#pragma unroll
    for (int a = 0; a < 2; ++a)
#pragma unroll
        for (int b = 0; b < 2; ++b)
#pragma unroll
            for (int m = 0; m < 4; ++m)
#pragma unroll
                for (int n = 0; n < 2; ++n) acc[a][b][m][n] = (f32x4){0.f, 0.f, 0.f, 0.f};
    bf16x8 At[4][2], B0[2][2], B1[2][2];
    const char* cA = (const char*)g.A + (size_t)cur.pm * tstep; const char* cB = (const char*)g.Bt + (size_t)cur.pn * tstep;
    S.a_ready(cur);
    if constexpr (SP2) {
        PG8_STAGE(PG8_SB(0, 0), cB, voffB); PG8_STAGE(PG8_SB(0, 1), cB + hstep, voffB); PG8_STAGE(PG8_SA(0, 0), cA, voffA); PG8_STAGE(PG8_SA(0, 1), cA + hstep, voffA);
        if (wr == 1) PG8_BAR;
        PG8_WAIT_V(2); PG8_BAR;
        PG8_STAGE(PG8_SB(1, 0), cB + kstep, voffB); PG8_STAGE(PG8_SA(1, 0), cA + kstep, voffA); PG8_STAGE(PG8_SB(1, 1), cB + hstep + kstep, voffB);
        PG8_WAIT_V(6); PG8_BAR;
    } else {
        PG8_STAGE(PG8_SB(0, 0), cB, voffB); PG8_STAGE(PG8_SA(0, 0), cA, voffA); PG8_STAGE(PG8_SB(0, 1), cB + hstep, voffB); PG8_STAGE(PG8_SA(0, 1), cA + hstep, voffA);
        if (wr == 1) PG8_BAR;
        PG8_WAIT_V(4); PG8_BAR;
        PG8_STAGE(PG8_SB(1, 0), cB + kstep, voffB); PG8_STAGE(PG8_SA(1, 0), cA + kstep, voffA); PG8_STAGE(PG8_SB(1, 1), cB + hstep + kstep, voffB);
        PG8_WAIT_V(6); PG8_BAR;
    }
    for (;;) {
        const bool has_next = S.next(ui + 1, nxt);
        const char* nA = has_next ? (const char*)g.A + (size_t)nxt.pm * tstep : cA; const char* nB = has_next ? (const char*)g.Bt + (size_t)nxt.pn * tstep : cB;
        for (int t = 0; t < nt; t += 2) {
            const bool last = (t == nt - 2);
            const char* a1 = cA + (size_t)(t + 1) * kstep;
            const char* a2 = last ? nA : cA + (size_t)(t + 2) * kstep; const char* b2 = last ? nB : cB + (size_t)(t + 2) * kstep;
            const char* a3 = a2 + kstep; const char* b3 = b2 + kstep;
            if (last && has_next) S.a_ready(nxt);
            if constexpr (SP2) {
            PG8_LDB(B0, 0, 0); PG8_LDB(B1, 0, 1); PG8_SCHED; PG8_LDA(At, 0, 0); PG8_STAGE(PG8_SA(1, 1), a1 + hstep, voffA);
            PG8_WAIT_V(8); PG8_WAIT_L(0); PG8_BAR; PG8_MMA(0, 0, At, B0); PG8_MMA(0, 1, At, B1); PG8_BAR; PG8_SCHED;
            PG8_LDA(At, 0, 1); PG8_STAGE(PG8_SB(0, 0), b2, voffB); PG8_STAGE(PG8_SB(0, 1), b2 + hstep, voffB); PG8_STAGE(PG8_SA(0, 0), a2, voffA);
            PG8_WAIT_V(8); PG8_WAIT_L(0); PG8_BAR; PG8_MMA(1, 0, At, B0); PG8_MMA(1, 1, At, B1); PG8_BAR; PG8_SCHED;
            PG8_LDB(B0, 1, 0); PG8_LDB(B1, 1, 1); PG8_SCHED; PG8_LDA(At, 1, 0); PG8_STAGE(PG8_SA(0, 1), a2 + hstep, voffA);
            PG8_WAIT_V(8); PG8_WAIT_L(0); PG8_BAR; PG8_MMA(0, 0, At, B0); PG8_MMA(0, 1, At, B1); PG8_BAR; PG8_SCHED;
            PG8_LDA(At, 1, 1); PG8_STAGE(PG8_SB(1, 0), b3, voffB); PG8_STAGE(PG8_SB(1, 1), b3 + hstep, voffB); PG8_STAGE(PG8_SA(1, 0), a3, voffA);
            PG8_WAIT_V(8); PG8_WAIT_L(0); PG8_BAR; PG8_MMA(1, 0, At, B0); PG8_MMA(1, 1, At, B1); PG8_BAR; PG8_SCHED;
            } else {
            PG8_LDB(B0, 0, 0); PG8_SCHED; PG8_LDA(At, 0, 0); PG8_STAGE(PG8_SA(1, 1), a1 + hstep, voffA);
            PG8_WAIT_L(8); PG8_BAR; PG8_WAIT_L(0); PG8_MMA(0, 0, At, B0); PG8_BAR; PG8_SCHED;
            PG8_LDB(B1, 0, 1); PG8_STAGE(PG8_SB(0, 0), b2, voffB);
            PG8_BAR; PG8_WAIT_L(0); PG8_MMA(0, 1, At, B1); PG8_BAR;
            PG8_LDA(At, 0, 1); PG8_STAGE(PG8_SA(0, 0), a2, voffA);
            PG8_BAR; PG8_WAIT_L(0); PG8_MMA(1, 0, At, B0); PG8_BAR; PG8_SCHED;
            PG8_STAGE(PG8_SB(0, 1), b2 + hstep, voffB);
            PG8_WAIT_V(6); PG8_BAR; PG8_MMA(1, 1, At, B1); PG8_BAR;
            PG8_LDB(B0, 1, 0); PG8_SCHED; PG8_LDA(At, 1, 0); PG8_STAGE(PG8_SA(0, 1), a2 + hstep, voffA);
            PG8_WAIT_L(8); PG8_BAR; PG8_WAIT_L(0); PG8_MMA(0, 0, At, B0); PG8_BAR; PG8_SCHED;
            PG8_LDB(B1, 1, 1); PG8_STAGE(PG8_SB(1, 0), b3, voffB);
            PG8_BAR; PG8_WAIT_L(0); PG8_MMA(0, 1, At, B1); PG8_BAR;
            PG8_LDA(At, 1, 1); PG8_STAGE(PG8_SA(1, 0), a3, voffA);
            PG8_BAR; PG8_WAIT_L(0); PG8_MMA(1, 0, At, B0); PG8_BAR; PG8_SCHED;
            PG8_STAGE(PG8_SB(1, 1), b3 + hstep, voffB);
            PG8_WAIT_V(6); PG8_BAR; PG8_MMA(1, 1, At, B1); PG8_BAR;
            }
        }
        if constexpr (ALIGN_EPI) { if (wr == 0) PG8_BAR; }
        if constexpr (!Epi::AFTER_DRAIN) { E(acc, cur, wr, wc, fr, fq); S.done(cur); }
        if (!has_next) break;
#pragma unroll
        for (int a = 0; a < 2; ++a)
#pragma unroll
            for (int b = 0; b < 2; ++b)
#pragma unroll
                for (int m = 0; m < 4; ++m)
#pragma unroll
                    for (int n = 0; n < 2; ++n) acc[a][b][m][n] = (f32x4){0.f, 0.f, 0.f, 0.f};
        cur = nxt; cA = nA; cB = nB; ++ui;
        if constexpr (ALIGN_EPI) { if (wr == 1) PG8_BAR; }
    }
    PG8_WAIT_V(0);
    if constexpr (!ALIGN_EPI) { if (wr == 0) PG8_BAR; }
    PG8_BAR;
    if constexpr (Epi::AFTER_DRAIN) { E.fused(acc, cur, wr, wc, fr, fq, lds, wid, lane); S.done(cur); }
#undef PG8_SA
#undef PG8_SB
#undef PG8_STAGE
#undef PG8_LDA
#undef PG8_LDB
#undef PG8_MMA
#undef PG8_WAIT_V
#undef PG8_WAIT_L
#undef PG8_BAR
#undef PG8_SCHED
}
}
#include <hip/hip_bf16.h>
#include <cmath>
namespace attn_body {
using bf16=__hip_bfloat16;
using bf16x8=__attribute__((ext_vector_type(8)))short;
using s16x4=__attribute__((ext_vector_type(4)))short;
using f32x16=__attribute__((ext_vector_type(16)))float;
using u32x4=__attribute__((ext_vector_type(4)))unsigned;
constexpr int BATCH=8,NHEAD=8,SEQ=4096,D=64,PQ=3840,PO=1024;
constexpr int NW=8,QBLK=32,QB=QBLK*NW,KVBLK=64,NQB=SEQ/QB;
constexpr int ATTN_UNIT_ROWS=QB;
__device__ __forceinline__ int crow(int r,int hi){return (r&3)+8*(r>>2)+4*hi;}
#define SBAR() __builtin_amdgcn_sched_barrier(0)
__device__ __forceinline__ void cmask(f32x16&p0,f32x16&p1,int jb,int qrel,int hi){
  const float NEG=-INFINITY; int kb=64*jb+4*hi;
  #pragma unroll
  for(int r=0;r<16;++r){int kv=kb+(r&3)+8*(r>>2); if(kv>qrel)p0[r]=NEG; if(kv+32>qrel)p1[r]=NEG;}
}

constexpr int NSLOT=3, SLOTB=8192, SEL_OFF=90112+64;
constexpr int LDS_K=0, LDS_V=NSLOT*SLOTB, LDS_WS=2*NSLOT*SLOTB, LDS_OST=LDS_WS+NW*64*4, LDS_BYTES=LDS_OST+NW*4096;
constexpr float C2=0.125f*1.4426950408889634f;
__device__ __forceinline__ void glds16(const void*gsrc,unsigned lds_dst){unsigned keep;
  asm volatile("s_mov_b32 %0, m0\n\ts_mov_b32 m0, %2\n\ts_nop 0\n\tglobal_load_lds_dwordx4 %1, off\n\ts_mov_b32 m0, %0":"=&s"(keep):"v"(gsrc),"s"(lds_dst):"memory");}
__device__ __forceinline__ float max3f(float a,float b,float c){float r;asm("v_max3_f32 %0, %1, %2, %3":"=v"(r):"v"(a),"v"(b),"v"(c));return r;}
__device__ __forceinline__ float max2f(float a,float b){float r;asm("v_max_f32_e32 %0, %1, %2":"=v"(r):"v"(a),"v"(b));return r;}
__device__ __forceinline__ float fadd_s(float a,float b){float r;asm("v_add_f32_e32 %0, %1, %2":"=v"(r):"v"(a),"v"(b));return r;}
__device__ __forceinline__ float fsub_s(float a,float b){float r;asm("v_sub_f32_e32 %0, %1, %2":"=v"(r):"v"(a),"v"(b));return r;}
typedef float f32x2_t __attribute__((ext_vector_type(2))); typedef __bf16 bf16x2_t __attribute__((ext_vector_type(2)));
__device__ __forceinline__ unsigned cvtpk_s(float lo,float hi){f32x2_t v={lo,hi};bf16x2_t b=__builtin_convertvector(v,bf16x2_t);return __builtin_bit_cast(unsigned,b);}
#define WAIT_BAR(N) asm volatile("s_waitcnt vmcnt(" #N ") lgkmcnt(0)\n\ts_barrier":::"memory")

__device__ __forceinline__ void qkt(f32x16&p0,f32x16&p1,const char*Kslot,const bf16x8*qr,const f32x16&negm,int r32,int hi){
  const char*kb=Kslot+hi*1024+r32*16;
  #pragma unroll
  for(int d0=0;d0<4;++d0){
    const bf16x8 b0=*reinterpret_cast<const bf16x8*>(kb+d0*2048);
    const bf16x8 b1=*reinterpret_cast<const bf16x8*>(kb+d0*2048+512);
    if(d0==0){p0=__builtin_amdgcn_mfma_f32_32x32x16_bf16(b0,qr[0],negm,0,0,0);p1=__builtin_amdgcn_mfma_f32_32x32x16_bf16(b1,qr[0],negm,0,0,0);}
    else{p0=__builtin_amdgcn_mfma_f32_32x32x16_bf16(b0,qr[d0],p0,0,0,0);p1=__builtin_amdgcn_mfma_f32_32x32x16_bf16(b1,qr[d0],p1,0,0,0);}}
}
typedef __attribute__((address_space(3))) const char* lds_cptr;
typedef short v4i16_t __attribute__((ext_vector_type(4)));
__device__ __forceinline__ void kload8(bf16x8*kf,lds_cptr kp){
  kf[0]=*(const __attribute__((address_space(3))) bf16x8*)(kp);      kf[1]=*(const __attribute__((address_space(3))) bf16x8*)(kp+512);
  kf[2]=*(const __attribute__((address_space(3))) bf16x8*)(kp+2048); kf[3]=*(const __attribute__((address_space(3))) bf16x8*)(kp+2560);
  kf[4]=*(const __attribute__((address_space(3))) bf16x8*)(kp+4096); kf[5]=*(const __attribute__((address_space(3))) bf16x8*)(kp+4608);
  kf[6]=*(const __attribute__((address_space(3))) bf16x8*)(kp+6144); kf[7]=*(const __attribute__((address_space(3))) bf16x8*)(kp+6656);
}
__device__ __forceinline__ void kload2(bf16x8*kf,lds_cptr kp,int j){ kf[2*j]=*(const __attribute__((address_space(3))) bf16x8*)(kp+j*2048); kf[2*j+1]=*(const __attribute__((address_space(3))) bf16x8*)(kp+j*2048+512); }
__device__ __forceinline__ s16x4 vtr(lds_cptr p){ return __builtin_bit_cast(s16x4,__builtin_amdgcn_ds_read_tr16_b64_v4i16((__attribute__((address_space(3))) v4i16_t*)p)); }
__device__ __forceinline__ float rowmax(const f32x16&p0,const f32x16&p1){
  float a=max3f(p0[0],p0[1],p1[0]),b=max3f(p0[2],p0[3],p1[1]);a=max3f(a,p1[2],p1[3]);
  #pragma unroll
  for(int r=4;r<16;r+=4){a=max3f(a,p0[r],p0[r+1]);b=max3f(b,p0[r+2],p0[r+3]);a=max3f(a,p1[r],p1[r+1]);b=max3f(b,p1[r+2],p1[r+3]);}
  const float m=max2f(a,b);
  auto rr=__builtin_amdgcn_permlane32_swap(__float_as_uint(m),__float_as_uint(m),false,false);
  return max2f(__uint_as_float(rr[0]),__uint_as_float(rr[1]));
}
__device__ __forceinline__ void pv(f32x16*o,int vb,bf16x8 pa0,bf16x8 pa1,bf16x8 pa2,bf16x8 pa3){
  #pragma unroll
  for(int d0=0;d0<2;++d0){s16x4 lo[4],hi[4];
    #pragma unroll
    for(int ks=0;ks<4;++ks){
      asm volatile("ds_read_b64_tr_b16 %0,%1 offset:%c2":"=&v"(lo[ks]):"v"(vb),"i"(d0*4096+ks*1024):"memory");
      asm volatile("ds_read_b64_tr_b16 %0,%1 offset:%c2":"=&v"(hi[ks]):"v"(vb),"i"(d0*4096+ks*1024+512):"memory");}
    asm volatile("s_waitcnt lgkmcnt(0)":::"memory");SBAR();
    #define PK(k) (bf16x8){lo[k][0],lo[k][1],lo[k][2],lo[k][3],hi[k][0],hi[k][1],hi[k][2],hi[k][3]}
    o[d0]=__builtin_amdgcn_mfma_f32_32x32x16_bf16(pa0,PK(0),o[d0],0,0,0);
    o[d0]=__builtin_amdgcn_mfma_f32_32x32x16_bf16(pa1,PK(1),o[d0],0,0,0);
    o[d0]=__builtin_amdgcn_mfma_f32_32x32x16_bf16(pa2,PK(2),o[d0],0,0,0);
    o[d0]=__builtin_amdgcn_mfma_f32_32x32x16_bf16(pa3,PK(3),o[d0],0,0,0);
    #undef PK
  }
}

#ifndef ATTN_STORE16
#define ATTN_STORE16(p,v) (*(u32x4*)(p)=(v))
#endif
template<int THRL> __device__ __forceinline__ void attn_unit(int b,int h,int qb,const bf16*Q,const bf16*__restrict__ K,const bf16*__restrict__ V,bf16*O,char*shm){
  const int tid=opaque_tid(),lane=tid&63,r32=lane&31,hi=lane>>5; const int wid=__builtin_amdgcn_readfirstlane(tid>>6);
  const long rowbase=(long)b*SEQ; const int q0=qb*QB;
  const bf16*Qw=Q+(rowbase+q0+wid*QBLK)*PQ+h*D;
  const bf16*Kh=K+rowbase*PQ+h*D,*Vh=V+rowbase*PQ+h*D;
  const unsigned lds0=(unsigned)(uintptr_t)shm;
  float*wsf=(float*)(shm+LDS_WS)+wid*64;
  const bf16*ksrc=Kh+(long)lane*PQ+wid*8;
  const bf16*vsrc=Vh+(long)(16*(wid&3)+(lane>>2))*PQ+(wid>>2)*32+(lane&3)*8;
  const unsigned kdst=lds0+LDS_K+wid*1024, vdst=lds0+LDS_V+wid*1024;
  #define KT(t) (((t)<4)?(NT-4+(t)):((t)-4))
  #define DMA_K(t,slot) glds16(ksrc+(long)KT(t)*KVBLK*PQ,(unsigned)__builtin_amdgcn_readfirstlane(kdst+(slot)))
  #define DMA_V(t,slot) glds16(vsrc+(long)KT(t)*KVBLK*PQ,(unsigned)__builtin_amdgcn_readfirstlane(vdst+(slot)))
  const int vb0=(int)(lds0+LDS_V)+((lane>>4)&1)*32+(lane&3)*8+(4*hi+((lane&15)>>2))*64;
  const char*Kbase=shm+LDS_K; bf16x8 kf[8];
  const lds_cptr shm3=(lds_cptr)shm; const lds_cptr kp0=shm3+LDS_K+hi*1024+r32*16; const lds_cptr vp0=shm3+LDS_V+((lane>>4)&1)*32+(lane&3)*8+(4*hi+((lane&15)>>2))*64;
  const int NT=(q0+QB)/KVBLK;
  DMA_K(0,0);DMA_V(0,0);DMA_K(1,SLOTB);
  bf16x8 qr[4];
  #pragma unroll
  for(int d0=0;d0<4;++d0)qr[d0]=*reinterpret_cast<const bf16x8*>(&Qw[(long)r32*PQ+d0*16+hi*8]);
  const unsigned selmask=((const unsigned*)(shm+SEL_OFF))[wid*QBLK+r32];
  float mhat=0.f,l_reg=0.f;f32x16 o[2];o[0]=f32x16{};o[1]=f32x16{};const f32x16 negm=f32x16{};
  const int qrel=wid*QBLK+r32;
  #define CMASK(P0,P1,t) do{const int t_=(t); if(t_<4){cmask(P0,P1,t_,qrel,hi);} else if(!((selmask>>((t_-4)>>2))&1u)){ _Pragma("unroll") for(int r_=0;r_<16;++r_){P0[r_]=-INFINITY;P1[r_]=-INFINITY;} } }while(0)
  bool resc=false;
  #define START(P0,P1) do{ const float rm=rowmax(P0,P1); resc=false; \
    { const float dl=rm; mhat=fadd_s(mhat,dl); \
      _Pragma("unroll") for(int r=0;r<16;++r){P0[r]=fsub_s(P0[r],dl);P1[r]=fsub_s(P1[r],dl);} \
      } \
    _Pragma("unroll") for(int r=0;r<16;++r)P0[r]=__builtin_amdgcn_exp2f(P0[r]); }while(0)
  #define RESC() do{ if(resc){ asm volatile("s_waitcnt lgkmcnt(0)":::"memory"); \
      _Pragma("unroll") for(int d_=0;d_<2;++d_) _Pragma("unroll") for(int r=0;r<16;++r)o[d_][r]*=wsf[crow(r,hi)]; } }while(0)
  f32x16 pA0,pA1,pB0,pB1;
  int sl_prev=0,sl_cur=0,sl_next=SLOTB;
  #define ROT() do{sl_prev=sl_cur;sl_cur=sl_next;sl_next=(sl_next==(NSLOT-1)*SLOTB)?0:sl_next+SLOTB;}while(0)
  DMA_K(2,2*SLOTB);
  WAIT_BAR(3);
  qkt(pA0,pA1,Kbase,qr,negm,r32,hi);asm volatile("s_nop 15\n\ts_nop 7":"+v"(pA0),"+v"(pA1));CMASK(pA0,pA1,0);
  START(pA0,pA1);
  _Pragma("unroll") for(int r=0;r<16;++r)pA1[r]=__builtin_amdgcn_exp2f(pA1[r]);
  WAIT_BAR(0);
  DMA_K(3,0);DMA_V(1,SLOTB);
  ROT();
  kload8(kf,kp0+sl_cur);
  WAIT_BAR(2);
  s16x4 vlo[8],vhi[8]; u32x4 pw0,pw1,pw2,pw3;
  #define PKW(P,B) cvtpk_s(P[B],P[B+1])
  #define PAF(k) __builtin_bit_cast(bf16x8,pw##k)
  #define VFR(i) (bf16x8){vlo[i][0],vlo[i][1],vlo[i][2],vlo[i][3],vhi[i][0],vhi[i][1],vhi[i][2],vhi[i][3]}
  #define PIN(x) asm volatile("":"+v"(x))
  #define MX3(a,b,c) __builtin_fmaxf(__builtin_fmaxf((a),(b)),(c))
  #define GAPA(MF,A0,A1,A2,A3,W0,W1,PW) do{ MF; sacc+=A0; sacc+=A1; sacc+=A2; sacc+=A3; PIN(sacc); W0; W1; PIN(PW); SBAR(); }while(0)
  #define EX(v) __builtin_amdgcn_exp2f(v)
  #define GAPB(MF,X,B) do{ MF; X[B]=EX(X[B]); X[B+1]=EX(X[B+1]); X[B+2]=EX(X[B+2]); X[B+3]=EX(X[B+3]); PIN(X); SBAR(); }while(0)
  #define VRD(i) do{ vlo[i]=vtr(vp_+(((i)>>2)*4096+((i)&3)*1024)); vhi[i]=vtr(vp_+(((i)>>2)*4096+((i)&3)*1024+512)); }while(0)
  #define KRD(G,j) do{ if(G){ kload2(kf,kp0+sl_next,j); SBAR(); } }while(0)
  #define STEP(C0,C1,P0,P1,t,GK,GV,GL) do{ SBAR(); \
    const lds_cptr vp_=vp0+sl_prev; \
    VRD(0); SBAR(); float sacc=(P0[0]+P0[1]); \
    GAPA(C0=__builtin_amdgcn_mfma_f32_32x32x16_bf16(kf[0],qr[0],negm,0,0,0), P0[2],P0[3],P0[4],P0[5],     pw0[0]=PKW(P0,0), pw0[1]=PKW(P0,2), pw0); \
    VRD(4); SBAR(); GAPA(C1=__builtin_amdgcn_mfma_f32_32x32x16_bf16(kf[1],qr[0],negm,0,0,0), P0[6],P0[7],P0[8],P0[9],     pw0[2]=PKW(P0,4), pw0[3]=PKW(P0,6), pw0); \
    VRD(1); SBAR(); GAPA(C0=__builtin_amdgcn_mfma_f32_32x32x16_bf16(kf[2],qr[1],C0,0,0,0),   P0[10],P0[11],P0[12],P0[13], pw1[0]=PKW(P0,8), pw1[1]=PKW(P0,10), pw1); \
    VRD(5); SBAR(); GAPA(C1=__builtin_amdgcn_mfma_f32_32x32x16_bf16(kf[3],qr[1],C1,0,0,0),   P0[14],P0[15],P1[0],P1[1],   pw1[2]=PKW(P0,12),pw1[3]=PKW(P0,14), pw1); \
    VRD(2); SBAR(); GAPA(C0=__builtin_amdgcn_mfma_f32_32x32x16_bf16(kf[4],qr[2],C0,0,0,0),   P1[2],P1[3],P1[4],P1[5],     pw2[0]=PKW(P1,0), pw2[1]=PKW(P1,2), pw2); \
    VRD(6); SBAR(); GAPA(C1=__builtin_amdgcn_mfma_f32_32x32x16_bf16(kf[5],qr[2],C1,0,0,0),   P1[6],P1[7],P1[8],P1[9],     pw2[2]=PKW(P1,4), pw2[3]=PKW(P1,6), pw2); \
    VRD(3); SBAR(); GAPA(C0=__builtin_amdgcn_mfma_f32_32x32x16_bf16(kf[6],qr[3],C0,0,0,0),   P1[10],P1[11],P1[12],P1[13], pw3[0]=PKW(P1,8), pw3[1]=PKW(P1,10), pw3); \
    VRD(7); SBAR(); GAPA(C1=__builtin_amdgcn_mfma_f32_32x32x16_bf16(kf[7],qr[3],C1,0,0,0),   P1[14],P1[15],0.f,0.f,       pw3[2]=PKW(P1,12),pw3[3]=PKW(P1,14), pw3); \
    l_reg+=sacc; \
    _Pragma("unroll") for(int r=0;r<16;++r){C0[r]-=mhat;C1[r]-=mhat;} \
    if(GK){DMA_K((t)+3,sl_cur);} if(GV){DMA_V((t)+1,sl_next);} \
    CMASK(C0,C1,t); \
    { float a=MX3(C0[0],C0[1],C1[0]),b=MX3(C0[2],C0[3],C1[1]); a=MX3(a,C1[2],C1[3]); \
      _Pragma("unroll") for(int r=4;r<16;r+=4){a=MX3(a,C0[r],C0[r+1]);b=MX3(b,C0[r+2],C0[r+3]);a=MX3(a,C1[r],C1[r+1]);b=MX3(b,C1[r+2],C1[r+3]);} \
      float rm=__builtin_fmaxf(a,b); { auto rr=__builtin_amdgcn_permlane32_swap(__float_as_uint(rm),__float_as_uint(rm),false,false); rm=__builtin_fmaxf(__uint_as_float(rr[0]),__uint_as_float(rr[1])); } \
      resc=false; \
      if(__builtin_expect(__any(rm>(float)THRL),0)){ const float dl=__builtin_fmaxf(rm,0.f); mhat+=dl; \
        _Pragma("unroll") for(int r=0;r<16;++r){C0[r]-=dl;C1[r]-=dl;} \
        const float f=__builtin_amdgcn_exp2f(-dl); l_reg*=f; if(hi==0)wsf[r32]=f; resc=true; } } \
    SBAR(); \
    GAPB(o[0]=__builtin_amdgcn_mfma_f32_32x32x16_bf16(PAF(0),VFR(0),o[0],0,0,0), C0,0); \
    GAPB(o[1]=__builtin_amdgcn_mfma_f32_32x32x16_bf16(PAF(0),VFR(4),o[1],0,0,0), C0,4); \
    KRD(GL,0); GAPB(o[0]=__builtin_amdgcn_mfma_f32_32x32x16_bf16(PAF(1),VFR(1),o[0],0,0,0), C0,8); \
    KRD(GL,1); GAPB(o[1]=__builtin_amdgcn_mfma_f32_32x32x16_bf16(PAF(1),VFR(5),o[1],0,0,0), C0,12); \
    KRD(GL,2); GAPB(o[0]=__builtin_amdgcn_mfma_f32_32x32x16_bf16(PAF(2),VFR(2),o[0],0,0,0), C1,0); \
    KRD(GL,3); GAPB(o[1]=__builtin_amdgcn_mfma_f32_32x32x16_bf16(PAF(2),VFR(6),o[1],0,0,0), C1,4); \
    GAPB(o[0]=__builtin_amdgcn_mfma_f32_32x32x16_bf16(PAF(3),VFR(3),o[0],0,0,0), C1,8); \
    GAPB(o[1]=__builtin_amdgcn_mfma_f32_32x32x16_bf16(PAF(3),VFR(7),o[1],0,0,0), C1,12); \
    }while(0)
  int t=1;
  for(;t+5<NT;t+=2){
    STEP(pB0,pB1,pA0,pA1,t,true,true,true);     WAIT_BAR(2); RESC(); ROT();
    STEP(pA0,pA1,pB0,pB1,t+1,true,true,true);   WAIT_BAR(2); RESC(); ROT();
  }
  #define ENDW(tt) do{ if((tt)+3<NT){WAIT_BAR(2);} else if((tt)+2<NT){WAIT_BAR(1);} else {WAIT_BAR(0);} }while(0)
  for(;t+1<NT;t+=2){
    STEP(pB0,pB1,pA0,pA1,t,(t+3<NT),(t+1<NT),(t+1<NT));       ENDW(t);   RESC(); ROT();
    STEP(pA0,pA1,pB0,pB1,t+1,(t+4<NT),(t+2<NT),(t+2<NT));     ENDW(t+1); RESC(); ROT();
  }
  STEP(pB0,pB1,pA0,pA1,NT-1,false,false,false); RESC();
  { float sacc=pB0[0]+pB0[1]; _Pragma("unroll") for(int r=2;r<16;++r)sacc+=pB0[r]; _Pragma("unroll") for(int r=0;r<16;++r)sacc+=pB1[r]; l_reg+=sacc;
    pw0=(u32x4){PKW(pB0,0),PKW(pB0,2),PKW(pB0,4),PKW(pB0,6)};pw1=(u32x4){PKW(pB0,8),PKW(pB0,10),PKW(pB0,12),PKW(pB0,14)};pw2=(u32x4){PKW(pB1,0),PKW(pB1,2),PKW(pB1,4),PKW(pB1,6)};pw3=(u32x4){PKW(pB1,8),PKW(pB1,10),PKW(pB1,12),PKW(pB1,14)};
    SBAR(); pv(o,vb0+sl_cur,PAF(0),PAF(1),PAF(2),PAF(3)); }
  #undef PKW
  #undef PAF
  #undef VFR
  #undef PIN
  #undef MX3
  #undef GAPA
  #undef GAPB
  #undef EX
  #undef VRD
  #undef KRD
  #undef STEP
  #undef ENDW
  {auto rr=__builtin_amdgcn_permlane32_swap(__float_as_uint(l_reg),__float_as_uint(l_reg),false,false);l_reg=__uint_as_float(rr[0])+__uint_as_float(rr[1]);}
  if(hi==0)wsf[32+r32]=l_reg;asm volatile("s_waitcnt lgkmcnt(0)":::"memory");
  float rli[16];
  #pragma unroll
  for(int r=0;r<16;++r)rli[r]=__builtin_amdgcn_rcpf(wsf[32+crow(r,hi)]);
  bf16*Ow=O+(rowbase+q0+wid*QBLK)*PO+h*D;
  { bf16*stg=(bf16*)(shm+LDS_OST)+wid*2048;
    #pragma unroll
    for(int r=0;r<16;++r){const int orow=crow(r,hi);
      #pragma unroll
      for(int d0=0;d0<2;++d0)stg[orow*64+d0*32+r32]=__float2bfloat16(o[d0][r]*rli[r]);}
    asm volatile("s_waitcnt lgkmcnt(0)":::"memory");
    #pragma unroll
    for(int i=0;i<4;++i){const int row=i*8+(lane>>3),ch=lane&7; const u32x4 v=*(const u32x4*)(stg+row*64+ch*8); ATTN_STORE16(Ow+(long)row*PO+ch*8,v);} }
  asm volatile("s_waitcnt lgkmcnt(0)\n\ts_barrier":::"memory");
  #undef DMA_K
  #undef KT
  #undef DMA_V
  #undef CMASK
  #undef START
  #undef RESC
  #undef ROT
}
constexpr int ATTN_LDS_BYTES=LDS_BYTES;
struct AttnTensors { const bf16* Q; const bf16* K; const bf16* V; bf16* O; };
#undef SBAR
#undef WAIT_BAR
}
typedef unsigned short bf16;
typedef unsigned v4u __attribute__((ext_vector_type(4)));
typedef unsigned v2u __attribute__((ext_vector_type(2)));
typedef float f32x4 __attribute__((ext_vector_type(4)));
typedef short bf16x8 __attribute__((ext_vector_type(8)));
constexpr int NB = 8, SEQL = 4096, DMODEL = 1024, NLAYER = 2, MTOK = NB * SEQL;
constexpr int NIN = 3592, NINP = 3840, DFF = 2816, NUP = 5632;
constexpr int C_QA = 0, C_KA = 512, C_VA = 1024, C_Z = 1536, C_QB = 2048, C_KB = 2560, C_VB = 3072, C_AL = 3584, C_BL = 3588;
constexpr float ALPHA = 1.4142135623730951f, LN_EPS = 1e-5f, NORM_EPS = 1e-6f;
constexpr size_t MiB = 1u << 20;
constexpr size_t WS_CTL = 0, WS_KMEAN = 256 * 1024, WS_GLAST = 512 * 1024;
constexpr size_t WS_W = 1 * MiB, W_LAYER = 26 * MiB, W_IN = 0, W_OUT = 7864320, W_UP = W_OUT + 2 * MiB, W_DOWN = W_UP + 11 * MiB;
constexpr size_t WS_XBF = 53 * MiB;
constexpr size_t WS_PROJ = 117 * MiB;
constexpr size_t WS_GDN = 357 * MiB;
constexpr size_t WS_YX = WS_PROJ;
constexpr size_t WS_ACT = 245 * MiB;
constexpr size_t WS_EDGE = 421 * MiB;
constexpr size_t WS_END = 501 * MiB;
constexpr int CHUNK_REC = 73728;
constexpr int LDS_BYTES = 155648;
constexpr int NTHREADS = 512;

__device__ __forceinline__ float bf2f(unsigned short u) { return __uint_as_float(((unsigned)u) << 16); }
__device__ __forceinline__ unsigned f2bf(float f) { unsigned u = __float_as_uint(f); return (u + 0x7fffu + ((u >> 16) & 1u)) >> 16; }
__device__ __forceinline__ unsigned pk2(float lo, float hi) { return f2bf(lo) | (f2bf(hi) << 16); }
__device__ __forceinline__ float wave_sum(float v) {
#pragma unroll
    for (int o = 1; o < 64; o <<= 1) v += __shfl_xor(v, o);
    return v;
}
__device__ __forceinline__ f32x4 mfma16(bf16x8 a, bf16x8 b, f32x4 c) { return __builtin_amdgcn_mfma_f32_16x16x32_bf16(a, b, c, 0, 0, 0); }

template <int MAPID> __device__ __forceinline__ int wmap(int n) {
    if (MAPID == 0) return n;
    if (MAPID == 1) { if (n < 1536) return n; if (n < 3584) return n + 8; if (n < 3592) return n - 3584 + 1536; return -1; }
    { const int pn = n >> 8, rem = n & 255; return (rem >> 7) * DFF + pn * 128 + (rem & 127); }
}
template <int MAPID> __device__ __forceinline__ void transpose_item(const float* W, int K, int N, int NP, bf16* WT, float* scr, int item, int lane) {
    const int nblk = NP / 32, kb = item / nblk, nb = item % nblk, k0 = 64 * kb, n0 = 32 * nb;
    const int src = wmap<MAPID>(n0 + (lane & 31));
#pragma unroll 8
    for (int i = 0; i < 32; ++i) { const int kk = 2 * i + (lane >> 5); scr[kk * 33 + (lane & 31)] = (src >= 0) ? W[(size_t)(k0 + kk) * N + src] : 0.f; }
    asm volatile("s_waitcnt lgkmcnt(0)" ::: "memory");
    const int c = lane & 7;
#pragma unroll
    for (int j = 0; j < 4; ++j) { const int n = (lane >> 3) + 8 * j; const float* s = scr + (8 * c) * 33 + n;
        v4u o; o.x = pk2(s[0 * 33], s[1 * 33]); o.y = pk2(s[2 * 33], s[3 * 33]); o.z = pk2(s[4 * 33], s[5 * 33]); o.w = pk2(s[6 * 33], s[7 * 33]);
        *(v4u*)(WT + (size_t)(n0 + n) * K + k0 + 8 * c) = o; }
    asm volatile("s_waitcnt lgkmcnt(0)" ::: "memory");
}
struct Ptrs {
    const float *x, *w_in, *conv_w, *a_log, *dt_bias, *norm_g, *w_out, *ln1_g, *ln1_b, *w_up, *fconv_w, *fconv_b, *w_down, *ln2_g, *ln2_b;
    float* out; unsigned char* ws;
};
__device__ __forceinline__ void p0_prologue(const Ptrs& P, unsigned char* lds, int G) {
    const int tid = opaque_tid(), lane = tid & 63, wave = tid >> 6;
    float* scr = (float*)(lds + wave * 16384);
    const int gw = blockIdx.x * 8 + wave, NGW = G * 8;
    constexpr int I_IN = 16 * (NINP / 32), I_OUT = 16 * 32, I_UP = 16 * (NUP / 32), I_DN = (DFF / 64) * 32, I_L = I_IN + I_OUT + I_UP + I_DN;
    for (int it = gw; it < NLAYER * I_L; it += NGW) {
        const int l = it / I_L; int r = it % I_L;
        unsigned char* wb = P.ws + WS_W + (size_t)l * W_LAYER;
        if (r < I_IN) { transpose_item<1>(P.w_in + (size_t)l * DMODEL * NIN, DMODEL, NIN, NINP, (bf16*)(wb + W_IN), scr, r, lane); continue; } r -= I_IN;
        if (r < I_OUT) { transpose_item<0>(P.w_out + (size_t)l * DMODEL * DMODEL, DMODEL, DMODEL, DMODEL, (bf16*)(wb + W_OUT), scr, r, lane); continue; } r -= I_OUT;
        if (r < I_UP) { transpose_item<2>(P.w_up + (size_t)l * DMODEL * NUP, DMODEL, NUP, NUP, (bf16*)(wb + W_UP), scr, r, lane); continue; } r -= I_UP;
        transpose_item<0>(P.w_down + (size_t)l * DFF * DMODEL, DFF, DMODEL, DMODEL, (bf16*)(wb + W_DOWN), scr, r, lane);
    }
    bf16* xb = (bf16*)(P.ws + WS_XBF);
    const size_t nvec = (size_t)MTOK * DMODEL / 8;
    for (size_t v = (size_t)blockIdx.x * NTHREADS + tid; v < nvec; v += (size_t)G * NTHREADS) {
        const f32x4 a = *(const f32x4*)(P.x + v * 8), b = *(const f32x4*)(P.x + v * 8 + 4);
        v4u o; o.x = pk2(a[0], a[1]); o.y = pk2(a[2], a[3]); o.z = pk2(b[0], b[1]); o.w = pk2(b[2], b[3]);
        *(v4u*)(xb + v * 8) = o;
    }
}

__device__ __forceinline__ void ln_phase(const float* y, float* outf, bf16* outb, const float* gam, const float* bet, int G) {
    const int tid = opaque_tid(), lane = tid & 63, wave = tid >> 6;
    f32x4 gv[4], bv[4];
#pragma unroll
    for (int j = 0; j < 4; ++j) { gv[j] = *(const f32x4*)(gam + 4 * lane + 256 * j); bv[j] = *(const f32x4*)(bet + 4 * lane + 256 * j); }
    for (int m = blockIdx.x * 8 + wave; m < MTOK; m += G * 8) {
        const f32x4* xr = (const f32x4*)(y + (size_t)m * DMODEL) + lane;
        f32x4 v[4]; float s = 0.f;
#pragma unroll
        for (int j = 0; j < 4; ++j) { v[j] = xr[64 * j]; s += (v[j][0] + v[j][1]) + (v[j][2] + v[j][3]); }
        const float mean = wave_sum(s) * (1.f / DMODEL); float s2 = 0.f;
#pragma unroll
        for (int j = 0; j < 4; ++j) { v[j] = v[j] - mean; s2 += (v[j][0] * v[j][0] + v[j][1] * v[j][1]) + (v[j][2] * v[j][2] + v[j][3] * v[j][3]); }
        const float rstd = 1.f / sqrtf(wave_sum(s2) * (1.f / DMODEL) + LN_EPS);
        f32x4* of = (f32x4*)(outf + (size_t)m * DMODEL) + lane;
        v2u* ob = (v2u*)(outb + (size_t)m * DMODEL) + lane;
#pragma unroll
        for (int j = 0; j < 4; ++j) { const f32x4 o = v[j] * rstd * gv[j] + bv[j]; of[64 * j] = o; v2u w; w.x = pk2(o[0], o[1]); w.y = pk2(o[2], o[3]); ob[64 * j] = w; }
    }
}

__device__ __forceinline__ void fix_phase(const float* edge, bf16* act, const float* cw, const float* cb, int G) {
    const int total = 512 * 2 * (DFF / 4);
    const int tid = opaque_tid();
    for (int it = blockIdx.x * NTHREADS + tid; it < total; it += G * NTHREADS) {
        const int c4 = it % (DFF / 4), rr = (it / (DFF / 4)) & 1, s = it / (DFF / 2);
        const int ch = 4 * c4; const bool first = (s % 64) == 0;
        f32x4 h[2];
#pragma unroll
        for (int bj = 0; bj < 2; ++bj) {
            const int col = bj * DFF + ch;
            const f32x4 z4 = (f32x4){0.f, 0.f, 0.f, 0.f};
            const f32x4 cur = *(const f32x4*)(edge + ((size_t)s * 4 + rr) * NUP + col);
            f32x4 p1, p2;
            if (rr == 1) { p1 = *(const f32x4*)(edge + ((size_t)s * 4 + 0) * NUP + col); p2 = first ? z4 : *(const f32x4*)(edge + ((size_t)(s - 1) * 4 + 3) * NUP + col); }
            else { p1 = first ? z4 : *(const f32x4*)(edge + ((size_t)(s - 1) * 4 + 3) * NUP + col); p2 = first ? z4 : *(const f32x4*)(edge + ((size_t)(s - 1) * 4 + 2) * NUP + col); }
            h[bj] = *(const f32x4*)(cw + 2 * NUP + col) * cur + *(const f32x4*)(cw + NUP + col) * p1 + *(const f32x4*)(cw + col) * p2 + *(const f32x4*)(cb + col);
        }
        v2u o; o.x = pk2(pg8::silu_f(h[0][0]) * h[1][0], pg8::silu_f(h[0][1]) * h[1][1]); o.y = pk2(pg8::silu_f(h[0][2]) * h[1][2], pg8::silu_f(h[0][3]) * h[1][3]);
        *(v2u*)(act + ((size_t)s * 64 + rr) * DFF + ch) = o;
    }
}

__device__ __forceinline__ void moba_prep_item(bf16* proj, float* kmean, int item, unsigned char* lds) {
    const int tid = opaque_tid(); const int j = item & 15, h = (item >> 4) & 7, b = item >> 7;
    const int r = tid >> 1, part = tid & 1;
    float* tile = (float*)lds;
    float* psum = (float*)(lds + 256 * 65 * 4);
    const int pos = 256 * j + r;
    bf16* qp = proj + ((size_t)b * SEQL + pos) * NINP + C_QB + h * 64 + 32 * part;
    bf16* kp = proj + ((size_t)b * SEQL + pos) * NINP + C_KB + h * 64 + 32 * part;
    float q[32], k[32];
#pragma unroll
    for (int v = 0; v < 4; ++v) { const v4u a = *(const v4u*)(qp + 8 * v), c = *(const v4u*)(kp + 8 * v);
#pragma unroll
        for (int e = 0; e < 4; ++e) { q[8 * v + 2 * e] = bf2f((unsigned short)(a[e] & 0xffffu)); q[8 * v + 2 * e + 1] = bf2f((unsigned short)(a[e] >> 16));
                                      k[8 * v + 2 * e] = bf2f((unsigned short)(c[e] & 0xffffu)); k[8 * v + 2 * e + 1] = bf2f((unsigned short)(c[e] >> 16)); } }
    if (part == 0) {
#pragma unroll
        for (int i = 0; i < 8; ++i) {
            const float inv = powf(500000.0f, -(float)i / 8.0f);
            const float ang = (float)pos * inv; float sn, cs; sincosf(ang, &sn, &cs);
            const float q1 = q[i], q2 = q[i + 8], k1 = k[i], k2 = k[i + 8];
            q[i] = q1 * cs - q2 * sn; q[i + 8] = q2 * cs + q1 * sn; k[i] = k1 * cs - k2 * sn; k[i + 8] = k2 * cs + k1 * sn;
        }
    }
    const float C2 = 0.125f * 1.4426950408889634f;
#pragma unroll
    for (int v = 0; v < 4; ++v) { v4u a, c;
#pragma unroll
        for (int e = 0; e < 4; ++e) { a[e] = pk2(q[8 * v + 2 * e] * C2, q[8 * v + 2 * e + 1] * C2); c[e] = pk2(k[8 * v + 2 * e], k[8 * v + 2 * e + 1]); }
        *(v4u*)(qp + 8 * v) = a; *(v4u*)(kp + 8 * v) = c; }
#pragma unroll
    for (int i = 0; i < 32; ++i) tile[r * 65 + 32 * part + i] = k[i];
    __syncthreads();
    { const int d = tid & 63, seg = tid >> 6; float s = 0.f;
#pragma unroll 8
      for (int rr = 0; rr < 32; ++rr) s += tile[(seg * 32 + rr) * 65 + d];
      psum[seg * 64 + d] = s; }
    __syncthreads();
    if (tid < 64) { float s = 0.f;
#pragma unroll
        for (int w = 0; w < 8; ++w) s += psum[w * 64 + tid];
        kmean[((size_t)(b * 8 + h) * 16 + j) * 64 + tid] = s * (1.0f / 256.0f); }
    __syncthreads();
}

__device__ __forceinline__ void moba_select(int b, int h, int qb, const bf16* proj, const float* kmean_bh, unsigned char* lds) {
    const int tid = opaque_tid(), r = tid >> 1, half = tid & 1;
    const bf16* qp = proj + ((size_t)b * SEQL + qb * 256 + r) * NINP + C_QB + h * 64 + 32 * half;
    float q[32];
#pragma unroll
    for (int v = 0; v < 4; ++v) { const v4u a = *(const v4u*)(qp + 8 * v);
#pragma unroll
        for (int e = 0; e < 4; ++e) { q[8 * v + 2 * e] = bf2f((unsigned short)(a[e] & 0xffffu)); q[8 * v + 2 * e + 1] = bf2f((unsigned short)(a[e] >> 16)); } }
    float gate[16];
#pragma unroll
    for (int j = 0; j < 16; ++j) { float sg = -INFINITY;
        if (j < qb) { const float* km = kmean_bh + j * 64 + 32 * half; float a_ = 0.f;
#pragma unroll
            for (int v = 0; v < 8; ++v) { const f32x4 k4 = *(const f32x4*)(km + 4 * v); a_ += q[4 * v] * k4[0] + q[4 * v + 1] * k4[1] + q[4 * v + 2] * k4[2] + q[4 * v + 3] * k4[3]; }
            a_ += __shfl_xor(a_, 1); sg = a_; }
        gate[j] = sg; }
    unsigned selmask = 0u;
#pragma unroll
    for (int rk = 0; rk < 3; ++rk) { float best = -INFINITY; int bi = -1;
#pragma unroll
        for (int j = 0; j < 16; ++j) { const bool ok = (j < qb) && !((selmask >> j) & 1u) && (gate[j] > best); if (ok) { best = gate[j]; bi = j; } }
        if (bi >= 0) selmask |= (1u << bi); }
    if (half == 0) ((unsigned*)(lds + attn_body::SEL_OFF))[r] = selmask;
}
namespace gdn {
constexpr int LQD = 0, LQN = 17408, LKN = 34816, LVBT = 52224, LKBG = 70656, LKDT = 89088, LAF = 107520, LTINV = 124928, LATT = 134144, LGATE = 143360, LSLOT5 = 144384;
constexpr int SLOT0 = LQN, SLOT1 = LQN + 9216, SLOT2 = LQN + 18432;
constexpr int SQ = 136, ST = 72, SA = 68;
__device__ __forceinline__ bf16x8 ld16(const unsigned char* p) { return *(const bf16x8*)p; }

__device__ __forceinline__ void prep_item(const bf16* proj, unsigned char* rec, float* glast_out, const float* cw, float a_log_h, float dt_bias_h, int b, int h, int n, unsigned char* lds) {
    const int tid = opaque_tid(), lane = tid & 63, wid = tid >> 6, g = lane >> 4, ln = lane & 15;
    bf16* Qn = (bf16*)(lds + LQN); bf16* Qd = (bf16*)(lds + LQD); bf16* Kn = (bf16*)(lds + LKN);
    bf16* VbT = (bf16*)(lds + LVBT); bf16* KbgT = (bf16*)(lds + LKBG); bf16* KdT = (bf16*)(lds + LKDT);
    float* Af = (float*)(lds + LAF); bf16* Wl = (bf16*)(lds + LAF); bf16* Tinv = (bf16*)(lds + LTINV); bf16* Att = (bf16*)(lds + LATT);
    float* gcum = (float*)(lds + LGATE); float* beta = gcum + 64; float* expg = gcum + 128; float* kdf = gcum + 192;
    const int t0 = n * 64; const size_t rowb = (size_t)b * SEQL;
    if (wid == 0) {
        const bf16* pr = proj + (rowb + t0 + lane) * NINP;
        const float al = bf2f(pr[C_AL + h]), bl = bf2f(pr[C_BL + h]);
        const float xx = al + dt_bias_h; const float sp = (xx > 20.f) ? xx : log1pf(expf(xx));
        float gv = -expf(a_log_h) * sp;
#pragma unroll
        for (int o = 1; o < 64; o <<= 1) { const float t = __shfl_up(gv, o); if (lane >= o) gv += t; }
        const float gl = __shfl(gv, 63);
        gcum[lane] = gv; beta[lane] = 1.0f / (1.0f + expf(-bl)); expg[lane] = expf(gv); kdf[lane] = expf(gl - gv);
        if (lane == 0) *glast_out = gl;
    }
    __syncthreads();
    {
        const int r = tid >> 3, part = tid & 7;
        const float be = beta[r], eg = expg[r], kd = kdf[r];
#pragma unroll
        for (int sec = 0; sec < 3; ++sec) {
            const int cb = sec * 512 + h * 128 + part * 16;
            float y[16];
#pragma unroll
            for (int i = 0; i < 16; ++i) y[i] = 0.f;
#pragma unroll
            for (int off = 0; off < 4; ++off) {
                const int t = t0 + r - 3 + off;
                v4u x0 = (v4u){0u, 0u, 0u, 0u}, x1 = x0;
                if (t >= 0) { const bf16* xp = proj + (rowb + t) * NINP + cb; x0 = *(const v4u*)xp; x1 = *(const v4u*)(xp + 8); }
                const float* wp = cw + off * 1536 + cb;
#pragma unroll
                for (int v = 0; v < 4; ++v) { const f32x4 w4 = *(const f32x4*)(wp + 4 * v);
                    const unsigned ua = (v < 2) ? x0[2 * v] : x1[2 * v - 4], ub = (v < 2) ? x0[2 * v + 1] : x1[2 * v - 3];
                    y[4 * v + 0] += w4[0] * bf2f((unsigned short)(ua & 0xffffu)); y[4 * v + 1] += w4[1] * bf2f((unsigned short)(ua >> 16));
                    y[4 * v + 2] += w4[2] * bf2f((unsigned short)(ub & 0xffffu)); y[4 * v + 3] += w4[3] * bf2f((unsigned short)(ub >> 16)); }
            }
            float ssq = 0.f;
#pragma unroll
            for (int i = 0; i < 16; ++i) { y[i] = y[i] / (1.0f + expf(-y[i])); ssq += y[i] * y[i]; }
            if (sec < 2) { ssq += __shfl_xor(ssq, 1); ssq += __shfl_xor(ssq, 2); ssq += __shfl_xor(ssq, 4); }
            const float rs = rsqrtf(ssq + NORM_EPS);
            if (sec == 0) {
                const float sc = rs * 0.08838834764831845f;
                v4u a0, a1, d0, d1;
#pragma unroll
                for (int e = 0; e < 4; ++e) { a0[e] = pk2(y[2 * e] * sc, y[2 * e + 1] * sc); a1[e] = pk2(y[8 + 2 * e] * sc, y[9 + 2 * e] * sc);
                                              d0[e] = pk2(y[2 * e] * sc * eg, y[2 * e + 1] * sc * eg); d1[e] = pk2(y[8 + 2 * e] * sc * eg, y[9 + 2 * e] * sc * eg); }
                *(v4u*)(Qn + r * SQ + part * 16) = a0; *(v4u*)(Qn + r * SQ + part * 16 + 8) = a1;
                *(v4u*)(Qd + r * SQ + part * 16) = d0; *(v4u*)(Qd + r * SQ + part * 16 + 8) = d1;
            } else if (sec == 1) {
                v4u a0, a1;
#pragma unroll
                for (int e = 0; e < 4; ++e) { a0[e] = pk2(y[2 * e] * rs, y[2 * e + 1] * rs); a1[e] = pk2(y[8 + 2 * e] * rs, y[9 + 2 * e] * rs); }
                *(v4u*)(Kn + r * SQ + part * 16) = a0; *(v4u*)(Kn + r * SQ + part * 16 + 8) = a1;
#pragma unroll
                for (int i = 0; i < 16; ++i) { const float kn = y[i] * rs; const int d = part * 16 + i;
                    KbgT[d * ST + r] = (bf16)f2bf(kn * be * eg); KdT[d * ST + r] = (bf16)f2bf(kn * kd); }
            } else {
#pragma unroll
                for (int i = 0; i < 16; ++i) VbT[(part * 16 + i) * ST + r] = (bf16)f2bf(y[i] * be);
            }
        }
    }
    __syncthreads();
    {
        const int Ti = wid >> 1;
        f32x4 aK[2], aQ[2];
#pragma unroll
        for (int tt = 0; tt < 2; ++tt) {
            const int Tj = 2 * (wid & 1) + tt;
            aK[tt] = (f32x4){0.f, 0.f, 0.f, 0.f}; aQ[tt] = aK[tt];
            if (Tj <= Ti) {
#pragma unroll
                for (int kk = 0; kk < 4; ++kk) {
                    const bf16x8 fk = ld16((const unsigned char*)(Kn + (16 * Ti + ln) * SQ + 32 * kk + 8 * g));
                    const bf16x8 fq = ld16((const unsigned char*)(Qn + (16 * Ti + ln) * SQ + 32 * kk + 8 * g));
                    const bf16x8 fb = ld16((const unsigned char*)(Kn + (16 * Tj + ln) * SQ + 32 * kk + 8 * g));
                    aK[tt] = mfma16(fk, fb, aK[tt]); aQ[tt] = mfma16(fq, fb, aQ[tt]);
                }
            }
        }
        __syncthreads();
        bf16* Prow[2] = {(bf16*)(lds + SLOT0), (bf16*)(lds + SLOT2)}; bf16* Ptr[2] = {(bf16*)(lds + SLOT1), (bf16*)(lds + LAF)};
        bf16* Rb[2] = {(bf16*)(lds + LSLOT5), (bf16*)(lds + LTINV)};
        f32x4 racc[2];
#pragma unroll
        for (int tt = 0; tt < 2; ++tt) {
            const int Tj = 2 * (wid & 1) + tt; const int jj = 16 * Tj + ln; const float gj = gcum[jj];
            unsigned short nb[4];
#pragma unroll
            for (int j = 0; j < 4; ++j) { const int i = 16 * Ti + 4 * g + j; const float dcy = expf(fminf(gcum[i] - gj, 0.f));
                const float nv = (i > jj) ? -(beta[i] * aK[tt][j] * dcy) : 0.f;
                Att[i * ST + jj] = (bf16)f2bf((i >= jj) ? aQ[tt][j] * dcy : 0.f);
                racc[tt][j] = nv + ((i == jj) ? 1.f : 0.f);
                nb[j] = (unsigned short)f2bf(nv);
                Prow[0][i * ST + jj] = nb[j]; Rb[0][i * ST + jj] = (bf16)f2bf(racc[tt][j]); }
            v2u tw; tw[0] = (unsigned)nb[0] | ((unsigned)nb[1] << 16); tw[1] = (unsigned)nb[2] | ((unsigned)nb[3] << 16);
            *(v2u*)(Ptr[0] + jj * ST + 16 * Ti + 4 * g) = tw;
        }
        __syncthreads();
#pragma unroll
        for (int t = 1; t <= 5; ++t) {
            const int ps = (t - 1) & 1, pd = t & 1;
            f32x4 pn[2];
#pragma unroll
            for (int tt = 0; tt < 2; ++tt) {
                const int Tj = 2 * (wid & 1) + tt; f32x4 a = (f32x4){0.f, 0.f, 0.f, 0.f};
#pragma unroll
                for (int kk = 0; kk < 2; ++kk) a = mfma16(ld16((const unsigned char*)(Prow[ps] + (16 * Ti + ln) * ST + 32 * kk + 8 * g)), ld16((const unsigned char*)(Ptr[ps] + (16 * Tj + ln) * ST + 32 * kk + 8 * g)), a);
                pn[tt] = a;
            }
#pragma unroll
            for (int tt = 0; tt < 2; ++tt) {
                const int Tj = 2 * (wid & 1) + tt; const int jj = 16 * Tj + ln;
                const unsigned w0 = pk2(pn[tt][0], pn[tt][1]), w1 = pk2(pn[tt][2], pn[tt][3]);
                Prow[pd][(16 * Ti + 4 * g + 0) * ST + jj] = (bf16)(w0 & 0xffffu); Prow[pd][(16 * Ti + 4 * g + 1) * ST + jj] = (bf16)(w0 >> 16);
                Prow[pd][(16 * Ti + 4 * g + 2) * ST + jj] = (bf16)(w1 & 0xffffu); Prow[pd][(16 * Ti + 4 * g + 3) * ST + jj] = (bf16)(w1 >> 16);
                v2u tw; tw[0] = w0; tw[1] = w1; *(v2u*)(Ptr[pd] + jj * ST + 16 * Ti + 4 * g) = tw;
            }
            __syncthreads();
#pragma unroll
            for (int tt = 0; tt < 2; ++tt) {
                const int Tj = 2 * (wid & 1) + tt; const int jj = 16 * Tj + ln; f32x4 a = racc[tt];
#pragma unroll
                for (int kk = 0; kk < 2; ++kk) a = mfma16(ld16((const unsigned char*)(Rb[ps] + (16 * Ti + ln) * ST + 32 * kk + 8 * g)), ld16((const unsigned char*)(Ptr[pd] + (16 * Tj + ln) * ST + 32 * kk + 8 * g)), a);
                racc[tt] = a;
#pragma unroll
                for (int j = 0; j < 4; ++j) Rb[pd][(16 * Ti + 4 * g + j) * ST + jj] = (bf16)f2bf(a[j]);
            }
            __syncthreads();
        }
    }
    {
        f32x4 aU[4], aW[4];
#pragma unroll
        for (int T = 0; T < 4; ++T) { aU[T] = (f32x4){0.f, 0.f, 0.f, 0.f}; aW[T] = aU[T]; }
#pragma unroll
        for (int kk = 0; kk < 2; ++kk) {
            const bf16x8 bU = ld16((const unsigned char*)(VbT + (16 * wid + ln) * ST + 32 * kk + 8 * g));
            const bf16x8 bW = ld16((const unsigned char*)(KbgT + (16 * wid + ln) * ST + 32 * kk + 8 * g));
#pragma unroll
            for (int T = 0; T < 4; ++T) { const bf16x8 a = ld16((const unsigned char*)(Tinv + (16 * T + ln) * ST + 32 * kk + 8 * g)); aU[T] = mfma16(a, bU, aU[T]); aW[T] = mfma16(a, bW, aW[T]); }
        }
        v4u u0, u1;
        u0[0] = pk2(aU[0][0], aU[0][1]); u0[1] = pk2(aU[0][2], aU[0][3]); u0[2] = pk2(aU[1][0], aU[1][1]); u0[3] = pk2(aU[1][2], aU[1][3]);
        u1[0] = pk2(aU[2][0], aU[2][1]); u1[1] = pk2(aU[2][2], aU[2][3]); u1[2] = pk2(aU[3][0], aU[3][1]); u1[3] = pk2(aU[3][2], aU[3][3]);
        *(v4u*)(rec + (wid * 64 + lane) * 32) = u0; *(v4u*)(rec + (wid * 64 + lane) * 32 + 16) = u1;
#pragma unroll
        for (int T = 0; T < 4; ++T)
#pragma unroll
            for (int j = 0; j < 4; ++j) Wl[(16 * T + 4 * g + j) * SQ + 16 * wid + ln] = (bf16)f2bf(aW[T][j]);
    }
    __syncthreads();
#pragma unroll
    for (int it = 0; it < 7; ++it) {
        const int p = tid + 512 * it;
        const bf16* src; int stride, T, kk, idx; int dst;
        if (p < 1024) { idx = p; src = Wl; stride = SQ; T = idx >> 8; kk = (idx >> 6) & 3; dst = 16384 + idx * 16; }
        else if (p < 2048) { idx = p - 1024; src = Qd; stride = SQ; T = idx >> 8; kk = (idx >> 6) & 3; dst = 32768 + idx * 16; }
        else if (p < 2560) { idx = p - 2048; src = Att; stride = ST; T = idx >> 7; kk = (idx >> 6) & 1; dst = 49152 + idx * 16; }
        else { idx = p - 2560; src = KdT; stride = ST; T = idx >> 7; kk = (idx >> 6) & 1; dst = 57344 + idx * 16; }
        const int l = idx & 63, gg = l >> 4, m = l & 15;
        const bf16* sp = src + (16 * T + m) * stride + 32 * kk + 4 * gg;
        const v2u lo = *(const v2u*)sp, hi = *(const v2u*)(sp + 16);
        v4u o; o[0] = lo[0]; o[1] = lo[1]; o[2] = hi[0]; o[3] = hi[1];
        *(v4u*)(rec + dst) = o;
    }
    __syncthreads();
}

constexpr int SREC = 57344, SZ = 272, SBUF = SREC + 64 * SZ, SRED = 2 * SBUF;
__device__ __forceinline__ bf16x8 packS(const f32x4& a, const f32x4& b) {
    v4u r; r[0] = pg8::cvt_pk_bf16(a[0], a[1]); r[1] = pg8::cvt_pk_bf16(a[2], a[3]); r[2] = pg8::cvt_pk_bf16(b[0], b[1]); r[3] = pg8::cvt_pk_bf16(b[2], b[3]);
    return __builtin_bit_cast(bf16x8, r);
}
__device__ __forceinline__ float row16_sum(float v) {
    v += __builtin_bit_cast(float, __builtin_amdgcn_update_dpp(0, __builtin_bit_cast(int, v), 0x128, 0xf, 0xf, false));
    v += __builtin_bit_cast(float, __builtin_amdgcn_update_dpp(0, __builtin_bit_cast(int, v), 0x124, 0xf, 0xf, false));
    v += __builtin_bit_cast(float, __builtin_amdgcn_update_dpp(0, __builtin_bit_cast(int, v), 0x122, 0xf, 0xf, false));
    v += __builtin_bit_cast(float, __builtin_amdgcn_update_dpp(0, __builtin_bit_cast(int, v), 0x121, 0xf, 0xf, false));
    return v;
}
__device__ __forceinline__ void scan_bh(int bh, const unsigned char* gdnbase, const float* glast, const bf16* proj, bf16* concat, const float* normg, unsigned char* lds) {
    const int tid = opaque_tid(), lane = tid & 63, wid = tid >> 6, g = lane >> 4, ln = lane & 15;
    const int b = bh >> 2, h = bh & 3;
    f32x4 S[8];
#pragma unroll
    for (int T = 0; T < 8; ++T) S[T] = (f32x4){0.f, 0.f, 0.f, 0.f};
    const unsigned char* rec0 = gdnbase + (size_t)bh * 64 * CHUNK_REC;
    float* red = (float*)(lds + SRED);
    const float ng = normg[16 * wid + ln];
    const size_t tok0 = (size_t)b * SEQL;
    const int zr0 = tid >> 4, zs = tid & 15;
    const bf16* zsrc = proj + (tok0 + zr0) * NINP + C_Z + h * 128 + zs * 8;
    bf16* odst = concat + (tok0 + zr0) * DMODEL + h * 128 + zs * 8;
    v4u st[9];
#pragma unroll
    for (int i = 0; i < 7; ++i) st[i] = *(const v4u*)(rec0 + 16384 + (size_t)(tid + 512 * i) * 16);
    st[7] = *(const v4u*)zsrc; st[8] = *(const v4u*)(zsrc + (size_t)32 * NINP);
    v4u u0 = *(const v4u*)(rec0 + (wid * 64 + lane) * 32), u1 = *(const v4u*)(rec0 + (wid * 64 + lane) * 32 + 16);
    float gl = glast[bh * 64];
#pragma unroll
    for (int i = 0; i < 7; ++i) *(v4u*)(lds + (tid + 512 * i) * 16) = st[i];
    *(v4u*)(lds + SREC + zr0 * SZ + zs * 16) = st[7]; *(v4u*)(lds + SREC + (zr0 + 32) * SZ + zs * 16) = st[8];
    __syncthreads();
    for (int c = 0; c < 64; ++c) {
        unsigned char* buf = lds + (c & 1) * SBUF;
        unsigned char* obuf = lds + ((c + 1) & 1) * SBUF;
        const int cn = (c + 1 < 64) ? c + 1 : 63, cp = (c > 0) ? c - 1 : 0;
        const unsigned char* recn = rec0 + (size_t)cn * CHUNK_REC;
        const float gln = glast[bh * 64 + cn];
#pragma unroll
        for (int i = 0; i < 7; ++i) st[i] = *(const v4u*)(recn + 16384 + (size_t)(tid + 512 * i) * 16);
        { const bf16* zp = zsrc + (size_t)cn * 64 * NINP; st[7] = *(const v4u*)zp; st[8] = *(const v4u*)(zp + (size_t)32 * NINP); }
        const v4u un0 = *(const v4u*)(recn + (wid * 64 + lane) * 32), un1 = *(const v4u*)(recn + (wid * 64 + lane) * 32 + 16);
        {
            const v4u o0 = *(const v4u*)(obuf + SREC + zr0 * SZ + zs * 16), o1 = *(const v4u*)(obuf + SREC + (zr0 + 32) * SZ + zs * 16);
            bf16* od = odst + (size_t)cp * 64 * DMODEL;
            *(v4u*)od = o0; *(v4u*)(od + (size_t)32 * DMODEL) = o1;
        }
        const float dec = __expf(gl);
        bf16x8 bS[4];
#pragma unroll
        for (int kk = 0; kk < 4; ++kk) bS[kk] = packS(S[2 * kk], S[2 * kk + 1]);
        f32x4 Vn[4];
#pragma unroll
        for (int T = 0; T < 4; ++T) {
            f32x4 p = (f32x4){0.f, 0.f, 0.f, 0.f};
#pragma unroll
            for (int kk = 0; kk < 4; ++kk) p = mfma16(ld16(buf + ((T * 4 + kk) * 64 + lane) * 16), bS[kk], p);
            const unsigned ua = (T < 2) ? u0[2 * T] : u1[2 * T - 4], ub = (T < 2) ? u0[2 * T + 1] : u1[2 * T - 3];
            Vn[T][0] = bf2f((unsigned short)(ua & 0xffffu)) - p[0]; Vn[T][1] = bf2f((unsigned short)(ua >> 16)) - p[1];
            Vn[T][2] = bf2f((unsigned short)(ub & 0xffffu)) - p[2]; Vn[T][3] = bf2f((unsigned short)(ub >> 16)) - p[3];
        }
        bf16x8 bV[2];
        bV[0] = packS(Vn[0], Vn[1]); bV[1] = packS(Vn[2], Vn[3]);
        f32x4 O[4];
#pragma unroll
        for (int T = 0; T < 4; ++T) {
            f32x4 a = (f32x4){0.f, 0.f, 0.f, 0.f};
#pragma unroll
            for (int kk = 0; kk < 4; ++kk) a = mfma16(ld16(buf + 16384 + ((T * 4 + kk) * 64 + lane) * 16), bS[kk], a);
#pragma unroll
            for (int kk = 0; kk < 2; ++kk) a = mfma16(ld16(buf + 32768 + ((T * 2 + kk) * 64 + lane) * 16), bV[kk], a);
            O[T] = a;
        }
#pragma unroll
        for (int T = 0; T < 8; ++T) {
            f32x4 a = S[T] * dec;
#pragma unroll
            for (int kk = 0; kk < 2; ++kk) a = mfma16(ld16(buf + 40960 + ((T * 2 + kk) * 64 + lane) * 16), bV[kk], a);
            S[T] = a;
        }
#pragma unroll
        for (int T = 0; T < 4; ++T)
#pragma unroll
            for (int j = 0; j < 4; ++j) { const float s = row16_sum(O[T][j] * O[T][j]); if (ln == 0) red[(16 * T + 4 * g + j) * 8 + wid] = s; }
        __syncthreads();
        bf16* zt = (bf16*)(buf + SREC);
#pragma unroll
        for (int T = 0; T < 4; ++T)
#pragma unroll
            for (int j = 0; j < 4; ++j) { const int row = 16 * T + 4 * g + j;
                const f32x4 r0 = *(const f32x4*)(red + row * 8), r1 = *(const f32x4*)(red + row * 8 + 4);
                const float tot = ((r0[0] + r0[1]) + (r0[2] + r0[3])) + ((r1[0] + r1[1]) + (r1[2] + r1[3]));
                const float rstd = rsqrtf(tot * (1.0f / 128.0f) + NORM_EPS);
                bf16* zp = zt + row * (SZ / 2) + 16 * wid + ln;
                const float z = bf2f(*zp);
                const float val = O[T][j] * rstd * ng * z * __builtin_amdgcn_rcpf(1.0f + __expf(-z));
                *zp = (bf16)f2bf(val); }
#pragma unroll
        for (int i = 0; i < 7; ++i) *(v4u*)(obuf + (tid + 512 * i) * 16) = st[i];
        *(v4u*)(obuf + SREC + zr0 * SZ + zs * 16) = st[7]; *(v4u*)(obuf + SREC + (zr0 + 32) * SZ + zs * 16) = st[8];
        __syncthreads();
        u0 = un0; u1 = un1; gl = gln;
    }
    {
        const unsigned char* obuf = lds + SBUF;
        const v4u o0 = *(const v4u*)(obuf + SREC + zr0 * SZ + zs * 16), o1 = *(const v4u*)(obuf + SREC + (zr0 + 32) * SZ + zs * 16);
        bf16* od = odst + (size_t)63 * 64 * DMODEL;
        *(v4u*)od = o0; *(v4u*)(od + (size_t)32 * DMODEL) = o1;
    }
    __syncthreads();
}
}
struct Args { Ptrs p; int pad0, pad1; };
#define LP() (&args.p)
#define WSP(off) (LP()->ws + (off))
template <int l> __device__ __forceinline__ void layer_body(const Args& args, cg::grid_group& grid, unsigned char* lds, PG8_LAS unsigned char* ldsl, const int G) {
        { pg8::Gemm gm{(const bf16*)WSP(WS_XBF), (const bf16*)(WSP(WS_W) + (size_t)l * W_LAYER + W_IN), MTOK, NINP, DMODEL}; pg8::StaticOrder S; S.init(MTOK, NINP, G, (int)blockIdx.x);
          pg8::EpiBf16 E{(bf16*)WSP(WS_PROJ), NINP};
          pg8::gemm_phase<pg8::EpiBf16, pg8::StaticOrder, true, true>(ldsl, gm, S, E);
          if (PROBE_MASK & 1) { __syncthreads(); pg8::gemm_phase<pg8::EpiBf16, pg8::StaticOrder, true, true>(ldsl, gm, S, E); } }
        grid.sync();
        if (blockIdx.x == 0 && threadIdx.x == 0) { ((unsigned*)WSP(WS_CTL))[64 + l] = 0u; ((unsigned*)WSP(WS_CTL))[80 + l] = 0u; }
        for (int rep_ = 0; rep_ < ((PROBE_MASK & 2) ? 2 : 1); ++rep_)
        for (int it = blockIdx.x; it < 2048; it += G) {
            const int n = it & 63, h = (it >> 6) & 3, b = it >> 8;
            const Ptrs* pp = LP();
            gdn::prep_item((const bf16*)(pp->ws + WS_PROJ), pp->ws + WS_GDN + (size_t)it * CHUNK_REC, (float*)(pp->ws + WS_GLAST) + it, pp->conv_w + (size_t)l * 4 * 1536, pp->a_log[l * 4 + h], pp->dt_bias[l * 4 + h], b, h, n, lds);
        }
        for (int it = blockIdx.x; it < 1024; it += G) moba_prep_item((bf16*)WSP(WS_PROJ), (float*)WSP(WS_KMEAN), it, lds);
        grid.sync();
        for (int rep_ = 0; rep_ < ((PROBE_MASK & (4 | 64 | 128)) ? 2 : 1); ++rep_) {
        if (blockIdx.x < 32 && (rep_ == 0 || (PROBE_MASK & (4 | 64)))) { const Ptrs* pp = LP(); gdn::scan_bh((int)blockIdx.x, pp->ws + WS_GDN, (const float*)(pp->ws + WS_GLAST), (const bf16*)(pp->ws + WS_PROJ), (bf16*)(pp->ws + WS_XBF), pp->norm_g + l * 128, lds); }
        {
            volatile unsigned* sh_u = (volatile unsigned*)(lds + 90112);
            if (rep_ == 0 || (PROBE_MASK & (4 | 128))) for (;;) {
                __syncthreads();
                if (threadIdx.x == 0) *sh_u = atomicAdd((unsigned*)WSP(WS_CTL) + 64 + 16 * rep_ + l, 1u);
                __syncthreads();
                const unsigned u = (unsigned)__builtin_amdgcn_readfirstlane((int)*sh_u);
                if (u >= 1024u) break;
                const int qb = 15 - (int)(u >> 6), bh = (int)(u & 63u), b = bh >> 3, h = bh & 7;
                const bf16* proj = (const bf16*)WSP(WS_PROJ);
                moba_select(b, h, qb, proj, (const float*)WSP(WS_KMEAN) + (size_t)bh * 16 * 64, lds);
                __syncthreads();
                attn_body::attn_unit<8>(b, h, qb, (const attn_body::bf16*)(proj + C_QB), (const attn_body::bf16*)(proj + C_KB), (const attn_body::bf16*)(proj + C_VB),
                                        (attn_body::bf16*)((bf16*)WSP(WS_XBF) + 512), (char*)lds);
            }
        }
        }
        grid.sync();
        { const Ptrs* pp = LP();
          pg8::Gemm gm{(const bf16*)(pp->ws + WS_XBF), (const bf16*)(pp->ws + WS_W + (size_t)l * W_LAYER + W_OUT), MTOK, DMODEL, DMODEL}; pg8::StaticOrder S; S.init(MTOK, DMODEL, G, (int)blockIdx.x);
          pg8::EpiResF32 E{(l == 0) ? pp->x : (const float*)pp->out, (float*)(pp->ws + WS_YX), DMODEL, ALPHA};
          pg8::gemm_phase<pg8::EpiResF32, pg8::StaticOrder, true, true>(ldsl, gm, S, E);
          if (PROBE_MASK & 16) { __syncthreads(); pg8::gemm_phase<pg8::EpiResF32, pg8::StaticOrder, true, true>(ldsl, gm, S, E); } }
        grid.sync();
        { const Ptrs* pp = LP(); ln_phase((const float*)(pp->ws + WS_YX), (float*)(pp->ws + WS_YX), (bf16*)(pp->ws + WS_XBF), pp->ln1_g + l * DMODEL, pp->ln1_b + l * DMODEL, G); }
        grid.sync();
        { const Ptrs* pp = LP();
          pg8::Gemm gm{(const bf16*)(pp->ws + WS_XBF), (const bf16*)(pp->ws + WS_W + (size_t)l * W_LAYER + W_UP), MTOK, NUP, DMODEL}; pg8::StaticOrder S; S.init(MTOK, NUP, G, (int)blockIdx.x);
          pg8::EpiUpConv E{(bf16*)(pp->ws + WS_ACT), (float*)(pp->ws + WS_EDGE), pp->fconv_w + (size_t)l * 3 * NUP, pp->fconv_b + (size_t)l * NUP};
          pg8::gemm_phase<pg8::EpiUpConv, pg8::StaticOrder, true, true>(ldsl, gm, S, E);
          if (PROBE_MASK & 8) { __syncthreads(); pg8::gemm_phase<pg8::EpiUpConv, pg8::StaticOrder, true, true>(ldsl, gm, S, E); } }
        grid.sync();
        { const Ptrs* pp = LP(); fix_phase((const float*)(pp->ws + WS_EDGE), (bf16*)(pp->ws + WS_ACT), pp->fconv_w + (size_t)l * 3 * NUP, pp->fconv_b + (size_t)l * NUP, G); }
        grid.sync();
        { const Ptrs* pp = LP();
          pg8::Gemm gm{(const bf16*)(pp->ws + WS_ACT), (const bf16*)(pp->ws + WS_W + (size_t)l * W_LAYER + W_DOWN), MTOK, DMODEL, DFF}; pg8::StaticOrder S; S.init(MTOK, DMODEL, G, (int)blockIdx.x);
          pg8::EpiResF32 E{(const float*)(pp->ws + WS_YX), (float*)(pp->ws + WS_YX), DMODEL, ALPHA};
          pg8::gemm_phase<pg8::EpiResF32, pg8::StaticOrder, true, true>(ldsl, gm, S, E); }
        grid.sync();
        { const Ptrs* pp = LP(); ln_phase((const float*)(pp->ws + WS_YX), pp->out, (bf16*)(pp->ws + WS_XBF), pp->ln2_g + l * DMODEL, pp->ln2_b + l * DMODEL, G);
          if (PROBE_MASK & 32) ln_phase((const float*)(pp->ws + WS_YX), pp->out, (bf16*)(pp->ws + WS_XBF), pp->ln2_g + l * DMODEL, pp->ln2_b + l * DMODEL, G); }
        if (l + 1 < NLAYER) grid.sync();
}
__global__ void __launch_bounds__(NTHREADS, 2) hybrid_fwd(Args args) {
    extern __shared__ __attribute__((aligned(16))) unsigned char lds[];
    cg::grid_group grid = cg::this_grid();
    const int G = gridDim.x;
    PG8_LAS unsigned char* ldsl = (PG8_LAS unsigned char*)lds;

    { const Ptrs P = *LP(); p0_prologue(P, lds, G); }
    grid.sync();

    layer_body<0>(args, grid, lds, ldsl, G);
    layer_body<1>(args, grid, lds, ldsl, G);
}

extern "C" void kernel_launch(void* const* d_in, const int* in_sizes, int n_in, void* d_out, int out_size, void* d_ws, size_t ws_size, hipStream_t stream) {
    static int grid = 0;
    if (grid == 0) {
        if (n_in != 15 || ws_size < WS_END) { fprintf(stderr, "kernel_launch: unexpected inputs (n_in %d, ws %zu)\n", n_in, ws_size); grid = -1; return; }
        int dev = 0, cus = 0, per_cu = 0;
        hipGetDevice(&dev); hipDeviceGetAttribute(&cus, hipDeviceAttributeMultiprocessorCount, dev);
        if (hipFuncSetAttribute((const void*)hybrid_fwd, hipFuncAttributeMaxDynamicSharedMemorySize, LDS_BYTES) != hipSuccess) { fprintf(stderr, "kernel_launch: hipFuncSetAttribute failed\n"); grid = -1; return; }
        if (hipOccupancyMaxActiveBlocksPerMultiprocessor(&per_cu, (const void*)hybrid_fwd, NTHREADS, LDS_BYTES) != hipSuccess || per_cu < 1) { fprintf(stderr, "kernel_launch: occupancy query says %d\n", per_cu); per_cu = 1; }
        (void)hipGetLastError();
        grid = cus;
        if (grid < 64) grid = 64;
    }
    if (grid < 0) return;
    Args a{};
    const float* const* in = (const float* const*)d_in;
    a.p.x = in[0]; a.p.w_in = in[1]; a.p.conv_w = in[2]; a.p.a_log = in[3]; a.p.dt_bias = in[4]; a.p.norm_g = in[5]; a.p.w_out = in[6];
    a.p.ln1_g = in[7]; a.p.ln1_b = in[8]; a.p.w_up = in[9]; a.p.fconv_w = in[10]; a.p.fconv_b = in[11]; a.p.w_down = in[12]; a.p.ln2_g = in[13]; a.p.ln2_b = in[14];
    a.p.out = (float*)d_out; a.p.ws = (unsigned char*)d_ws;
    void* kargs[] = {&a};
    hipError_t e = hipLaunchCooperativeKernel((const void*)hybrid_fwd, dim3(grid), dim3(NTHREADS), kargs, LDS_BYTES, stream);
    if (e != hipSuccess) fprintf(stderr, "kernel_launch: cooperative launch failed: %s (grid %d)\n", hipGetErrorString(e), grid);
}
```

```cpp
#include <hip/hip_runtime.h>
#include <hip/hip_cooperative_groups.h>
#include <hip/hip_bf16.h>
#include <cstdio>
#include <cstdint>
#include <cmath>
namespace cg = cooperative_groups;
#ifndef PROBE_MASK
#define PROBE_MASK 0
#endif
__device__ __forceinline__ int opaque_tid() { int t = threadIdx.x; asm volatile("" : "+v"(t)); return t; }
namespace pg8 {
#define PG8_LAS __attribute__((address_space(3)))
typedef unsigned short bf16_t;
typedef short bf16x8 __attribute__((ext_vector_type(8)));
typedef float f32x4 __attribute__((ext_vector_type(4)));
typedef unsigned u32x4 __attribute__((ext_vector_type(4)));
constexpr int BM = 256, BK = 64, HALF = 128, HTB = HALF * BK * 2  , STAGE_BYTES = 8 * HTB, NXCD = 8, WGM = 8;

__host__ __device__ __forceinline__ int lds_byte(int r, int c) { const int st = (r >> 4) * 2 + (c >> 5), rr = r & 15, cc = c & 31, ob = rr * 64 + cc * 2; return st * 1024 + (ob ^ (((ob >> 9) & 1) << 5)); }
__host__ __device__ __forceinline__ void stage_rc(int b, int& R, int& C) { const int st = b / 1024, sb = b % 1024, swz = sb ^ (((sb >> 9) & 1) << 5); R = (st >> 1) * 16 + swz / 64; C = (st & 1) * 32 + (swz % 64) / 2; }
__host__ __device__ __forceinline__ int perm32(int rho) { const int n = rho >> 4, i = rho & 15; return 8 * (i >> 2) + 4 * n + (i & 3); }

struct Unit { int pm, pn; };
struct Gemm { const bf16_t* A; const bf16_t* Bt; int M, N, K; };

struct StaticOrder {
    int nM, nN, nwg, G, c;
    __host__ __device__ void init(int M, int N, int G_, int c_) { nM = M / BM; nN = N / BM; nwg = nM * nN; G = G_; c = c_; }
    __host__ __device__ bool next(int i, Unit& u) const {
        const long L = (long)i * G + c; if (L >= nwg) return false;
        int wgid = (int)L; { const int q = nwg / NXCD, r = nwg % NXCD, xcd = wgid % NXCD, off = wgid / NXCD; wgid = (xcd < r ? xcd * (q + 1) : r * (q + 1) + (xcd - r) * q) + off; }
        const int nig = WGM * nN, gid = wgid / nig, fm = gid * WGM, gsz = (nM - fm) < WGM ? (nM - fm) : WGM;
        u.pm = fm + ((wgid % nig) % gsz); u.pn = (wgid % nig) / gsz; return true;
    }
    __device__ __forceinline__ void a_ready(const Unit&) const {}
    __device__ __forceinline__ void done(const Unit&) const {}
};

__device__ __forceinline__ unsigned cvt_pk_bf16(float lo, float hi) { unsigned r; asm volatile("v_cvt_pk_bf16_f32 %0, %1, %2" : "=v"(r) : "v"(lo), "v"(hi)); return r; }
typedef float f32x2 __attribute__((ext_vector_type(2)));
typedef unsigned u32x2 __attribute__((ext_vector_type(2)));
struct EpiBf16 {
    static constexpr bool PERM = true, AFTER_DRAIN = false, PERMA = false;
    bf16_t* O; int ldc;
    __device__ __forceinline__ void operator()(const f32x4 (&acc)[2][2][4][2], const Unit& u, int wr, int wc, int fr, int fq) const {
        const int row0 = u.pm * BM + wr * 64 + fr; const int col0 = u.pn * BM + wc * 32 + 8 * fq;
#pragma unroll
        for (int ai = 0; ai < 2; ++ai)
#pragma unroll
            for (int m = 0; m < 4; ++m) { bf16_t* rowp = O + (size_t)(row0 + ai * HALF + m * 16) * ldc + col0;
#pragma unroll
                for (int bj = 0; bj < 2; ++bj) { const f32x4 v0 = acc[ai][bj][m][0], v1 = acc[ai][bj][m][1];
                    u32x4 w; w.x = cvt_pk_bf16(v0[0], v0[1]); w.y = cvt_pk_bf16(v0[2], v0[3]); w.z = cvt_pk_bf16(v1[0], v1[1]); w.w = cvt_pk_bf16(v1[2], v1[3]);
                    *(u32x4*)(rowp + bj * HALF) = w; } }
    }
};
template <bool REBUILD> struct EpiResBf {
    static constexpr bool PERM = true, AFTER_DRAIN = false, PERMA = false;
    const float* resf; const bf16_t* resb; bf16_t* out; const float* stat_; const float* g_; const float* b_;
    static constexpr int ldc = 1024; static constexpr float alpha = 1.4142135623730951f;
    __device__ __forceinline__ void operator()(const f32x4 (&acc)[2][2][4][2], const Unit& u, int wr, int wc, int fr, int fq) const {
        const float* stat = stat_; const float* g = g_; const float* b = b_; asm volatile("" : "+s"(stat), "+s"(g), "+s"(b));
        const int row0 = u.pm * BM + wr * 64 + fr; const int col0 = u.pn * BM + wc * 32 + 8 * fq;
#pragma unroll
        for (int bj = 0; bj < 2; ++bj) {
            const int col = col0 + bj * HALF;
            if (REBUILD) {
                const f32x4 g0 = *(const f32x4*)(g + col) * alpha, g1 = *(const f32x4*)(g + col + 4) * alpha, b0 = *(const f32x4*)(b + col) * alpha, b1 = *(const f32x4*)(b + col + 4) * alpha;
#pragma unroll
                for (int ai = 0; ai < 2; ++ai) {
                u32x4 rb[4]; f32x2 ms[4];
#pragma unroll
                for (int q = 0; q < 4; ++q) { const int row = row0 + ai * HALF + q * 16; rb[q] = *(const u32x4*)(resb + (size_t)row * ldc + col); ms[q] = *(const f32x2*)(stat + 2 * (size_t)row); }
#pragma unroll
                for (int q = 0; q < 4; ++q) { const int m = q; const int row = row0 + ai * HALF + m * 16;
                    f32x4 r0, r1; r0[0] = __uint_as_float(rb[q].x << 16); r0[1] = __uint_as_float(rb[q].x & 0xffff0000u); r0[2] = __uint_as_float(rb[q].y << 16); r0[3] = __uint_as_float(rb[q].y & 0xffff0000u);
                    r1[0] = __uint_as_float(rb[q].z << 16); r1[1] = __uint_as_float(rb[q].z & 0xffff0000u); r1[2] = __uint_as_float(rb[q].w << 16); r1[3] = __uint_as_float(rb[q].w & 0xffff0000u);
                    const f32x4 v0 = (r0 - ms[q].x) * ms[q].y * g0 + b0 + acc[ai][bj][m][0], v1 = (r1 - ms[q].x) * ms[q].y * g1 + b1 + acc[ai][bj][m][1];
                    u32x4 w; w.x = cvt_pk_bf16(v0[0], v0[1]); w.y = cvt_pk_bf16(v0[2], v0[3]); w.z = cvt_pk_bf16(v1[0], v1[1]); w.w = cvt_pk_bf16(v1[2], v1[3]);
                    *(u32x4*)(out + (size_t)row * ldc + col) = w; }
                }
            } else {
#pragma unroll
                for (int ai = 0; ai < 2; ++ai) {
                    f32x4 ra[4], rc[4];
#pragma unroll
                    for (int m = 0; m < 4; ++m) { const size_t off = (size_t)(row0 + ai * HALF + m * 16) * ldc + col; ra[m] = *(const f32x4*)(resf + off); rc[m] = *(const f32x4*)(resf + off + 4); }
#pragma unroll
                    for (int m = 0; m < 4; ++m) { const size_t off = (size_t)(row0 + ai * HALF + m * 16) * ldc + col;
                        const f32x4 v0 = ra[m] * alpha + acc[ai][bj][m][0], v1 = rc[m] * alpha + acc[ai][bj][m][1];
                        u32x4 w; w.x = cvt_pk_bf16(v0[0], v0[1]); w.y = cvt_pk_bf16(v0[2], v0[3]); w.z = cvt_pk_bf16(v1[0], v1[1]); w.w = cvt_pk_bf16(v1[2], v1[3]);
                        *(u32x4*)(out + off) = w; }
                }
            }
        }
    }
};
__device__ __forceinline__ float dpp_ror1(float v) { return __builtin_bit_cast(float, __builtin_amdgcn_update_dpp(0, __builtin_bit_cast(int, v), 0x121, 0xf, 0xf, false)); }
__device__ __forceinline__ float dpp_ror2(float v) { return __builtin_bit_cast(float, __builtin_amdgcn_update_dpp(0, __builtin_bit_cast(int, v), 0x122, 0xf, 0xf, false)); }
__device__ __forceinline__ float silu_f(float x) { return x * __builtin_amdgcn_rcpf(1.0f + __expf(-x)); }
__device__ __forceinline__ float dpp_shr1(float v) { return __builtin_bit_cast(float, __builtin_amdgcn_update_dpp(0, __builtin_bit_cast(int, v), 0x111, 0xf, 0xf, true)); }
struct EpiUpConv {
    static constexpr bool PERM = true, AFTER_DRAIN = false, PERMA = true;
    bf16_t* act; float* edge; const float* cw; const float* cb;
    __device__ __forceinline__ void operator()(const f32x4 (&acc)[2][2][4][2], const Unit& u, int wr, int wc, int fr, int fq) const {
        const int ch0 = u.pn * 128 + wc * 32 + 8 * fq;
        f32x4 w0[2][2], w1[2][2], w2[2][2], bb[2][2];
#pragma unroll
        for (int n = 0; n < 2; ++n)
#pragma unroll
            for (int bj = 0; bj < 2; ++bj) { const int col = bj * 2816 + ch0 + 4 * n;
                w0[n][bj] = *(const f32x4*)(cw + col); w1[n][bj] = *(const f32x4*)(cw + 5632 + col); w2[n][bj] = *(const f32x4*)(cw + 2 * 5632 + col); bb[n][bj] = *(const f32x4*)(cb + col); }
#pragma unroll
        for (int ai = 0; ai < 2; ++ai) {
            const int slab = u.pm * 4 + ai * 2 + wr;
            u32x2 pk[2][4];
#pragma unroll
            for (int n = 0; n < 2; ++n) {
                const int ch = ch0 + 4 * n;
                f32x4 hv[2][4];
#pragma unroll
                for (int bj = 0; bj < 2; ++bj) {
                    const int col = bj * 2816 + ch;
                    const f32x4 c0 = acc[ai][bj][0][n], c1 = acc[ai][bj][1][n], c2 = acc[ai][bj][2][n], c3 = acc[ai][bj][3][n];
                    f32x4 s2, s3;
#pragma unroll
                    for (int e = 0; e < 4; ++e) { s2[e] = dpp_shr1(c2[e]); s3[e] = dpp_shr1(c3[e]); }
                    hv[bj][0] = w2[n][bj] * c0 + w1[n][bj] * s3 + w0[n][bj] * s2 + bb[n][bj];
                    hv[bj][1] = w2[n][bj] * c1 + w1[n][bj] * c0 + w0[n][bj] * s3 + bb[n][bj];
                    hv[bj][2] = w2[n][bj] * c2 + w1[n][bj] * c1 + w0[n][bj] * c0 + bb[n][bj];
                    hv[bj][3] = w2[n][bj] * c3 + w1[n][bj] * c2 + w0[n][bj] * c1 + bb[n][bj];
                    if (fr == 0) { *(f32x4*)(edge + ((size_t)slab * 4 + 0) * 5632 + col) = c0; *(f32x4*)(edge + ((size_t)slab * 4 + 1) * 5632 + col) = c1; }
                    if (fr == 15) { *(f32x4*)(edge + ((size_t)slab * 4 + 2) * 5632 + col) = c2; *(f32x4*)(edge + ((size_t)slab * 4 + 3) * 5632 + col) = c3; }
                }
#pragma unroll
                for (int m = 0; m < 4; ++m) { pk[n][m].x = cvt_pk_bf16(silu_f(hv[0][m][0]) * hv[1][m][0], silu_f(hv[0][m][1]) * hv[1][m][1]); pk[n][m].y = cvt_pk_bf16(silu_f(hv[0][m][2]) * hv[1][m][2], silu_f(hv[0][m][3]) * hv[1][m][3]); }
            }
            const size_t row0 = (size_t)u.pm * BM + ai * HALF + wr * 64 + 4 * fr;
#pragma unroll
            for (int m = 0; m < 4; ++m) {
                if (!(m < 2 && fr == 0)) { u32x4 o; o.x = pk[0][m].x; o.y = pk[0][m].y; o.z = pk[1][m].x; o.w = pk[1][m].y; *(u32x4*)(act + (row0 + m) * 2816 + ch0) = o; }
            }
        }
    }
};
template <class Epi, class Sched, bool ALIGN_EPI = false, bool SP2 = false>
__device__ __forceinline__ void gemm_phase(PG8_LAS unsigned char* lds, const Gemm g, const Sched& S, const Epi& E) {
    const int tid = opaque_tid(), wid = __builtin_amdgcn_readfirstlane(tid >> 6), lane = tid & 63, wr = wid >> 2, wc = wid & 3, fr = lane & 15, fq = lane >> 4;
    const int K = g.K, nt = K / BK;
    unsigned voffA[2], voffB[2];
#pragma unroll
    for (int i = 0; i < 2; ++i) { int R, C; stage_rc(tid * 16 + i * 8192, R, C); const int Rb = Epi::PERM ? ((R & ~31) + perm32(R & 31)) : R;
        const int Ra = Epi::PERMA ? ((R & ~63) + 4 * (R & 15) + ((R >> 4) & 3)) : R;
        voffA[i] = (unsigned)(Ra * K + C) * 2u; voffB[i] = (unsigned)(Rb * K + C) * 2u; }
    const size_t kstep = (size_t)(BK * 2);
    const size_t hstep = (size_t)HALF * K * 2;
    const size_t tstep = 2 * hstep;
    const unsigned ldsw = (unsigned)wid * 1024u;
    const int aoff = lds_byte(wr * 64 + fr, fq * 8), boff = lds_byte(wc * 32 + fr, fq * 8);
#define PG8_SA(b, h) (((b) * 2 + (h)) * HTB)
#define PG8_SB(b, h) ((4 + (b) * 2 + (h)) * HTB)
#define PG8_STAGE(bufoff, gbase, voff) do { _Pragma("unroll") for (int _i = 0; _i < 2; ++_i) \
        __builtin_amdgcn_global_load_lds((const unsigned*)((const char*)(gbase) + (voff)[_i]), (PG8_LAS unsigned*)(lds + (bufoff) + ldsw + _i * 8192), 16, 0, 0); } while (0)
#define PG8_LDA(dst, b, h) do { _Pragma("unroll") for (int m = 0; m < 4; ++m) _Pragma("unroll") for (int k = 0; k < 2; ++k) dst[m][k] = *(const PG8_LAS bf16x8*)(lds + PG8_SA(b, h) + aoff + m * 2048 + k * 1024); } while (0)
#define PG8_LDB(dst, b, h) do { _Pragma("unroll") for (int n = 0; n < 2; ++n) _Pragma("unroll") for (int k = 0; k < 2; ++k) dst[n][k] = *(const PG8_LAS bf16x8*)(lds + PG8_SB(b, h) + boff + n * 2048 + k * 1024); } while (0)
#define PG8_MMA(ai, bj, At, Bt) do { __builtin_amdgcn_s_setprio(1); _Pragma("unroll") for (int m = 0; m < 4; ++m) _Pragma("unroll") for (int n = 0; n < 2; ++n) _Pragma("unroll") for (int k = 0; k < 2; ++k) \
        acc[ai][bj][m][n] = __builtin_amdgcn_mfma_f32_16x16x32_bf16(Bt[n][k], At[m][k], acc[ai][bj][m][n], 0, 0, 0); __builtin_amdgcn_s_setprio(0); } while (0)
#define PG8_WAIT_V(n) asm volatile("s_waitcnt vmcnt(" #n ")" ::: "memory")
#define PG8_WAIT_L(n) asm volatile("s_waitcnt lgkmcnt(" #n ")" ::: "memory")
#define PG8_BAR __builtin_amdgcn_s_barrier()
#define PG8_SCHED __builtin_amdgcn_sched_barrier(0)
    Unit cur, nxt; int ui = 0;
    if (!S.next(0, cur)) return;
    f32x4 acc[2][2][4][2];
#pragma unroll
    for (int a = 0; a < 2; ++a)
#pragma unroll
        for (int b = 0; b < 2; ++b)
#pragma unroll
            for (int m = 0; m < 4; ++m)
#pragma unroll
                for (int n = 0; n < 2; ++n) acc[a][b][m][n] = (f32x4){0.f, 0.f, 0.f, 0.f};
    bf16x8 At[4][2], B0[2][2], B1[2][2];
    const char* cA = (const char*)g.A + (size_t)cur.pm * tstep; const char* cB = (const char*)g.Bt + (size_t)cur.pn * tstep;
    S.a_ready(cur);
    if constexpr (SP2) {
        PG8_STAGE(PG8_SB(0, 0), cB, voffB); PG8_STAGE(PG8_SB(0, 1), cB + hstep, voffB); PG8_STAGE(PG8_SA(0, 0), cA, voffA); PG8_STAGE(PG8_SA(0, 1), cA + hstep, voffA);
        if (wr == 1) PG8_BAR;
        PG8_WAIT_V(2); PG8_BAR;
        PG8_STAGE(PG8_SB(1, 0), cB + kstep, voffB); PG8_STAGE(PG8_SA(1, 0), cA + kstep, voffA); PG8_STAGE(PG8_SB(1, 1), cB + hstep + kstep, voffB);
        PG8_WAIT_V(6); PG8_BAR;
    } else {
        PG8_STAGE(PG8_SB(0, 0), cB, voffB); PG8_STAGE(PG8_SA(0, 0), cA, voffA); PG8_STAGE(PG8_SB(0, 1), cB + hstep, voffB); PG8_STAGE(PG8_SA(0, 1), cA + hstep, voffA);
        if (wr == 1) PG8_BAR;
        PG8_WAIT_V(4); PG8_BAR;
        PG8_STAGE(PG8_SB(1, 0), cB + kstep, voffB); PG8_STAGE(PG8_SA(1, 0), cA + kstep, voffA); PG8_STAGE(PG8_SB(1, 1), cB + hstep + kstep, voffB);
        PG8_WAIT_V(6); PG8_BAR;
    }
    for (;;) {
        const bool has_next = S.next(ui + 1, nxt);
        const char* nA = has_next ? (const char*)g.A + (size_t)nxt.pm * tstep : cA; const char* nB = has_next ? (const char*)g.Bt + (size_t)nxt.pn * tstep : cB;
        for (int t = 0; t < nt; t += 2) {
            const bool last = (t == nt - 2);
            const char* a1 = cA + (size_t)(t + 1) * kstep;
            const char* a2 = last ? nA : cA + (size_t)(t + 2) * kstep; const char* b2 = last ? nB : cB + (size_t)(t + 2) * kstep;
            const char* a3 = a2 + kstep; const char* b3 = b2 + kstep;
            if (last && has_next) S.a_ready(nxt);
            if constexpr (SP2) {
            PG8_LDB(B0, 0, 0); PG8_LDB(B1, 0, 1); PG8_SCHED; PG8_LDA(At, 0, 0); PG8_STAGE(PG8_SA(1, 1), a1 + hstep, voffA);
            PG8_WAIT_V(8); PG8_WAIT_L(0); PG8_BAR; PG8_MMA(0, 0, At, B0); PG8_MMA(0, 1, At, B1); PG8_BAR; PG8_SCHED;
            PG8_LDA(At, 0, 1); PG8_STAGE(PG8_SB(0, 0), b2, voffB); PG8_STAGE(PG8_SB(0, 1), b2 + hstep, voffB); PG8_STAGE(PG8_SA(0, 0), a2, voffA);
            PG8_WAIT_V(8); PG8_WAIT_L(0); PG8_BAR; PG8_MMA(1, 0, At, B0); PG8_MMA(1, 1, At, B1); PG8_BAR; PG8_SCHED;
            PG8_LDB(B0, 1, 0); PG8_LDB(B1, 1, 1); PG8_SCHED; PG8_LDA(At, 1, 0); PG8_STAGE(PG8_SA(0, 1), a2 + hstep, voffA);
            PG8_WAIT_V(8); PG8_WAIT_L(0); PG8_BAR; PG8_MMA(0, 0, At, B0); PG8_MMA(0, 1, At, B1); PG8_BAR; PG8_SCHED;
            PG8_LDA(At, 1, 1); PG8_STAGE(PG8_SB(1, 0), b3, voffB); PG8_STAGE(PG8_SB(1, 1), b3 + hstep, voffB); PG8_STAGE(PG8_SA(1, 0), a3, voffA);
            PG8_WAIT_V(8); PG8_WAIT_L(0); PG8_BAR; PG8_MMA(1, 0, At, B0); PG8_MMA(1, 1, At, B1); PG8_BAR; PG8_SCHED;
            } else {
            PG8_LDB(B0, 0, 0); PG8_SCHED; PG8_LDA(At, 0, 0); PG8_STAGE(PG8_SA(1, 1), a1 + hstep, voffA);
            PG8_WAIT_L(8); PG8_BAR; PG8_WAIT_L(0); PG8_MMA(0, 0, At, B0); PG8_BAR; PG8_SCHED;
            PG8_LDB(B1, 0, 1); PG8_STAGE(PG8_SB(0, 0), b2, voffB);
            PG8_BAR; PG8_WAIT_L(0); PG8_MMA(0, 1, At, B1); PG8_BAR;
            PG8_LDA(At, 0, 1); PG8_STAGE(PG8_SA(0, 0), a2, voffA);
            PG8_BAR; PG8_WAIT_L(0); PG8_MMA(1, 0, At, B0); PG8_BAR; PG8_SCHED;
            PG8_STAGE(PG8_SB(0, 1), b2 + hstep, voffB);
            PG8_WAIT_V(6); PG8_BAR; PG8_MMA(1, 1, At, B1); PG8_BAR;
            PG8_LDB(B0, 1, 0); PG8_SCHED; PG8_LDA(At, 1, 0); PG8_STAGE(PG8_SA(0, 1), a2 + hstep, voffA);
            PG8_WAIT_L(8); PG8_BAR; PG8_WAIT_L(0); PG8_MMA(0, 0, At, B0); PG8_BAR; PG8_SCHED;
            PG8_LDB(B1, 1, 1); PG8_STAGE(PG8_SB(1, 0), b3, voffB);
            PG8_BAR; PG8_WAIT_L(0); PG8_MMA(0, 1, At, B1); PG8_BAR;
            PG8_LDA(At, 1, 1); PG8_STAGE(PG8_SA(1, 0), a3, voffA);
            PG8_BAR; PG8_WAIT_L(0); PG8_MMA(1, 0, At, B0); PG8_BAR; PG8_SCHED;
            PG8_STAGE(PG8_SB(1, 1), b3 + hstep, voffB);
            PG8_WAIT_V(6); PG8_BAR; PG8_MMA(1, 1, At, B1); PG8_BAR;
            }
        }
        if constexpr (ALIGN_EPI) { if (wr == 0) PG8_BAR; }
        if constexpr (!Epi::AFTER_DRAIN) { E(acc, cur, wr, wc, fr, fq); S.done(cur); }
        if (!has_next) break;
#pragma unroll
        for (int a = 0; a < 2; ++a)
#pragma unroll
            for (int b = 0; b < 2; ++b)
#pragma unroll
                for (int m = 0; m < 4; ++m)
#pragma unroll
                    for (int n = 0; n < 2; ++n) acc[a][b][m][n] = (f32x4){0.f, 0.f, 0.f, 0.f};
        cur = nxt; cA = nA; cB = nB; ++ui;
        if constexpr (ALIGN_EPI) { if (wr == 1) PG8_BAR; }
    }
    PG8_WAIT_V(0);
    if constexpr (!ALIGN_EPI) { if (wr == 0) PG8_BAR; }
    PG8_BAR;
    if constexpr (Epi::AFTER_DRAIN) { E.fused(acc, cur, wr, wc, fr, fq, lds, wid, lane); S.done(cur); }
#undef PG8_SA
#undef PG8_SB
#undef PG8_STAGE
#undef PG8_LDA
#undef PG8_LDB
#undef PG8_MMA
#undef PG8_WAIT_V
#undef PG8_WAIT_L
#undef PG8_BAR
#undef PG8_SCHED
}
}
#include <hip/hip_bf16.h>
#include <cmath>
namespace attn_body {
using bf16=__hip_bfloat16;
using bf16x8=__attribute__((ext_vector_type(8)))short;
using s16x4=__attribute__((ext_vector_type(4)))short;
using f32x16=__attribute__((ext_vector_type(16)))float;
using u32x4=__attribute__((ext_vector_type(4)))unsigned;
constexpr int BATCH=8,NHEAD=8,SEQ=4096,D=64,PQ=3840,PO=1024;
constexpr int NW=8,QBLK=32,QB=QBLK*NW,KVBLK=64,NQB=SEQ/QB;
constexpr int ATTN_UNIT_ROWS=QB;
__device__ __forceinline__ int crow(int r,int hi){return (r&3)+8*(r>>2)+4*hi;}
#define SBAR() __builtin_amdgcn_sched_barrier(0)
__device__ __forceinline__ void cmask(f32x16&p0,f32x16&p1,int jb,int qrel,int hi){
  const float NEG=-INFINITY; int kb=64*jb+4*hi;
  #pragma unroll
  for(int r=0;r<16;++r){int kv=kb+(r&3)+8*(r>>2); if(kv>qrel)p0[r]=NEG; if(kv+32>qrel)p1[r]=NEG;}
}

constexpr int NSLOT=3, SLOTB=8192, SEL_OFF=90112+64;
constexpr int LDS_K=0, LDS_V=NSLOT*SLOTB, LDS_WS=2*NSLOT*SLOTB, LDS_OST=LDS_WS+NW*64*4, LDS_BYTES=LDS_OST+NW*4096;
constexpr float C2=0.125f*1.4426950408889634f;
__device__ __forceinline__ void glds16(const void*gsrc,unsigned lds_dst){unsigned keep;
  asm volatile("s_mov_b32 %0, m0\n\ts_mov_b32 m0, %2\n\ts_nop 0\n\tglobal_load_lds_dwordx4 %1, off\n\ts_mov_b32 m0, %0":"=&s"(keep):"v"(gsrc),"s"(lds_dst):"memory");}
__device__ __forceinline__ float max3f(float a,float b,float c){float r;asm("v_max3_f32 %0, %1, %2, %3":"=v"(r):"v"(a),"v"(b),"v"(c));return r;}
__device__ __forceinline__ float max2f(float a,float b){float r;asm("v_max_f32_e32 %0, %1, %2":"=v"(r):"v"(a),"v"(b));return r;}
__device__ __forceinline__ float fadd_s(float a,float b){float r;asm("v_add_f32_e32 %0, %1, %2":"=v"(r):"v"(a),"v"(b));return r;}
__device__ __forceinline__ float fsub_s(float a,float b){float r;asm("v_sub_f32_e32 %0, %1, %2":"=v"(r):"v"(a),"v"(b));return r;}
typedef float f32x2_t __attribute__((ext_vector_type(2))); typedef __bf16 bf16x2_t __attribute__((ext_vector_type(2)));
__device__ __forceinline__ unsigned cvtpk_s(float lo,float hi){f32x2_t v={lo,hi};bf16x2_t b=__builtin_convertvector(v,bf16x2_t);return __builtin_bit_cast(unsigned,b);}
#define WAIT_BAR(N) asm volatile("s_waitcnt vmcnt(" #N ") lgkmcnt(0)\n\ts_barrier":::"memory")

__device__ __forceinline__ void qkt(f32x16&p0,f32x16&p1,const char*Kslot,const bf16x8*qr,const f32x16&negm,int r32,int hi){
  const char*kb=Kslot+hi*1024+r32*16;
  #pragma unroll
  for(int d0=0;d0<4;++d0){
    const bf16x8 b0=*reinterpret_cast<const bf16x8*>(kb+d0*2048);
    const bf16x8 b1=*reinterpret_cast<const bf16x8*>(kb+d0*2048+512);
    if(d0==0){p0=__builtin_amdgcn_mfma_f32_32x32x16_bf16(b0,qr[0],negm,0,0,0);p1=__builtin_amdgcn_mfma_f32_32x32x16_bf16(b1,qr[0],negm,0,0,0);}
    else{p0=__builtin_amdgcn_mfma_f32_32x32x16_bf16(b0,qr[d0],p0,0,0,0);p1=__builtin_amdgcn_mfma_f32_32x32x16_bf16(b1,qr[d0],p1,0,0,0);}}
}
typedef __attribute__((address_space(3))) const char* lds_cptr;
typedef short v4i16_t __attribute__((ext_vector_type(4)));
__device__ __forceinline__ void kload8(bf16x8*kf,lds_cptr kp){
  kf[0]=*(const __attribute__((address_space(3))) bf16x8*)(kp);      kf[1]=*(const __attribute__((address_space(3))) bf16x8*)(kp+512);
  kf[2]=*(const __attribute__((address_space(3))) bf16x8*)(kp+2048); kf[3]=*(const __attribute__((address_space(3))) bf16x8*)(kp+2560);
  kf[4]=*(const __attribute__((address_space(3))) bf16x8*)(kp+4096); kf[5]=*(const __attribute__((address_space(3))) bf16x8*)(kp+4608);
  kf[6]=*(const __attribute__((address_space(3))) bf16x8*)(kp+6144); kf[7]=*(const __attribute__((address_space(3))) bf16x8*)(kp+6656);
}
__device__ __forceinline__ void kload2(bf16x8*kf,lds_cptr kp,int j){ kf[2*j]=*(const __attribute__((address_space(3))) bf16x8*)(kp+j*2048); kf[2*j+1]=*(const __attribute__((address_space(3))) bf16x8*)(kp+j*2048+512); }
__device__ __forceinline__ s16x4 vtr(lds_cptr p){ return __builtin_bit_cast(s16x4,__builtin_amdgcn_ds_read_tr16_b64_v4i16((__attribute__((address_space(3))) v4i16_t*)p)); }
__device__ __forceinline__ float rowmax(const f32x16&p0,const f32x16&p1){
  float a=max3f(p0[0],p0[1],p1[0]),b=max3f(p0[2],p0[3],p1[1]);a=max3f(a,p1[2],p1[3]);
  #pragma unroll
  for(int r=4;r<16;r+=4){a=max3f(a,p0[r],p0[r+1]);b=max3f(b,p0[r+2],p0[r+3]);a=max3f(a,p1[r],p1[r+1]);b=max3f(b,p1[r+2],p1[r+3]);}
  const float m=max2f(a,b);
  auto rr=__builtin_amdgcn_permlane32_swap(__float_as_uint(m),__float_as_uint(m),false,false);
  return max2f(__uint_as_float(rr[0]),__uint_as_float(rr[1]));
}
__device__ __forceinline__ void pv(f32x16*o,int vb,bf16x8 pa0,bf16x8 pa1,bf16x8 pa2,bf16x8 pa3){
  #pragma unroll
  for(int d0=0;d0<2;++d0){s16x4 lo[4],hi[4];
    #pragma unroll
    for(int ks=0;ks<4;++ks){
      asm volatile("ds_read_b64_tr_b16 %0,%1 offset:%c2":"=&v"(lo[ks]):"v"(vb),"i"(d0*4096+ks*1024):"memory");
      asm volatile("ds_read_b64_tr_b16 %0,%1 offset:%c2":"=&v"(hi[ks]):"v"(vb),"i"(d0*4096+ks*1024+512):"memory");}
    asm volatile("s_waitcnt lgkmcnt(0)":::"memory");SBAR();
    #define PK(k) (bf16x8){lo[k][0],lo[k][1],lo[k][2],lo[k][3],hi[k][0],hi[k][1],hi[k][2],hi[k][3]}
    o[d0]=__builtin_amdgcn_mfma_f32_32x32x16_bf16(pa0,PK(0),o[d0],0,0,0);
    o[d0]=__builtin_amdgcn_mfma_f32_32x32x16_bf16(pa1,PK(1),o[d0],0,0,0);
    o[d0]=__builtin_amdgcn_mfma_f32_32x32x16_bf16(pa2,PK(2),o[d0],0,0,0);
    o[d0]=__builtin_amdgcn_mfma_f32_32x32x16_bf16(pa3,PK(3),o[d0],0,0,0);
    #undef PK
  }
}

#ifndef ATTN_STORE16
#define ATTN_STORE16(p,v) (*(u32x4*)(p)=(v))
#endif
template<int THRL,class SelF> __device__ __forceinline__ void attn_unit(int b,int h,int qb,const bf16*Q,const bf16*__restrict__ K,const bf16*__restrict__ V,bf16*O,char*shm,const SelF&selF){
  const int tid=opaque_tid(),lane=tid&63,r32=lane&31,hi=lane>>5; const int wid=__builtin_amdgcn_readfirstlane(tid>>6);
  const long rowbase=(long)b*SEQ; const int q0=qb*QB;
  const bf16*Qw=Q+(rowbase+q0+wid*QBLK)*PQ+h*D;
  const bf16*Kh=K+rowbase*PQ+h*D,*Vh=V+rowbase*PQ+h*D;
  const unsigned lds0=(unsigned)(uintptr_t)shm;
  float*wsf=(float*)(shm+LDS_WS)+wid*64;
  const bf16*ksrc=Kh+(long)lane*PQ+wid*8;
  const bf16*vsrc=Vh+(long)(16*(wid&3)+(lane>>2))*PQ+(wid>>2)*32+(lane&3)*8;
  const unsigned kdst=lds0+LDS_K+wid*1024, vdst=lds0+LDS_V+wid*1024;
  #define KT(t) (((t)<4)?(NT-4+(t)):((t)-4))
  #define DMA_K(t,slot) glds16(ksrc+(long)KT(t)*KVBLK*PQ,(unsigned)__builtin_amdgcn_readfirstlane(kdst+(slot)))
  #define DMA_V(t,slot) glds16(vsrc+(long)KT(t)*KVBLK*PQ,(unsigned)__builtin_amdgcn_readfirstlane(vdst+(slot)))
  const int vb0=(int)(lds0+LDS_V)+((lane>>4)&1)*32+(lane&3)*8+(4*hi+((lane&15)>>2))*64;
  const char*Kbase=shm+LDS_K; bf16x8 kf[8];
  const lds_cptr shm3=(lds_cptr)shm; const lds_cptr kp0=shm3+LDS_K+hi*1024+r32*16; const lds_cptr vp0=shm3+LDS_V+((lane>>4)&1)*32+(lane&3)*8+(4*hi+((lane&15)>>2))*64;
  const int NT=(q0+QB)/KVBLK;
  DMA_K(0,0);DMA_V(0,0);DMA_K(1,SLOTB);
  bf16x8 qr[4];
  #pragma unroll
  for(int d0=0;d0<4;++d0)qr[d0]=*reinterpret_cast<const bf16x8*>(&Qw[(long)r32*PQ+d0*16+hi*8]);
  selF(); asm volatile("s_waitcnt lgkmcnt(0)":::"memory");
  const unsigned selmask=((const unsigned*)(shm+SEL_OFF))[wid*QBLK+r32];
  float mhat=0.f,l_reg=0.f;f32x16 o[2];o[0]=f32x16{};o[1]=f32x16{};f32x16 negm=f32x16{};asm volatile("":"+v"(negm));
  const int qrel=wid*QBLK+r32;
  #define CMASK(P0,P1,t) do{const int t_=(t); if(t_<4){cmask(P0,P1,t_,qrel,hi);} else if(!((selmask>>((t_-4)>>2))&1u)){ _Pragma("unroll") for(int r_=0;r_<16;++r_){P0[r_]=-INFINITY;P1[r_]=-INFINITY;} } }while(0)
  bool resc=false;
  #define START(P0,P1) do{ const float rm=rowmax(P0,P1); resc=false; \
    { const float dl=rm; mhat=fadd_s(mhat,dl); \
      _Pragma("unroll") for(int r=0;r<16;++r){P0[r]=fsub_s(P0[r],dl);P1[r]=fsub_s(P1[r],dl);} \
      } \
    _Pragma("unroll") for(int r=0;r<16;++r)P0[r]=__builtin_amdgcn_exp2f(P0[r]); }while(0)
  #define RESC() do{ if(resc){ asm volatile("s_waitcnt lgkmcnt(0)":::"memory"); \
      _Pragma("unroll") for(int d_=0;d_<2;++d_) _Pragma("unroll") for(int r=0;r<16;++r)o[d_][r]*=wsf[crow(r,hi)]; } }while(0)
  f32x16 pA0,pA1,pB0,pB1;
  int sl_prev=0,sl_cur=0,sl_next=SLOTB;
  #define ROT() do{sl_prev=sl_cur;sl_cur=sl_next;sl_next=(sl_next==(NSLOT-1)*SLOTB)?0:sl_next+SLOTB;}while(0)
  DMA_K(2,2*SLOTB);
  WAIT_BAR(3);
  qkt(pA0,pA1,Kbase,qr,negm,r32,hi);asm volatile("s_nop 15\n\ts_nop 7":"+v"(pA0),"+v"(pA1));CMASK(pA0,pA1,0);
  START(pA0,pA1);
  _Pragma("unroll") for(int r=0;r<16;++r)pA1[r]=__builtin_amdgcn_exp2f(pA1[r]);
  WAIT_BAR(0);
  DMA_K(3,0);DMA_V(1,SLOTB);
  ROT();
  kload8(kf,kp0+sl_cur);
  WAIT_BAR(2);
  s16x4 vlo[8],vhi[8]; u32x4 pw0,pw1,pw2,pw3;
  #define PKW(P,B) cvtpk_s(P[B],P[B+1])
  #define PAF(k) __builtin_bit_cast(bf16x8,pw##k)
  #define VFR(i) (bf16x8){vlo[i][0],vlo[i][1],vlo[i][2],vlo[i][3],vhi[i][0],vhi[i][1],vhi[i][2],vhi[i][3]}
  #define PIN(x) asm volatile("":"+v"(x))
  #define MX3(a,b,c) __builtin_fmaxf(__builtin_fmaxf((a),(b)),(c))
  #define GAPA(MF,A0,A1,A2,A3,W0,W1,PW) do{ MF; sacc+=A0; sacc+=A1; sacc+=A2; sacc+=A3; PIN(sacc); W0; W1; PIN(PW); SBAR(); }while(0)
  #define EX(v) __builtin_amdgcn_exp2f(v)
  #define GAPB(MF,X,B) do{ MF; X[B]=EX(X[B]); X[B+1]=EX(X[B+1]); X[B+2]=EX(X[B+2]); X[B+3]=EX(X[B+3]); PIN(X); SBAR(); }while(0)
  #define VRD(i) do{ vlo[i]=vtr(vp_+(((i)>>2)*4096+((i)&3)*1024)); vhi[i]=vtr(vp_+(((i)>>2)*4096+((i)&3)*1024+512)); }while(0)
  #define KRD(G,j) do{ if(G){ kload2(kf,kp0+sl_next,j); SBAR(); } }while(0)
  #define STEP(C0,C1,P0,P1,t,GK,GV,GL) do{ \
    { const int t_=(t); if(((t_&3)==0)||resc||t_==1){ const float nm_=((t_<4)||((selmask>>((t_-4)>>2))&1u))?-mhat:-INFINITY; \
        _Pragma("unroll") for(int r=0;r<16;++r)negm[r]=nm_; asm volatile("":"+v"(negm)); } } \
    SBAR(); \
    const lds_cptr vp_=vp0+sl_prev; \
    VRD(0); SBAR(); float sacc=(P0[0]+P0[1]); \
    GAPA(C0=__builtin_amdgcn_mfma_f32_32x32x16_bf16(kf[0],qr[0],negm,0,0,0), P0[2],P0[3],P0[4],P0[5],     pw0[0]=PKW(P0,0), pw0[1]=PKW(P0,2), pw0); \
    VRD(4); SBAR(); GAPA(C1=__builtin_amdgcn_mfma_f32_32x32x16_bf16(kf[1],qr[0],negm,0,0,0), P0[6],P0[7],P0[8],P0[9],     pw0[2]=PKW(P0,4), pw0[3]=PKW(P0,6), pw0); \
    VRD(1); SBAR(); GAPA(C0=__builtin_amdgcn_mfma_f32_32x32x16_bf16(kf[2],qr[1],C0,0,0,0),   P0[10],P0[11],P0[12],P0[13], pw1[0]=PKW(P0,8), pw1[1]=PKW(P0,10), pw1); \
    VRD(5); SBAR(); GAPA(C1=__builtin_amdgcn_mfma_f32_32x32x16_bf16(kf[3],qr[1],C1,0,0,0),   P0[14],P0[15],P1[0],P1[1],   pw1[2]=PKW(P0,12),pw1[3]=PKW(P0,14), pw1); \
    VRD(2); SBAR(); GAPA(C0=__builtin_amdgcn_mfma_f32_32x32x16_bf16(kf[4],qr[2],C0,0,0,0),   P1[2],P1[3],P1[4],P1[5],     pw2[0]=PKW(P1,0), pw2[1]=PKW(P1,2), pw2); \
    VRD(6); SBAR(); GAPA(C1=__builtin_amdgcn_mfma_f32_32x32x16_bf16(kf[5],qr[2],C1,0,0,0),   P1[6],P1[7],P1[8],P1[9],     pw2[2]=PKW(P1,4), pw2[3]=PKW(P1,6), pw2); \
    VRD(3); SBAR(); GAPA(C0=__builtin_amdgcn_mfma_f32_32x32x16_bf16(kf[6],qr[3],C0,0,0,0),   P1[10],P1[11],P1[12],P1[13], pw3[0]=PKW(P1,8), pw3[1]=PKW(P1,10), pw3); \
    VRD(7); SBAR(); GAPA(C1=__builtin_amdgcn_mfma_f32_32x32x16_bf16(kf[7],qr[3],C1,0,0,0),   P1[14],P1[15],0.f,0.f,       pw3[2]=PKW(P1,12),pw3[3]=PKW(P1,14), pw3); \
    l_reg+=sacc; \
    if(GK){DMA_K((t)+3,sl_cur);} if(GV){DMA_V((t)+1,sl_next);} \
    { const int t_=(t); if(t_<4) cmask(C0,C1,t_,qrel,hi); } \
    { float a=MX3(C0[0],C0[1],C1[0]),b=MX3(C0[2],C0[3],C1[1]); a=MX3(a,C1[2],C1[3]); \
      _Pragma("unroll") for(int r=4;r<16;r+=4){a=MX3(a,C0[r],C0[r+1]);b=MX3(b,C0[r+2],C0[r+3]);a=MX3(a,C1[r],C1[r+1]);b=MX3(b,C1[r+2],C1[r+3]);} \
      float rm=__builtin_fmaxf(a,b); { auto rr=__builtin_amdgcn_permlane32_swap(__float_as_uint(rm),__float_as_uint(rm),false,false); rm=__builtin_fmaxf(__uint_as_float(rr[0]),__uint_as_float(rr[1])); } \
      resc=false; \
      if(__builtin_expect(__any(rm>(float)THRL),0)){ const float dl=__builtin_fmaxf(rm,0.f); mhat+=dl; \
        _Pragma("unroll") for(int r=0;r<16;++r){C0[r]-=dl;C1[r]-=dl;} \
        const float f=__builtin_amdgcn_exp2f(-dl); l_reg*=f; if(hi==0)wsf[r32]=f; resc=true; } } \
    SBAR(); \
    GAPB(o[0]=__builtin_amdgcn_mfma_f32_32x32x16_bf16(PAF(0),VFR(0),o[0],0,0,0), C0,0); \
    GAPB(o[1]=__builtin_amdgcn_mfma_f32_32x32x16_bf16(PAF(0),VFR(4),o[1],0,0,0), C0,4); \
    KRD(GL,0); GAPB(o[0]=__builtin_amdgcn_mfma_f32_32x32x16_bf16(PAF(1),VFR(1),o[0],0,0,0), C0,8); \
    KRD(GL,1); GAPB(o[1]=__builtin_amdgcn_mfma_f32_32x32x16_bf16(PAF(1),VFR(5),o[1],0,0,0), C0,12); \
    KRD(GL,2); GAPB(o[0]=__builtin_amdgcn_mfma_f32_32x32x16_bf16(PAF(2),VFR(2),o[0],0,0,0), C1,0); \
    KRD(GL,3); GAPB(o[1]=__builtin_amdgcn_mfma_f32_32x32x16_bf16(PAF(2),VFR(6),o[1],0,0,0), C1,4); \
    GAPB(o[0]=__builtin_amdgcn_mfma_f32_32x32x16_bf16(PAF(3),VFR(3),o[0],0,0,0), C1,8); \
    GAPB(o[1]=__builtin_amdgcn_mfma_f32_32x32x16_bf16(PAF(3),VFR(7),o[1],0,0,0), C1,12); \
    }while(0)
  int t=1;
  for(;t+5<NT;t+=2){
    STEP(pB0,pB1,pA0,pA1,t,true,true,true);     WAIT_BAR(2); RESC(); ROT();
    STEP(pA0,pA1,pB0,pB1,t+1,true,true,true);   WAIT_BAR(2); RESC(); ROT();
  }
  #define ENDW(tt) do{ if((tt)+3<NT){WAIT_BAR(2);} else if((tt)+2<NT){WAIT_BAR(1);} else {WAIT_BAR(0);} }while(0)
  for(;t+1<NT;t+=2){
    STEP(pB0,pB1,pA0,pA1,t,(t+3<NT),(t+1<NT),(t+1<NT));       ENDW(t);   RESC(); ROT();
    STEP(pA0,pA1,pB0,pB1,t+1,(t+4<NT),(t+2<NT),(t+2<NT));     ENDW(t+1); RESC(); ROT();
  }
  STEP(pB0,pB1,pA0,pA1,NT-1,false,false,false); RESC();
  { float sacc=pB0[0]+pB0[1]; _Pragma("unroll") for(int r=2;r<16;++r)sacc+=pB0[r]; _Pragma("unroll") for(int r=0;r<16;++r)sacc+=pB1[r]; l_reg+=sacc;
    pw0=(u32x4){PKW(pB0,0),PKW(pB0,2),PKW(pB0,4),PKW(pB0,6)};pw1=(u32x4){PKW(pB0,8),PKW(pB0,10),PKW(pB0,12),PKW(pB0,14)};pw2=(u32x4){PKW(pB1,0),PKW(pB1,2),PKW(pB1,4),PKW(pB1,6)};pw3=(u32x4){PKW(pB1,8),PKW(pB1,10),PKW(pB1,12),PKW(pB1,14)};
    SBAR(); pv(o,vb0+sl_cur,PAF(0),PAF(1),PAF(2),PAF(3)); }
  #undef PKW
  #undef PAF
  #undef VFR
  #undef PIN
  #undef MX3
  #undef GAPA
  #undef GAPB
  #undef EX
  #undef VRD
  #undef KRD
  #undef STEP
  #undef ENDW
  {auto rr=__builtin_amdgcn_permlane32_swap(__float_as_uint(l_reg),__float_as_uint(l_reg),false,false);l_reg=__uint_as_float(rr[0])+__uint_as_float(rr[1]);}
  if(hi==0)wsf[32+r32]=l_reg;asm volatile("s_waitcnt lgkmcnt(0)":::"memory");
  float rli[16];
  #pragma unroll
  for(int r=0;r<16;++r)rli[r]=__builtin_amdgcn_rcpf(wsf[32+crow(r,hi)]);
  bf16*Ow=O+(rowbase+q0+wid*QBLK)*PO+h*D;
  { bf16*stg=(bf16*)(shm+LDS_OST)+wid*2048;
    #pragma unroll
    for(int r=0;r<16;++r){const int orow=crow(r,hi);
      #pragma unroll
      for(int d0=0;d0<2;++d0)stg[orow*64+d0*32+r32]=__float2bfloat16(o[d0][r]*rli[r]);}
    asm volatile("s_waitcnt lgkmcnt(0)":::"memory");
    #pragma unroll
    for(int i=0;i<4;++i){const int row=i*8+(lane>>3),ch=lane&7; const u32x4 v=*(const u32x4*)(stg+row*64+ch*8); ATTN_STORE16(Ow+(long)row*PO+ch*8,v);} }
  asm volatile("s_waitcnt lgkmcnt(0)\n\ts_barrier":::"memory");
  #undef DMA_K
  #undef KT
  #undef DMA_V
  #undef CMASK
  #undef START
  #undef RESC
  #undef ROT
}
constexpr int ATTN_LDS_BYTES=LDS_BYTES;
struct AttnTensors { const bf16* Q; const bf16* K; const bf16* V; bf16* O; };
#undef SBAR
#undef WAIT_BAR
}
typedef unsigned short bf16;
typedef unsigned v4u __attribute__((ext_vector_type(4)));
typedef unsigned v2u __attribute__((ext_vector_type(2)));
typedef float f32x4 __attribute__((ext_vector_type(4)));
typedef short bf16x8 __attribute__((ext_vector_type(8)));
constexpr int NB = 8, SEQL = 4096, DMODEL = 1024, NLAYER = 2, MTOK = NB * SEQL;
constexpr int NIN = 3592, NINP = 3840, DFF = 2816, NUP = 5632;
constexpr int C_QA = 0, C_KA = 512, C_VA = 1024, C_Z = 1536, C_QB = 2048, C_KB = 2560, C_VB = 3072, C_AL = 3584, C_BL = 3588;
constexpr float ALPHA = 1.4142135623730951f, LN_EPS = 1e-5f, NORM_EPS = 1e-6f;
constexpr size_t MiB = 1u << 20;
constexpr size_t WS_CTL = 0, WS_KMEAN = 256 * 1024, WS_GLAST = 512 * 1024, WS_STAT = 576 * 1024;
constexpr size_t WS_W = 1 * MiB, W_LAYER = 26 * MiB, W_IN = 0, W_OUT = 7864320, W_UP = W_OUT + 2 * MiB, W_DOWN = W_UP + 11 * MiB;
constexpr size_t WS_XBF = 53 * MiB;
constexpr size_t WS_PROJ = 117 * MiB;
constexpr size_t WS_GDN = 357 * MiB;
constexpr size_t WS_YX = WS_PROJ;
constexpr size_t WS_ACT = 245 * MiB;
constexpr size_t WS_EDGE = 421 * MiB;
constexpr size_t WS_ROPE = 501 * MiB;
constexpr size_t WS_END = 502 * MiB;
constexpr int CHUNK_REC = 73728;
constexpr int LDS_BYTES = 155648;
constexpr int NTHREADS = 512;

__device__ __forceinline__ float bf2f(unsigned short u) { return __uint_as_float(((unsigned)u) << 16); }
typedef float pk_f32x2 __attribute__((ext_vector_type(2))); typedef __bf16 pk_bf16x2 __attribute__((ext_vector_type(2)));
__device__ __forceinline__ unsigned pk2(float lo, float hi) { const pk_f32x2 v = {lo, hi}; const pk_bf16x2 b = __builtin_convertvector(v, pk_bf16x2); return __builtin_bit_cast(unsigned, b); }
__device__ __forceinline__ unsigned f2bf(float f) { return pk2(f, 0.f); }
__device__ __forceinline__ float wave_sum(float v) {
#pragma unroll
    for (int o = 1; o < 64; o <<= 1) v += __shfl_xor(v, o);
    return v;
}
__device__ __forceinline__ f32x4 mfma16(bf16x8 a, bf16x8 b, f32x4 c) { return __builtin_amdgcn_mfma_f32_16x16x32_bf16(a, b, c, 0, 0, 0); }

template <int MAPID> __device__ __forceinline__ int wmap(int n) {
    if (MAPID == 0) return n;
    if (MAPID == 1) { if (n < 1536) return n; if (n < 3584) return n + 8; if (n < 3592) return n - 3584 + 1536; return -1; }
    { const int pn = n >> 8, rem = n & 255; return (rem >> 7) * DFF + pn * 128 + (rem & 127); }
}
template <int MAPID> __device__ __forceinline__ void transpose_item(const float* W, int K, int N, int NP, bf16* WT, float* scr, int item, int lane) {
    const int nblk = NP / 32, kb = item / nblk, nb = item % nblk, k0 = 64 * kb, n0 = 32 * nb;
    const int src = wmap<MAPID>(n0 + (lane & 31));
#pragma unroll
    for (int i = 0; i < 32; ++i) { const int kk = 2 * i + (lane >> 5); scr[kk * 33 + (lane & 31)] = (src >= 0) ? W[(size_t)(k0 + kk) * N + src] : 0.f; }
    asm volatile("s_waitcnt lgkmcnt(0)" ::: "memory");
    const int c = lane & 7;
#pragma unroll
    for (int j = 0; j < 4; ++j) { const int n = (lane >> 3) + 8 * j; const float* s = scr + (8 * c) * 33 + n;
        v4u o; o.x = pk2(s[0 * 33], s[1 * 33]); o.y = pk2(s[2 * 33], s[3 * 33]); o.z = pk2(s[4 * 33], s[5 * 33]); o.w = pk2(s[6 * 33], s[7 * 33]);
        *(v4u*)(WT + (size_t)(n0 + n) * K + k0 + 8 * c) = o; }
    asm volatile("s_waitcnt lgkmcnt(0)" ::: "memory");
}
struct Ptrs {
    const float *x, *w_in, *conv_w, *a_log, *dt_bias, *norm_g, *w_out, *ln1_g, *ln1_b, *w_up, *fconv_w, *fconv_b, *w_down, *ln2_g, *ln2_b;
    float* out; unsigned char* ws;
};
__device__ __forceinline__ void p0_prologue(const Ptrs& P, unsigned char* lds, int G) {
    const int tid = opaque_tid(), lane = tid & 63, wave = __builtin_amdgcn_readfirstlane(tid >> 6);
    if (wave < 4) {
        float* scr = (float*)(lds + wave * 16384);
        const int gw = blockIdx.x * 4 + wave, NGW = G * 4;
        constexpr int I_IN = 16 * (NINP / 32), I_OUT = 16 * 32, I_UP = 16 * (NUP / 32), I_DN = (DFF / 64) * 32, I_L = I_IN + I_OUT + I_UP + I_DN;
        for (int it = gw; it < NLAYER * I_L; it += NGW) {
            const int l = it / I_L; int r = it % I_L;
            unsigned char* wb = P.ws + WS_W + (size_t)l * W_LAYER;
            if (r < I_IN) { transpose_item<1>(P.w_in + (size_t)l * DMODEL * NIN, DMODEL, NIN, NINP, (bf16*)(wb + W_IN), scr, r, lane); continue; } r -= I_IN;
            if (r < I_OUT) { transpose_item<0>(P.w_out + (size_t)l * DMODEL * DMODEL, DMODEL, DMODEL, DMODEL, (bf16*)(wb + W_OUT), scr, r, lane); continue; } r -= I_OUT;
            if (r < I_UP) { transpose_item<2>(P.w_up + (size_t)l * DMODEL * NUP, DMODEL, NUP, NUP, (bf16*)(wb + W_UP), scr, r, lane); continue; } r -= I_UP;
            transpose_item<0>(P.w_down + (size_t)l * DFF * DMODEL, DFF, DMODEL, DMODEL, (bf16*)(wb + W_DOWN), scr, r, lane);
        }
    } else {
        const int t2 = tid - 256, NT2 = G * 256;
        for (int e = blockIdx.x * 256 + t2; e < SEQL * 8; e += NT2) {
            const int pos = e >> 3, i = e & 7; const float inv = powf(500000.0f, -(float)i / 8.0f);
            float sn, cs; sincosf((float)pos * inv, &sn, &cs);
            pg8::f32x2 t; t.x = cs; t.y = sn; ((pg8::f32x2*)(P.ws + WS_ROPE))[e] = t;
        }
        bf16* xb = (bf16*)(P.ws + WS_XBF);
        const size_t nvec = (size_t)MTOK * DMODEL / 8;
#pragma unroll 4
        for (size_t v = (size_t)blockIdx.x * 256 + t2; v < nvec; v += (size_t)NT2) {
            const f32x4 a = *(const f32x4*)(P.x + v * 8), b = *(const f32x4*)(P.x + v * 8 + 4);
            v4u o; o.x = pk2(a[0], a[1]); o.y = pk2(a[2], a[3]); o.z = pk2(b[0], b[1]); o.w = pk2(b[2], b[3]);
            *(v4u*)(xb + v * 8) = o;
        }
    }
}

__device__ __forceinline__ void ln_phase(const bf16* y, float* outf, bf16* outb, float* stat, const float* gam, const float* bet, int G) {
    const int tid = opaque_tid(), lane = tid & 63, wave = tid >> 6;
    f32x4 gv[4], bv[4];
#pragma unroll
    for (int j = 0; j < 4; ++j) { const int c = (j >> 1) * 512 + 8 * lane + 4 * (j & 1); gv[j] = *(const f32x4*)(gam + c); bv[j] = *(const f32x4*)(bet + c); }
    for (int m = blockIdx.x * 8 + wave; m < MTOK; m += G * 8) {
        const bf16* yr = y + (size_t)m * DMODEL + 8 * lane;
        const v4u a = *(const v4u*)yr, b2 = *(const v4u*)(yr + 512);
        f32x4 v[4]; float s = 0.f;
        v[0][0] = __uint_as_float(a[0] << 16); v[0][1] = __uint_as_float(a[0] & 0xffff0000u); v[0][2] = __uint_as_float(a[1] << 16); v[0][3] = __uint_as_float(a[1] & 0xffff0000u);
        v[1][0] = __uint_as_float(a[2] << 16); v[1][1] = __uint_as_float(a[2] & 0xffff0000u); v[1][2] = __uint_as_float(a[3] << 16); v[1][3] = __uint_as_float(a[3] & 0xffff0000u);
        v[2][0] = __uint_as_float(b2[0] << 16); v[2][1] = __uint_as_float(b2[0] & 0xffff0000u); v[2][2] = __uint_as_float(b2[1] << 16); v[2][3] = __uint_as_float(b2[1] & 0xffff0000u);
        v[3][0] = __uint_as_float(b2[2] << 16); v[3][1] = __uint_as_float(b2[2] & 0xffff0000u); v[3][2] = __uint_as_float(b2[3] << 16); v[3][3] = __uint_as_float(b2[3] & 0xffff0000u);
#pragma unroll
        for (int j = 0; j < 4; ++j) s += (v[j][0] + v[j][1]) + (v[j][2] + v[j][3]);
        const float mean = wave_sum(s) * (1.f / DMODEL); float s2 = 0.f;
#pragma unroll
        for (int j = 0; j < 4; ++j) { v[j] = v[j] - mean; s2 += (v[j][0] * v[j][0] + v[j][1] * v[j][1]) + (v[j][2] * v[j][2] + v[j][3] * v[j][3]); }
        const float rstd = 1.f / sqrtf(wave_sum(s2) * (1.f / DMODEL) + LN_EPS);
        if (stat != nullptr && lane == 0) { pg8::f32x2 ms; ms.x = mean; ms.y = rstd; *(pg8::f32x2*)(stat + 2 * (size_t)m) = ms; }
        f32x4 o[4];
#pragma unroll
        for (int j = 0; j < 4; ++j) o[j] = v[j] * rstd * gv[j] + bv[j];
        if (outf != nullptr) { float* of = outf + (size_t)m * DMODEL + 8 * lane; *(f32x4*)of = o[0]; *(f32x4*)(of + 4) = o[1]; *(f32x4*)(of + 512) = o[2]; *(f32x4*)(of + 516) = o[3]; }
        if (outb != nullptr) { bf16* ob = outb + (size_t)m * DMODEL + 8 * lane; v4u w0, w1; w0[0] = pk2(o[0][0], o[0][1]); w0[1] = pk2(o[0][2], o[0][3]); w0[2] = pk2(o[1][0], o[1][1]); w0[3] = pk2(o[1][2], o[1][3]);
            w1[0] = pk2(o[2][0], o[2][1]); w1[1] = pk2(o[2][2], o[2][3]); w1[2] = pk2(o[3][0], o[3][1]); w1[3] = pk2(o[3][2], o[3][3]); *(v4u*)ob = w0; *(v4u*)(ob + 512) = w1; }
    }
}

__device__ __forceinline__ void fix_phase(const float* edge, bf16* act, const float* cw, const float* cb, int G) {
    const int total = 512 * 2 * (DFF / 4);
    const int tid = opaque_tid();
    for (int it = blockIdx.x * NTHREADS + tid; it < total; it += G * NTHREADS) {
        const int c4 = it % (DFF / 4), rr = (it / (DFF / 4)) & 1, s = it / (DFF / 2);
        const int ch = 4 * c4; const bool first = (s % 64) == 0;
        f32x4 h[2];
#pragma unroll
        for (int bj = 0; bj < 2; ++bj) {
            const int col = bj * DFF + ch;
            const f32x4 z4 = (f32x4){0.f, 0.f, 0.f, 0.f};
            const f32x4 cur = *(const f32x4*)(edge + ((size_t)s * 4 + rr) * NUP + col);
            f32x4 p1, p2;
            if (rr == 1) { p1 = *(const f32x4*)(edge + ((size_t)s * 4 + 0) * NUP + col); p2 = first ? z4 : *(const f32x4*)(edge + ((size_t)(s - 1) * 4 + 3) * NUP + col); }
            else { p1 = first ? z4 : *(const f32x4*)(edge + ((size_t)(s - 1) * 4 + 3) * NUP + col); p2 = first ? z4 : *(const f32x4*)(edge + ((size_t)(s - 1) * 4 + 2) * NUP + col); }
            h[bj] = *(const f32x4*)(cw + 2 * NUP + col) * cur + *(const f32x4*)(cw + NUP + col) * p1 + *(const f32x4*)(cw + col) * p2 + *(const f32x4*)(cb + col);
        }
        v2u o; o.x = pk2(pg8::silu_f(h[0][0]) * h[1][0], pg8::silu_f(h[0][1]) * h[1][1]); o.y = pk2(pg8::silu_f(h[0][2]) * h[1][2], pg8::silu_f(h[0][3]) * h[1][3]);
        *(v2u*)(act + ((size_t)s * 64 + rr) * DFF + ch) = o;
    }
}

__device__ __forceinline__ void logits_group(int grp, const bf16* xb, const bf16* wt, bf16* proj) {
    const int tid = opaque_tid(), lane = tid & 63, wid = tid >> 6, g = lane >> 4, ln = lane & 15;
    const bf16* ap = xb + ((size_t)grp * 128 + wid * 16 + ln) * DMODEL + 8 * g;
    const bf16* bp = wt + (size_t)(3584 + ln) * DMODEL + 8 * g;
    f32x4 acc0 = (f32x4){0.f, 0.f, 0.f, 0.f}, acc1 = acc0;
#pragma unroll 1
    for (int k16 = 0; k16 < 2; ++k16) {
        bf16x8 fa[16], fb[16];
#pragma unroll
        for (int kk = 0; kk < 16; ++kk) { const int ko = (k16 * 16 + kk) * 32; fa[kk] = *(const bf16x8*)(ap + ko); fb[kk] = *(const bf16x8*)(bp + ko); }
#pragma unroll
        for (int kk = 0; kk < 16; kk += 2) { acc0 = mfma16(fa[kk], fb[kk], acc0); acc1 = mfma16(fa[kk + 1], fb[kk + 1], acc1); }
    }
    const f32x4 acc = acc0 + acc1;
    if (ln < 8) {
#pragma unroll
        for (int j = 0; j < 4; ++j) proj[((size_t)grp * 128 + wid * 16 + 4 * g + j) * NINP + 3584 + ln] = (bf16)f2bf(acc[j]);
    }
}

__device__ __forceinline__ void moba_prep_item(bf16* proj, float* kmean, const float* rope, int item, unsigned char* lds) {
    const int tid = opaque_tid(); const int j = item & 15, h = (item >> 4) & 7, b = item >> 7;
    const int r = tid >> 1, part = tid & 1;
    float* tile = (float*)lds;
    float* psum = (float*)(lds + 256 * 65 * 4);
    const int pos = 256 * j + r;
    bf16* qp = proj + ((size_t)b * SEQL + pos) * NINP + C_QB + h * 64 + 32 * part;
    bf16* kp = proj + ((size_t)b * SEQL + pos) * NINP + C_KB + h * 64 + 32 * part;
    float q[32], k[32];
#pragma unroll
    for (int v = 0; v < 4; ++v) { const v4u a = *(const v4u*)(qp + 8 * v), c = *(const v4u*)(kp + 8 * v);
#pragma unroll
        for (int e = 0; e < 4; ++e) { q[8 * v + 2 * e] = bf2f((unsigned short)(a[e] & 0xffffu)); q[8 * v + 2 * e + 1] = bf2f((unsigned short)(a[e] >> 16));
                                      k[8 * v + 2 * e] = bf2f((unsigned short)(c[e] & 0xffffu)); k[8 * v + 2 * e + 1] = bf2f((unsigned short)(c[e] >> 16)); } }
    if (part == 0) {
#pragma unroll
        for (int i = 0; i < 8; ++i) {
            const pg8::f32x2 t2 = ((const pg8::f32x2*)rope)[pos * 8 + i]; const float cs = t2.x, sn = t2.y;
            const float q1 = q[i], q2 = q[i + 8], k1 = k[i], k2 = k[i + 8];
            q[i] = q1 * cs - q2 * sn; q[i + 8] = q2 * cs + q1 * sn; k[i] = k1 * cs - k2 * sn; k[i + 8] = k2 * cs + k1 * sn;
        }
    }
    const float C2 = 0.125f * 1.4426950408889634f;
#pragma unroll
    for (int v = 0; v < 4; ++v) { v4u a, c;
#pragma unroll
        for (int e = 0; e < 4; ++e) { a[e] = pk2(q[8 * v + 2 * e] * C2, q[8 * v + 2 * e + 1] * C2); c[e] = pk2(k[8 * v + 2 * e], k[8 * v + 2 * e + 1]); }
        *(v4u*)(qp + 8 * v) = a; *(v4u*)(kp + 8 * v) = c; }
#pragma unroll
    for (int i = 0; i < 32; ++i) tile[r * 65 + 32 * part + i] = k[i];
    __syncthreads();
    { const int d = tid & 63, seg = tid >> 6; float s = 0.f;
#pragma unroll 8
      for (int rr = 0; rr < 32; ++rr) s += tile[(seg * 32 + rr) * 65 + d];
      psum[seg * 64 + d] = s; }
    __syncthreads();
    if (tid < 64) { float s = 0.f;
#pragma unroll
        for (int w = 0; w < 8; ++w) s += psum[w * 64 + tid];
        const float mv = s * (1.0f / 256.0f); const unsigned hb = pk2(mv, 0.f) & 0xffffu; const float hf = __uint_as_float(hb << 16);
        bf16* kmh = (bf16*)kmean; const size_t ix = ((size_t)(b * 8 + h) * 16 + j) * 64 + tid;
        kmh[ix] = (bf16)hb; kmh[ix + 65536] = (bf16)pk2(mv - hf, 0.f); }
    __syncthreads();
}

constexpr int GSC_OFF = 98304;
__device__ __forceinline__ void moba_select(int b, int h, int qb, const bf16* proj, const bf16* kmh_bh, unsigned char* lds) {
    const int tid = opaque_tid(), lane = tid & 63, wid = tid >> 6, g = lane >> 4, ln = lane & 15;
    const bf16* qp = proj + ((size_t)b * SEQL + qb * 256 + wid * 32 + ln) * NINP + C_QB + h * 64 + 8 * g;
    bf16x8 fa[2][2], fh[2], fl[2];
#pragma unroll
    for (int mt = 0; mt < 2; ++mt)
#pragma unroll
        for (int kk = 0; kk < 2; ++kk) fa[mt][kk] = *(const bf16x8*)(qp + (size_t)mt * 16 * NINP + 32 * kk);
#pragma unroll
    for (int kk = 0; kk < 2; ++kk) { fh[kk] = *(const bf16x8*)(kmh_bh + ln * 64 + 32 * kk + 8 * g); fl[kk] = *(const bf16x8*)(kmh_bh + 65536 + ln * 64 + 32 * kk + 8 * g); }
    float* gsc = (float*)(lds + GSC_OFF) + wid * (32 * 17);
#pragma unroll
    for (int mt = 0; mt < 2; ++mt) {
        f32x4 a = (f32x4){0.f, 0.f, 0.f, 0.f};
#pragma unroll
        for (int kk = 0; kk < 2; ++kk) { a = mfma16(fa[mt][kk], fl[kk], a); a = mfma16(fa[mt][kk], fh[kk], a); }
#pragma unroll
        for (int j = 0; j < 4; ++j) gsc[(16 * mt + 4 * g + j) * 17 + ln] = a[j];
    }
    asm volatile("s_waitcnt lgkmcnt(0)" ::: "memory");
    if (lane < 32) {
        float gate[16];
#pragma unroll
        for (int j = 0; j < 16; ++j) gate[j] = gsc[lane * 17 + j];
        unsigned selmask = 0u;
#pragma unroll
        for (int rk = 0; rk < 3; ++rk) { float best = -INFINITY; int bi = -1;
#pragma unroll
            for (int j = 0; j < 16; ++j) { const bool ok = (j < qb) && !((selmask >> j) & 1u) && (gate[j] > best); if (ok) { best = gate[j]; bi = j; } }
            if (bi >= 0) selmask |= (1u << bi); }
        ((unsigned*)(lds + attn_body::SEL_OFF))[wid * 32 + lane] = selmask;
    }
}
struct SelCall { int b, h, qb; const bf16* proj; const bf16* kmh; unsigned char* lds; __device__ __forceinline__ void operator()() const { moba_select(b, h, qb, proj, kmh, lds); } };
namespace gdn {
constexpr int LQD = 0, LQN = 17408, LKN = 34816, LVBT = 52224, LKBG = 70656, LKDT = 89088, LAF = 107520, LTINV = 124928, LATT = 134144, LGATE = 143360, LSLOT5 = 144384;
constexpr int SLOT0 = LQN, SLOT1 = LQN + 9216, SLOT2 = LQN + 18432;
constexpr int SQ = 136, ST = 72, SA = 68;
__device__ __forceinline__ bf16x8 ld16(const unsigned char* p) { return *(const bf16x8*)p; }

__device__ __forceinline__ void prep_load(v4u (&X)[3][4][2], float& al, float& bl, const bf16* proj, int it, int tid) {
    const int n = it & 63, h = (it >> 6) & 3, b = it >> 8; const int t0 = n * 64; const size_t rowb = (size_t)b * SEQL;
    const int r = tid >> 3, part = tid & 7;
#pragma unroll
    for (int sec = 0; sec < 3; ++sec)
#pragma unroll
        for (int off = 0; off < 4; ++off) {
            const int t = t0 + r - 3 + off; const int tc = t < 0 ? 0 : t;
            const bf16* xp = proj + (rowb + tc) * NINP + sec * 512 + h * 128 + part * 16;
            X[sec][off][0] = *(const v4u*)xp; X[sec][off][1] = *(const v4u*)(xp + 8);
        }
    const bf16* pr = proj + (rowb + t0 + (tid & 63)) * NINP;
    al = bf2f(pr[C_AL + h]); bl = bf2f(pr[C_BL + h]);
}
__device__ __forceinline__ void prep_item(v4u (&X)[3][4][2], float& al_in, float& bl_in, int nit, const float (&wreg)[3], const bf16* proj, unsigned char* rec, float* glast_out, float a_log_h, float dt_bias_h, int b, int h, int n, unsigned char* lds) {
    const int tid = opaque_tid(), lane = tid & 63, wid = tid >> 6, g = lane >> 4, ln = lane & 15;
    bf16* Qn = (bf16*)(lds + LQN); bf16* Qd = (bf16*)(lds + LQD); bf16* Kn = (bf16*)(lds + LKN);
    bf16* VbT = (bf16*)(lds + LVBT); bf16* KbgT = (bf16*)(lds + LKBG); bf16* KdT = (bf16*)(lds + LKDT);
    float* Af = (float*)(lds + LAF); bf16* Wl = (bf16*)(lds + LAF); bf16* Tinv = (bf16*)(lds + SLOT0);     bf16* Att = (bf16*)(lds + LATT);
    float* gcum = (float*)(lds + LGATE); float* beta = gcum + 64; float* expg = gcum + 128; float* kdf = gcum + 192;
    const int t0 = n * 64; const size_t rowb = (size_t)b * SEQL;
    {
        float* wl = (float*)(lds + LAF);
#pragma unroll
        for (int k = 0; k < 3; ++k) wl[tid + 512 * k] = wreg[k];
    }
    if (wid == 0) {
        const float al = al_in, bl = bl_in;
        const float xx = al + dt_bias_h; const float sp = (xx > 20.f) ? xx : __logf(1.0f + __expf(xx));
        float gv = -__expf(a_log_h) * sp;
#pragma unroll
        for (int o = 1; o < 64; o <<= 1) { const float t = __shfl_up(gv, o); if (lane >= o) gv += t; }
        const float gl = __shfl(gv, 63);
        gcum[lane] = gv; beta[lane] = 1.0f / (1.0f + __expf(-bl)); expg[lane] = __expf(gv); kdf[lane] = __expf(gl - gv);
        if (lane == 0) *glast_out = gl;
    }
    __syncthreads();
    for (int rpa_ = 0; rpa_ < ((PROBE_MASK & 1024) ? 2 : 1); ++rpa_)
    {
        const int r = tid >> 3, part = tid & 7;
        if (n == 0 && r < 3) {
#pragma unroll
            for (int sec = 0; sec < 3; ++sec)
#pragma unroll
                for (int off = 0; off < 3; ++off) if (r - 3 + off < 0) { X[sec][off][0] = (v4u){0u, 0u, 0u, 0u}; X[sec][off][1] = X[sec][off][0]; }
        }
        const float be = beta[r], eg = expg[r], kd = kdf[r];
#pragma unroll
        for (int sec = 0; sec < 3; ++sec) {
            float y[16];
#pragma unroll
            for (int i = 0; i < 16; ++i) y[i] = 0.f;
#pragma unroll
            for (int off = 0; off < 4; ++off) {
                const v4u x0 = X[sec][off][0], x1 = X[sec][off][1];
                const float* wp = (const float*)(lds + LAF) + (sec * 4 + off) * 128 + part * 16;
#pragma unroll
                for (int v = 0; v < 4; ++v) { const f32x4 w4 = *(const f32x4*)(wp + 4 * v);
                    const unsigned ua = (v < 2) ? x0[2 * v] : x1[2 * v - 4], ub = (v < 2) ? x0[2 * v + 1] : x1[2 * v - 3];
                    y[4 * v + 0] += w4[0] * bf2f((unsigned short)(ua & 0xffffu)); y[4 * v + 1] += w4[1] * bf2f((unsigned short)(ua >> 16));
                    y[4 * v + 2] += w4[2] * bf2f((unsigned short)(ub & 0xffffu)); y[4 * v + 3] += w4[3] * bf2f((unsigned short)(ub >> 16)); }
            }
            float ssq = 0.f;
#pragma unroll
            for (int i = 0; i < 16; ++i) { y[i] = y[i] * __builtin_amdgcn_rcpf(1.0f + __expf(-y[i])); ssq += y[i] * y[i]; }
            if (sec < 2) { ssq += __shfl_xor(ssq, 1); ssq += __shfl_xor(ssq, 2); ssq += __shfl_xor(ssq, 4); }
            const float rs = rsqrtf(ssq + NORM_EPS);
            if (sec == 0) {
                const float sc = rs * 0.08838834764831845f;
                v4u a0, a1, d0, d1;
#pragma unroll
                for (int e = 0; e < 4; ++e) { a0[e] = pk2(y[2 * e] * sc, y[2 * e + 1] * sc); a1[e] = pk2(y[8 + 2 * e] * sc, y[9 + 2 * e] * sc);
                                              d0[e] = pk2(y[2 * e] * sc * eg, y[2 * e + 1] * sc * eg); d1[e] = pk2(y[8 + 2 * e] * sc * eg, y[9 + 2 * e] * sc * eg); }
                *(v4u*)(Qn + r * SQ + part * 16) = a0; *(v4u*)(Qn + r * SQ + part * 16 + 8) = a1;
                *(v4u*)(Qd + r * SQ + part * 16) = d0; *(v4u*)(Qd + r * SQ + part * 16 + 8) = d1;
            } else if (sec == 1) {
                v4u a0, a1;
#pragma unroll
                for (int e = 0; e < 4; ++e) { a0[e] = pk2(y[2 * e] * rs, y[2 * e + 1] * rs); a1[e] = pk2(y[8 + 2 * e] * rs, y[9 + 2 * e] * rs); }
                *(v4u*)(Kn + r * SQ + part * 16) = a0; *(v4u*)(Kn + r * SQ + part * 16 + 8) = a1;
                const int rsw = ((((r >> 3) ^ part) & 7) << 3) | (r & 7);
#pragma unroll
                for (int i = 0; i < 16; ++i) { const float kn = y[i] * rs; const int d = part * 16 + i;
                    KbgT[d * ST + rsw] = (bf16)f2bf(kn * be * eg); KdT[d * ST + rsw] = (bf16)f2bf(kn * kd); }
            } else {
                const int rsw = ((((r >> 3) ^ part) & 7) << 3) | (r & 7);
#pragma unroll
                for (int i = 0; i < 16; ++i) VbT[(part * 16 + i) * ST + rsw] = (bf16)f2bf(y[i] * be);
            }
        }
    }
    prep_load(X, al_in, bl_in, proj, nit, tid);
    __syncthreads();
    {
        const int Ti = wid >> 1;
        f32x4 aK[2], aQ[2];
#pragma unroll
        for (int tt = 0; tt < 2; ++tt) {
            const int Tj = 2 * (wid & 1) + tt;
            aK[tt] = (f32x4){0.f, 0.f, 0.f, 0.f}; aQ[tt] = aK[tt];
            if (Tj <= Ti) {
#pragma unroll
                for (int kk = 0; kk < 4; ++kk) {
                    const bf16x8 fk = ld16((const unsigned char*)(Kn + (16 * Ti + ln) * SQ + 32 * kk + 8 * g));
                    const bf16x8 fq = ld16((const unsigned char*)(Qn + (16 * Ti + ln) * SQ + 32 * kk + 8 * g));
                    const bf16x8 fb = ld16((const unsigned char*)(Kn + (16 * Tj + ln) * SQ + 32 * kk + 8 * g));
                    aK[tt] = mfma16(fk, fb, aK[tt]); aQ[tt] = mfma16(fq, fb, aQ[tt]);
                }
            }
        }
        __syncthreads();
        bf16* Prow[2] = {(bf16*)(lds + SLOT0), (bf16*)(lds + SLOT2)}; bf16* Ptr[2] = {(bf16*)(lds + SLOT1), (bf16*)(lds + LAF)};
        bf16* Rtr[2] = {(bf16*)(lds + LSLOT5), (bf16*)(lds + LTINV)};
        f32x4 racc[2];
#pragma unroll
        for (int tt = 0; tt < 2; ++tt) {
            const int Tj = 2 * (wid & 1) + tt; const int jj = 16 * Tj + ln; const float gj = gcum[jj];
            f32x4 nv4;
#pragma unroll
            for (int j = 0; j < 4; ++j) { const int i = 16 * Ti + 4 * g + j; const float dcy = __expf(fminf(gcum[i] - gj, 0.f));
                const float nv = (i > jj) ? -(beta[i] * aK[tt][j] * dcy) : 0.f;
                Att[i * ST + jj] = (bf16)f2bf((i >= jj) ? aQ[tt][j] * dcy : 0.f);
                racc[tt][j] = nv + ((i == jj) ? 1.f : 0.f); nv4[j] = nv; }
            const unsigned w0 = pk2(nv4[0], nv4[1]), w1 = pk2(nv4[2], nv4[3]);
            Prow[0][(16 * Ti + 4 * g + 0) * ST + jj] = (bf16)(w0 & 0xffffu); Prow[0][(16 * Ti + 4 * g + 1) * ST + jj] = (bf16)(w0 >> 16);
            Prow[0][(16 * Ti + 4 * g + 2) * ST + jj] = (bf16)(w1 & 0xffffu); Prow[0][(16 * Ti + 4 * g + 3) * ST + jj] = (bf16)(w1 >> 16);
            v2u tw; tw[0] = w0; tw[1] = w1; *(v2u*)(Ptr[0] + jj * ST + 16 * Ti + 4 * g) = tw;
            v2u rw; rw[0] = pk2(racc[tt][0], racc[tt][1]); rw[1] = pk2(racc[tt][2], racc[tt][3]); *(v2u*)(Rtr[0] + jj * ST + 16 * Ti + 4 * g) = rw;
        }
        __syncthreads();
#pragma unroll
        for (int k = 1; k <= 6; ++k) {
            const int pb = (k - 1) & 1, pdst = k & 1;
            const int rb = (k & 1), rdst = (k + 1) & 1;
            const int rsrc = (k <= 2) ? 0 : rb;
            const int rwr = (k <= 2) ? 1 : rdst;
            bf16x8 fa[2];
#pragma unroll
            for (int kk = 0; kk < 2; ++kk) fa[kk] = ld16((const unsigned char*)(Prow[pb] + (16 * Ti + ln) * ST + 32 * kk + 8 * g));
#pragma unroll
            for (int tt = 0; tt < 2; ++tt) {
                const int Tj = 2 * (wid & 1) + tt; const int jj = 16 * Tj + ln;
                if (k <= 5) {
                    f32x4 a = (f32x4){0.f, 0.f, 0.f, 0.f};
#pragma unroll
                    for (int kk = 0; kk < 2; ++kk) a = mfma16(fa[kk], ld16((const unsigned char*)(Ptr[pb] + (16 * Tj + ln) * ST + 32 * kk + 8 * g)), a);
                    const unsigned w0 = pk2(a[0], a[1]), w1 = pk2(a[2], a[3]);
                    Prow[pdst][(16 * Ti + 4 * g + 0) * ST + jj] = (bf16)(w0 & 0xffffu); Prow[pdst][(16 * Ti + 4 * g + 1) * ST + jj] = (bf16)(w0 >> 16);
                    Prow[pdst][(16 * Ti + 4 * g + 2) * ST + jj] = (bf16)(w1 & 0xffffu); Prow[pdst][(16 * Ti + 4 * g + 3) * ST + jj] = (bf16)(w1 >> 16);
                    v2u tw; tw[0] = w0; tw[1] = w1; *(v2u*)(Ptr[pdst] + jj * ST + 16 * Ti + 4 * g) = tw;
                }
                if (k >= 2) {
                    f32x4 a = racc[tt];
#pragma unroll
                    for (int kk = 0; kk < 2; ++kk) a = mfma16(fa[kk], ld16((const unsigned char*)(Rtr[rsrc] + (16 * Tj + ln) * ST + 32 * kk + 8 * g)), a);
                    racc[tt] = a;
                    const unsigned w0 = pk2(a[0], a[1]), w1 = pk2(a[2], a[3]);
                    if (k < 6) { v2u rw; rw[0] = w0; rw[1] = w1; *(v2u*)(Rtr[rwr] + jj * ST + 16 * Ti + 4 * g) = rw; }
                    else { bf16* Rf = Prow[0];
                        Rf[(16 * Ti + 4 * g + 0) * ST + jj] = (bf16)(w0 & 0xffffu); Rf[(16 * Ti + 4 * g + 1) * ST + jj] = (bf16)(w0 >> 16);
                        Rf[(16 * Ti + 4 * g + 2) * ST + jj] = (bf16)(w1 & 0xffffu); Rf[(16 * Ti + 4 * g + 3) * ST + jj] = (bf16)(w1 >> 16); }
                }
            }
            __syncthreads();
        }
    }
    for (int rpe_ = 0; rpe_ < ((PROBE_MASK & 2048) ? 2 : 1); ++rpe_) {
    {
        f32x4 aU[4], aW[4];
#pragma unroll
        for (int T = 0; T < 4; ++T) { aU[T] = (f32x4){0.f, 0.f, 0.f, 0.f}; aW[T] = aU[T]; }
#pragma unroll
        for (int kk = 0; kk < 2; ++kk) {
            const bf16x8 bU = ld16((const unsigned char*)(VbT + (16 * wid + ln) * ST + (((4 * kk + g) ^ wid) & 7) * 8));
            const bf16x8 bW = ld16((const unsigned char*)(KbgT + (16 * wid + ln) * ST + (((4 * kk + g) ^ wid) & 7) * 8));
#pragma unroll
            for (int T = 0; T < 4; ++T) { const bf16x8 a = ld16((const unsigned char*)(Tinv + (16 * T + ln) * ST + 32 * kk + 8 * g)); aU[T] = mfma16(a, bU, aU[T]); aW[T] = mfma16(a, bW, aW[T]); }
        }
        v4u u0, u1;
        u0[0] = pk2(aU[0][0], aU[0][1]); u0[1] = pk2(aU[0][2], aU[0][3]); u0[2] = pk2(aU[1][0], aU[1][1]); u0[3] = pk2(aU[1][2], aU[1][3]);
        u1[0] = pk2(aU[2][0], aU[2][1]); u1[1] = pk2(aU[2][2], aU[2][3]); u1[2] = pk2(aU[3][0], aU[3][1]); u1[3] = pk2(aU[3][2], aU[3][3]);
        *(v4u*)(rec + (wid * 64 + lane) * 32) = u0; *(v4u*)(rec + (wid * 64 + lane) * 32 + 16) = u1;
#pragma unroll
        for (int T = 0; T < 4; ++T)
#pragma unroll
            for (int j = 0; j < 4; ++j) Wl[(16 * T + 4 * g + j) * SQ + 16 * wid + ln] = (bf16)f2bf(aW[T][j]);
    }
    __syncthreads();
#pragma unroll
    for (int it = 0; it < 7; ++it) {
        const int p = tid + 512 * it;
        const bf16* src; int stride, T, kk, idx; int dst;
        if (p < 1024) { idx = p; src = Wl; stride = SQ; T = idx >> 8; kk = (idx >> 6) & 3; dst = 16384 + idx * 16; }
        else if (p < 2048) { idx = p - 1024; src = Qd; stride = SQ; T = idx >> 8; kk = (idx >> 6) & 3; dst = 32768 + idx * 16; }
        else if (p < 2560) { idx = p - 2048; src = Att; stride = ST; T = idx >> 7; kk = (idx >> 6) & 1; dst = 49152 + idx * 16; }
        else { idx = p - 2560; src = KdT; stride = ST; T = idx >> 7; kk = (idx >> 6) & 1; dst = 57344 + idx * 16; }
        const int l = idx & 63, gg = l >> 4, m = l & 15;
        const int sw = (p >= 2560) ? (T & 7) : 0;
        const bf16* sp = src + (16 * T + m) * stride + 4 * (gg & 1);
        const v2u lo = *(const v2u*)(sp + (((4 * kk + (gg >> 1)) ^ sw) << 3)), hi = *(const v2u*)(sp + (((4 * kk + 2 + (gg >> 1)) ^ sw) << 3));
        v4u o; o[0] = lo[0]; o[1] = lo[1]; o[2] = hi[0]; o[3] = hi[1];
        *(v4u*)(rec + dst) = o;
    }
    __syncthreads();
    }
}

constexpr int SZ = 272;
__device__ __forceinline__ bf16x8 packS(const f32x4& a, const f32x4& b) {
    v4u r; r[0] = pg8::cvt_pk_bf16(a[0], a[1]); r[1] = pg8::cvt_pk_bf16(a[2], a[3]); r[2] = pg8::cvt_pk_bf16(b[0], b[1]); r[3] = pg8::cvt_pk_bf16(b[2], b[3]);
    return __builtin_bit_cast(bf16x8, r);
}
__device__ __forceinline__ float row16_sum(float v) {
    v += __builtin_bit_cast(float, __builtin_amdgcn_update_dpp(0, __builtin_bit_cast(int, v), 0x128, 0xf, 0xf, false));
    v += __builtin_bit_cast(float, __builtin_amdgcn_update_dpp(0, __builtin_bit_cast(int, v), 0x124, 0xf, 0xf, false));
    v += __builtin_bit_cast(float, __builtin_amdgcn_update_dpp(0, __builtin_bit_cast(int, v), 0x122, 0xf, 0xf, false));
    v += __builtin_bit_cast(float, __builtin_amdgcn_update_dpp(0, __builtin_bit_cast(int, v), 0x121, 0xf, 0xf, false));
    return v;
}
constexpr int SB2 = 32768;
__device__ __forceinline__ void scan_bh(int bh, unsigned char* gdnbase, const float* glast, unsigned char* lds) {
    const int tid = opaque_tid(), lane = tid & 63, wid = tid >> 6;
    f32x4 S[8];
#pragma unroll
    for (int T = 0; T < 8; ++T) S[T] = (f32x4){0.f, 0.f, 0.f, 0.f};
    unsigned char* rec0 = gdnbase + (size_t)bh * 64 * CHUNK_REC;
    v4u st[4];
#pragma unroll
    for (int i = 0; i < 2; ++i) { st[i] = *(const v4u*)(rec0 + 16384 + (size_t)(tid + 512 * i) * 16); st[2 + i] = *(const v4u*)(rec0 + 57344 + (size_t)(tid + 512 * i) * 16); }
    v4u u0 = *(const v4u*)(rec0 + (wid * 64 + lane) * 32), u1 = *(const v4u*)(rec0 + (wid * 64 + lane) * 32 + 16);
    float gl = glast[bh * 64];
#pragma unroll
    for (int i = 0; i < 2; ++i) { *(v4u*)(lds + (tid + 512 * i) * 16) = st[i]; *(v4u*)(lds + 16384 + (tid + 512 * i) * 16) = st[2 + i]; }
    __syncthreads();
    for (int c = 0; c < 64; ++c) {
        unsigned char* buf = lds + (c & 1) * SB2;
        unsigned char* obuf = lds + ((c + 1) & 1) * SB2;
        const int cn = (c + 1 < 64) ? c + 1 : 63;
        unsigned char* rec = rec0 + (size_t)c * CHUNK_REC;
        const unsigned char* recn = rec0 + (size_t)cn * CHUNK_REC;
        const float gln = glast[bh * 64 + cn];
#pragma unroll
        for (int i = 0; i < 2; ++i) { st[i] = *(const v4u*)(recn + 16384 + (size_t)(tid + 512 * i) * 16); st[2 + i] = *(const v4u*)(recn + 57344 + (size_t)(tid + 512 * i) * 16); }
        const v4u un0 = *(const v4u*)(recn + (wid * 64 + lane) * 32), un1 = *(const v4u*)(recn + (wid * 64 + lane) * 32 + 16);
        const float dec = __expf(gl);
        bf16x8 bS[4];
#pragma unroll
        for (int kk = 0; kk < 4; ++kk) { bS[kk] = packS(S[2 * kk], S[2 * kk + 1]); *(bf16x8*)(rec + ((wid * 4 + kk) * 64 + lane) * 16) = bS[kk]; }
        f32x4 Vn[4];
#pragma unroll
        for (int T = 0; T < 4; ++T) {
            f32x4 p = (f32x4){0.f, 0.f, 0.f, 0.f};
#pragma unroll
            for (int kk = 0; kk < 4; ++kk) p = mfma16(ld16(buf + ((T * 4 + kk) * 64 + lane) * 16), bS[kk], p);
            const unsigned ua = (T < 2) ? u0[2 * T] : u1[2 * T - 4], ub = (T < 2) ? u0[2 * T + 1] : u1[2 * T - 3];
            Vn[T][0] = __uint_as_float(ua << 16) - p[0]; Vn[T][1] = __uint_as_float(ua & 0xffff0000u) - p[1];
            Vn[T][2] = __uint_as_float(ub << 16) - p[2]; Vn[T][3] = __uint_as_float(ub & 0xffff0000u) - p[3];
        }
        bf16x8 bV[2];
        bV[0] = packS(Vn[0], Vn[1]); bV[1] = packS(Vn[2], Vn[3]);
        *(bf16x8*)(rec + 57344 + ((wid * 2 + 0) * 64 + lane) * 16) = bV[0]; *(bf16x8*)(rec + 57344 + ((wid * 2 + 1) * 64 + lane) * 16) = bV[1];
#pragma unroll
        for (int T = 0; T < 8; ++T) {
            f32x4 a = S[T] * dec;
#pragma unroll
            for (int kk = 0; kk < 2; ++kk) a = mfma16(ld16(buf + 16384 + ((T * 2 + kk) * 64 + lane) * 16), bV[kk], a);
            S[T] = a;
        }
#pragma unroll
        for (int i = 0; i < 2; ++i) { *(v4u*)(obuf + (tid + 512 * i) * 16) = st[i]; *(v4u*)(obuf + 16384 + (tid + 512 * i) * 16) = st[2 + i]; }
        asm volatile("s_waitcnt vmcnt(0)" ::: "memory");
        __syncthreads();
        u0 = un0; u1 = un1; gl = gln;
    }
}
constexpr int OQ = 0, OAT = 16384, OZ = 24576, ORED = OZ + 64 * SZ;
struct OutRegs { v4u q0, q1, a0, z0, z1; bf16x8 bS[4], bV[2]; };
__device__ __forceinline__ void out_load(OutRegs& R, int it, const unsigned char* gdnbase, const bf16* proj, int tid) {
    const int lane = tid & 63, wid = tid >> 6; const int n = it & 63, h = (it >> 6) & 3, b = it >> 8;
    const unsigned char* rec = gdnbase + (size_t)it * CHUNK_REC; const size_t tokb = (size_t)b * SEQL + n * 64; const int zr0 = tid >> 4, zs = tid & 15;
    R.q0 = *(const v4u*)(rec + 32768 + (size_t)tid * 16); R.q1 = *(const v4u*)(rec + 32768 + (size_t)(tid + 512) * 16); R.a0 = *(const v4u*)(rec + 49152 + (size_t)tid * 16);
    const bf16* zp = proj + (tokb + zr0) * NINP + C_Z + h * 128 + zs * 8;
    R.z0 = *(const v4u*)zp; R.z1 = *(const v4u*)(zp + (size_t)32 * NINP);
#pragma unroll
    for (int kk = 0; kk < 4; ++kk) R.bS[kk] = *(const bf16x8*)(rec + ((wid * 4 + kk) * 64 + lane) * 16);
#pragma unroll
    for (int kk = 0; kk < 2; ++kk) R.bV[kk] = *(const bf16x8*)(rec + 57344 + ((wid * 2 + kk) * 64 + lane) * 16);
}
__device__ __forceinline__ void out_phase(const unsigned char* gdnbase, const bf16* proj, bf16* concat, const float* normg, int G, unsigned char* lds) {
    const int tid = opaque_tid(), lane = tid & 63, wid = tid >> 6, g = lane >> 4, ln = lane & 15;
    const int zr0 = tid >> 4, zs = tid & 15;
    const float ng = normg[16 * wid + ln];
    if ((int)blockIdx.x >= 2048) return;
    OutRegs R; out_load(R, (int)blockIdx.x, gdnbase, proj, tid);
    for (int it = blockIdx.x; it < 2048; it += G) {
        const int n = it & 63, h = (it >> 6) & 3, b = it >> 8;
        const size_t tokb = (size_t)b * SEQL + n * 64;
        *(v4u*)(lds + OQ + tid * 16) = R.q0; *(v4u*)(lds + OQ + (tid + 512) * 16) = R.q1; *(v4u*)(lds + OAT + tid * 16) = R.a0;
        *(v4u*)(lds + OZ + zr0 * SZ + zs * 16) = R.z0; *(v4u*)(lds + OZ + (zr0 + 32) * SZ + zs * 16) = R.z1;
        bf16x8 bS[4], bV[2];
#pragma unroll
        for (int kk = 0; kk < 4; ++kk) bS[kk] = R.bS[kk];
#pragma unroll
        for (int kk = 0; kk < 2; ++kk) bV[kk] = R.bV[kk];
        __syncthreads();
        out_load(R, (it + G < 2048) ? it + G : it, gdnbase, proj, tid);
        f32x4 O[4];
#pragma unroll
        for (int T = 0; T < 4; ++T) {
            f32x4 a = (f32x4){0.f, 0.f, 0.f, 0.f};
#pragma unroll
            for (int kk = 0; kk < 4; ++kk) a = mfma16(ld16(lds + OQ + ((T * 4 + kk) * 64 + lane) * 16), bS[kk], a);
#pragma unroll
            for (int kk = 0; kk < 2; ++kk) a = mfma16(ld16(lds + OAT + ((T * 2 + kk) * 64 + lane) * 16), bV[kk], a);
            O[T] = a;
        }
        float* red = (float*)(lds + ORED);
#pragma unroll
        for (int T = 0; T < 4; ++T)
#pragma unroll
            for (int j = 0; j < 4; ++j) { const float s = row16_sum(O[T][j] * O[T][j]); if (ln == 0) red[(16 * T + 4 * g + j) * 8 + wid] = s; }
        __syncthreads();
        bf16* zt = (bf16*)(lds + OZ);
#pragma unroll
        for (int T = 0; T < 4; ++T)
#pragma unroll
            for (int j = 0; j < 4; ++j) { const int row = 16 * T + 4 * g + j;
                const f32x4 r0 = *(const f32x4*)(red + row * 8), r1 = *(const f32x4*)(red + row * 8 + 4);
                const float tot = ((r0[0] + r0[1]) + (r0[2] + r0[3])) + ((r1[0] + r1[1]) + (r1[2] + r1[3]));
                const float rstd = rsqrtf(tot * (1.0f / 128.0f) + NORM_EPS);
                bf16* zp = zt + row * (SZ / 2) + 16 * wid + ln;
                const float z = bf2f(*zp);
                const float val = O[T][j] * rstd * ng * z * __builtin_amdgcn_rcpf(1.0f + __expf(-z));
                *zp = (bf16)f2bf(val); }
        __syncthreads();
        {
            const v4u o0 = *(const v4u*)(lds + OZ + zr0 * SZ + zs * 16), o1 = *(const v4u*)(lds + OZ + (zr0 + 32) * SZ + zs * 16);
            bf16* od = concat + (tokb + zr0) * DMODEL + h * 128 + zs * 8;
            *(v4u*)od = o0; *(v4u*)(od + (size_t)32 * DMODEL) = o1;
        }
        __syncthreads();
    }
}
}
#define GAS __attribute__((address_space(1)))
#define LAS __attribute__((address_space(3)))
typedef unsigned short bf16;
typedef unsigned v4u __attribute__((ext_vector_type(4)));
typedef float f32x4 __attribute__((ext_vector_type(4)));
typedef short bf16x8 __attribute__((ext_vector_type(8)));
typedef GAS unsigned gu32;
typedef GAS unsigned long long gu64;
#define RLX_AGENT __ATOMIC_RELAXED, __HIP_MEMORY_SCOPE_AGENT
#define LDS_WAIT() asm volatile("s_waitcnt lgkmcnt(0)" ::: "memory")
#define VM_WAIT() asm volatile("s_waitcnt vmcnt(0)" ::: "memory")
__device__ __forceinline__ unsigned long long rt() { return __builtin_amdgcn_s_memrealtime(); }
#define XB_TMO      128
#define XB_XCNT(j)  (256  + 64 * (j))
#define XB_XSUB(j)  (1280 + 64 * (j))
#define XB_XGEN(j)  (2304 + 64 * (j))
#define XB_TOP      3328
#define XB_TOPGEN   3392
#define XCD_BAR_WORDS 3456
#define XB_SPIN_CAP (1u << 18)

__device__ __forceinline__ unsigned xb_ld(unsigned* p)              { return __hip_atomic_load(p, __ATOMIC_RELAXED, __HIP_MEMORY_SCOPE_AGENT); }
__device__ __forceinline__ unsigned xb_add(unsigned* p, unsigned v) { return __hip_atomic_fetch_add(p, v, __ATOMIC_RELAXED, __HIP_MEMORY_SCOPE_AGENT); }
__device__ __forceinline__ unsigned xb_xcc_id() { return (unsigned)__builtin_amdgcn_s_getreg((3 << 11) | 20) & 0xFu; }
#define XB_SPIN(cond, bar) do { unsigned _sp = 0; while (cond) { __builtin_amdgcn_s_sleep(1); \
    if ((++_sp & 255u) == 0u) { if (xb_ld(&(bar)[XB_TMO])) break; if (_sp > XB_SPIN_CAP) { atomicAdd(&(bar)[XB_TMO], 1u); break; } } } } while (0)

struct XcdBarrier {
    unsigned* bar; unsigned x;
    volatile LAS unsigned* st;
};

__device__ __forceinline__ XcdBarrier xcd_barrier_post(unsigned* bar, volatile LAS unsigned* st) {
    XcdBarrier b; b.bar = bar; b.x = xb_xcc_id(); b.st = st;
    if (threadIdx.x == 0) (void)xb_add(&bar[XB_XCNT(b.x)], 1u);
    return b;
}
__device__ __forceinline__ void xcd_barrier_complete(unsigned* bar, unsigned x, unsigned& nloc, unsigned& nx) {
    const unsigned G = gridDim.x * gridDim.y * gridDim.z;
    unsigned sum, cnt, mine, sp = 0u;
    for (;;) {
        sum = 0u; cnt = 0u; mine = 0u;
#pragma unroll
        for (unsigned j = 0; j < 16; ++j) { const unsigned c = xb_ld(&bar[XB_XCNT(j)]); sum += c; cnt += (c > 0u) ? 1u : 0u; mine = (j == x) ? c : mine; }
        if (sum == G) break;
        __builtin_amdgcn_s_sleep(1);
        if ((++sp & 255u) == 0u) { if (xb_ld(&bar[XB_TMO])) break; if (sp > XB_SPIN_CAP) { atomicAdd(&bar[XB_TMO], 1u); break; } }
    }
    nloc = mine > 0u ? mine : 1u; nx = cnt > 0u ? cnt : 1u;
}

__device__ __forceinline__ void xcd_barrier(const XcdBarrier& b) {
    asm volatile("s_waitcnt vmcnt(0)" ::: "memory");
    __syncthreads();
    if (threadIdx.x == 0) {
        unsigned* bar = b.bar;
        __builtin_amdgcn_s_waitcnt(0);
        unsigned nloc = b.st[0], nx = b.st[1];
        if (nloc == 0u) { xcd_barrier_complete(bar, b.x, nloc, nx); b.st[0] = nloc; b.st[1] = nx; }
        const unsigned old = xb_add(&bar[XB_XSUB(b.x)], 1u);
        const unsigned gen = old / nloc;
        if (old + 1u == (gen + 1u) * nloc) {
            __builtin_amdgcn_fence(__ATOMIC_RELEASE, "agent");
            asm volatile("s_waitcnt vmcnt(0)" ::: "memory");
            const unsigned og = xb_add(&bar[XB_TOP], 1u);
            const unsigned tg = og / nx;
            if (og + 1u == (tg + 1u) * nx) xb_add(&bar[XB_TOPGEN], 1u);
            else XB_SPIN(xb_ld(&bar[XB_TOPGEN]) == tg, bar);
            __builtin_amdgcn_fence(__ATOMIC_ACQUIRE, "agent");
            xb_add(&bar[XB_XGEN(b.x)], 1u);
            asm volatile("s_waitcnt vmcnt(0)" ::: "memory");
        } else {
            XB_SPIN(xb_ld(&bar[XB_XGEN(b.x)]) == gen, bar);
            __builtin_amdgcn_fence(__ATOMIC_ACQUIRE, "agent");
            asm volatile("s_waitcnt vmcnt(0)" ::: "memory");
        }
    }
    __syncthreads();
}

constexpr int CW_BAR = 4096, BAR_LDS_OFF = LDS_BYTES - 64;
struct Args { Ptrs p; int pad0, pad1; };
#define LP() (&args.p)
#define WSP(off) (LP()->ws + (off))
#define GSYNC() xcd_barrier(bar)
template <int l> __device__ __forceinline__ void layer_body(const Args& args, const XcdBarrier& bar, unsigned char* lds, PG8_LAS unsigned char* ldsl, const int G) {
        { pg8::Gemm gm{(const bf16*)WSP(WS_XBF), (const bf16*)(WSP(WS_W) + (size_t)l * W_LAYER + W_IN), MTOK, 3584, DMODEL}; pg8::StaticOrder S; S.init(MTOK, 3584, G, (int)blockIdx.x);
          pg8::EpiBf16 E{(bf16*)WSP(WS_PROJ), NINP};
          pg8::gemm_phase<pg8::EpiBf16, pg8::StaticOrder, true, true>(ldsl, gm, S, E);
          if (PROBE_MASK & 1) { __syncthreads(); pg8::gemm_phase<pg8::EpiBf16, pg8::StaticOrder, true, true>(ldsl, gm, S, E); } }
        for (int grp = blockIdx.x; grp < MTOK / 128; grp += G) logits_group(grp, (const bf16*)WSP(WS_XBF), (const bf16*)(WSP(WS_W) + (size_t)l * W_LAYER + W_IN), (bf16*)WSP(WS_PROJ));
        GSYNC();
        if (blockIdx.x == 0 && threadIdx.x == 0) { ((unsigned*)WSP(WS_CTL))[64 + l] = 0u; ((unsigned*)WSP(WS_CTL))[80 + l] = 0u; }
        for (int rep_ = 0; rep_ < ((PROBE_MASK & 2) ? 2 : 1); ++rep_)
        if ((int)blockIdx.x < 2048) {
            const Ptrs* pp = LP(); const bf16* projc = (const bf16*)(pp->ws + WS_PROJ);
            const int tid_ = opaque_tid(); const int h0 = ((int)blockIdx.x >> 6) & 3;
            float wreg[3];
#pragma unroll
            for (int k = 0; k < 3; ++k) { const int idx = tid_ + 512 * k, sec = idx >> 9, off = (idx >> 7) & 3, ch = idx & 127; wreg[k] = pp->conv_w[(size_t)l * 4 * 1536 + off * 1536 + sec * 512 + h0 * 128 + ch]; }
            v4u X[3][4][2]; float alr, blr;
            gdn::prep_load(X, alr, blr, projc, (int)blockIdx.x, tid_);
            for (int it = blockIdx.x; it < 2048; it += G) {
                const int n = it & 63, h = (it >> 6) & 3, b = it >> 8;
                const int nit = (it + G < 2048) ? it + G : it;
                gdn::prep_item(X, alr, blr, nit, wreg, projc, pp->ws + WS_GDN + (size_t)it * CHUNK_REC, (float*)(pp->ws + WS_GLAST) + it, pp->a_log[l * 4 + h], pp->dt_bias[l * 4 + h], b, h, n, lds);
            }
        }
        for (int it = blockIdx.x; it < 1024; it += G) moba_prep_item((bf16*)WSP(WS_PROJ), (float*)WSP(WS_KMEAN), (const float*)WSP(WS_ROPE), it, lds);
        GSYNC();
        for (int rep_ = 0; rep_ < ((PROBE_MASK & (4 | 64 | 128)) ? 2 : 1); ++rep_) {
        if (blockIdx.x < 32 && (rep_ == 0 || (PROBE_MASK & (4 | 64)))) { const Ptrs* pp = LP(); gdn::scan_bh((int)blockIdx.x, pp->ws + WS_GDN, (const float*)(pp->ws + WS_GLAST), lds); }
        {
            volatile unsigned* sh_u = (volatile unsigned*)(lds + 90112);
            if (rep_ == 0 || (PROBE_MASK & (4 | 128))) for (;;) {
                __syncthreads();
                if (threadIdx.x == 0) *sh_u = atomicAdd((unsigned*)WSP(WS_CTL) + 64 + 16 * rep_ + l, 1u);
                __syncthreads();
                const unsigned u = (unsigned)__builtin_amdgcn_readfirstlane((int)*sh_u);
                if (u >= 1024u) break;
                const int qb = 15 - (int)(u >> 6), bh = (int)(u & 63u), b = bh >> 3, h = bh & 7;
                const bf16* proj = (const bf16*)WSP(WS_PROJ);
                const SelCall selc{b, h, qb, proj, (const bf16*)WSP(WS_KMEAN) + (size_t)bh * 16 * 64, lds};
                attn_body::attn_unit<8, SelCall>(b, h, qb, (const attn_body::bf16*)(proj + C_QB), (const attn_body::bf16*)(proj + C_KB), (const attn_body::bf16*)(proj + C_VB),
                                        (attn_body::bf16*)((bf16*)WSP(WS_XBF) + 512), (char*)lds, selc);
            }
        }
        }
        GSYNC();
        for (int rep_ = 0; rep_ < ((PROBE_MASK & 512) ? 2 : 1); ++rep_)
        { const Ptrs* pp = LP(); gdn::out_phase(pp->ws + WS_GDN, (const bf16*)(pp->ws + WS_PROJ), (bf16*)(pp->ws + WS_XBF), pp->norm_g + l * 128, G, lds); }
        GSYNC();
        { const Ptrs* pp = LP();
          pg8::Gemm gm{(const bf16*)(pp->ws + WS_XBF), (const bf16*)(pp->ws + WS_W + (size_t)l * W_LAYER + W_OUT), MTOK, DMODEL, DMODEL}; pg8::StaticOrder S; S.init(MTOK, DMODEL, G, (int)blockIdx.x);
          typedef pg8::EpiResBf<(l > 0)> EpiD;
          EpiD E{pp->x, (const bf16*)pp->out, (bf16*)(pp->ws + WS_YX), (const float*)(pp->ws + WS_STAT), pp->ln2_g + (l > 0 ? l - 1 : 0) * DMODEL, pp->ln2_b + (l > 0 ? l - 1 : 0) * DMODEL};
          pg8::gemm_phase<EpiD, pg8::StaticOrder, true, true>(ldsl, gm, S, E);
          if (PROBE_MASK & 16) { __syncthreads(); pg8::gemm_phase<EpiD, pg8::StaticOrder, true, true>(ldsl, gm, S, E); } }
        GSYNC();
        { const Ptrs* pp = LP(); ln_phase((const bf16*)(pp->ws + WS_YX), nullptr, (bf16*)(pp->ws + WS_XBF), (float*)(pp->ws + WS_STAT), pp->ln1_g + l * DMODEL, pp->ln1_b + l * DMODEL, G); }
        GSYNC();
        { const Ptrs* pp = LP();
          pg8::Gemm gm{(const bf16*)(pp->ws + WS_XBF), (const bf16*)(pp->ws + WS_W + (size_t)l * W_LAYER + W_UP), MTOK, NUP, DMODEL}; pg8::StaticOrder S; S.init(MTOK, NUP, G, (int)blockIdx.x);
          pg8::EpiUpConv E{(bf16*)(pp->ws + WS_ACT), (float*)(pp->ws + WS_EDGE), pp->fconv_w + (size_t)l * 3 * NUP, pp->fconv_b + (size_t)l * NUP};
          pg8::gemm_phase<pg8::EpiUpConv, pg8::StaticOrder, true, true>(ldsl, gm, S, E);
          if (PROBE_MASK & 8) { __syncthreads(); pg8::gemm_phase<pg8::EpiUpConv, pg8::StaticOrder, true, true>(ldsl, gm, S, E); } }
        GSYNC();
        { const Ptrs* pp = LP(); fix_phase((const float*)(pp->ws + WS_EDGE), (bf16*)(pp->ws + WS_ACT), pp->fconv_w + (size_t)l * 3 * NUP, pp->fconv_b + (size_t)l * NUP, G); }
        GSYNC();
        { const Ptrs* pp = LP();
          pg8::Gemm gm{(const bf16*)(pp->ws + WS_ACT), (const bf16*)(pp->ws + WS_W + (size_t)l * W_LAYER + W_DOWN), MTOK, DMODEL, DFF}; pg8::StaticOrder S; S.init(MTOK, DMODEL, G, (int)blockIdx.x);
          pg8::EpiResBf<true> E{nullptr, (const bf16*)(pp->ws + WS_YX), (l + 1 < NLAYER) ? (bf16*)pp->out : (bf16*)(pp->ws + WS_YX), (const float*)(pp->ws + WS_STAT), pp->ln1_g + l * DMODEL, pp->ln1_b + l * DMODEL};
          pg8::gemm_phase<pg8::EpiResBf<true>, pg8::StaticOrder, true, true>(ldsl, gm, S, E); }
        GSYNC();
        { const Ptrs* pp = LP();
          if (l + 1 < NLAYER) ln_phase((const bf16*)pp->out, nullptr, (bf16*)(pp->ws + WS_XBF), (float*)(pp->ws + WS_STAT), pp->ln2_g + l * DMODEL, pp->ln2_b + l * DMODEL, G);
          else ln_phase((const bf16*)(pp->ws + WS_YX), pp->out, nullptr, nullptr, pp->ln2_g + l * DMODEL, pp->ln2_b + l * DMODEL, G); }
        if (PROBE_MASK & 256) { for (int q_ = 0; q_ < 8; ++q_) GSYNC(); }
        if (l + 1 < NLAYER) GSYNC();
}
__global__ void __launch_bounds__(NTHREADS, 2) hybrid_fwd(Args args) {
    extern __shared__ __attribute__((aligned(16))) unsigned char lds[];
    cg::grid_group grid = cg::this_grid();
    const int G = gridDim.x;
    PG8_LAS unsigned char* ldsl = (PG8_LAS unsigned char*)lds;

    if (threadIdx.x < 16) ((volatile LAS unsigned*)(ldsl + BAR_LDS_OFF))[threadIdx.x] = 0u;
    __syncthreads();
    const XcdBarrier bar = xcd_barrier_post((unsigned*)WSP(WS_CTL) + CW_BAR, (volatile LAS unsigned*)(ldsl + BAR_LDS_OFF));
    { const Ptrs P = *LP(); p0_prologue(P, lds, G); }
    if (args.pad0 != 0) grid.sync();
    xcd_barrier(bar);

    layer_body<0>(args, bar, lds, ldsl, G);
    layer_body<1>(args, bar, lds, ldsl, G);
}

extern "C" void kernel_launch(void* const* d_in, const int* in_sizes, int n_in, void* d_out, int out_size, void* d_ws, size_t ws_size, hipStream_t stream) {
    static int grid = 0;
    if (grid == 0) {
        if (n_in != 15 || ws_size < WS_END) { fprintf(stderr, "kernel_launch: unexpected inputs (n_in %d, ws %zu)\n", n_in, ws_size); grid = -1; return; }
        int dev = 0, cus = 0, per_cu = 0;
        hipGetDevice(&dev); hipDeviceGetAttribute(&cus, hipDeviceAttributeMultiprocessorCount, dev);
        if (hipFuncSetAttribute((const void*)hybrid_fwd, hipFuncAttributeMaxDynamicSharedMemorySize, LDS_BYTES) != hipSuccess) { fprintf(stderr, "kernel_launch: hipFuncSetAttribute failed\n"); grid = -1; return; }
        if (hipOccupancyMaxActiveBlocksPerMultiprocessor(&per_cu, (const void*)hybrid_fwd, NTHREADS, LDS_BYTES) != hipSuccess || per_cu < 1) { fprintf(stderr, "kernel_launch: occupancy query says %d\n", per_cu); per_cu = 1; }
        (void)hipGetLastError();
        grid = 256;
    }
    if (grid < 0) return;
    if (hipMemsetAsync(d_ws, 0, 65536, stream) != hipSuccess) { fprintf(stderr, "kernel_launch: hipMemsetAsync failed\n"); return; }
    Args a{};
    const float* const* in = (const float* const*)d_in;
    a.p.x = in[0]; a.p.w_in = in[1]; a.p.conv_w = in[2]; a.p.a_log = in[3]; a.p.dt_bias = in[4]; a.p.norm_g = in[5]; a.p.w_out = in[6];
    a.p.ln1_g = in[7]; a.p.ln1_b = in[8]; a.p.w_up = in[9]; a.p.fconv_w = in[10]; a.p.fconv_b = in[11]; a.p.w_down = in[12]; a.p.ln2_g = in[13]; a.p.ln2_b = in[14];
    a.p.out = (float*)d_out; a.p.ws = (unsigned char*)d_ws;
    void* kargs[] = {&a};
    hipError_t e = hipLaunchCooperativeKernel((const void*)hybrid_fwd, dim3(grid), dim3(NTHREADS), kargs, LDS_BYTES, stream);
    if (e != hipSuccess) fprintf(stderr, "kernel_launch: cooperative launch failed: %s (grid %d)\n", hipGetErrorString(e), grid);
}
```

```cpp
#include <hip/hip_runtime.h>
#include <hip/hip_cooperative_groups.h>
#include <hip/hip_bf16.h>
#include <cstdio>
#include <cstdint>
#include <cmath>
namespace cg = cooperative_groups;
#ifndef PROBE_MASK
#define PROBE_MASK 0
#endif
__device__ __forceinline__ int opaque_tid() { int t = threadIdx.x; asm volatile("" : "+v"(t)); return t; }
namespace pg8 {
#define PG8_LAS __attribute__((address_space(3)))
typedef unsigned short bf16_t;
typedef short bf16x8 __attribute__((ext_vector_type(8)));
typedef float f32x4 __attribute__((ext_vector_type(4)));
typedef unsigned u32x4 __attribute__((ext_vector_type(4)));
constexpr int BM = 256, BK = 64, HALF = 128, HTB = HALF * BK * 2  , STAGE_BYTES = 8 * HTB, NXCD = 8, WGM = 8;

__host__ __device__ __forceinline__ int lds_byte(int r, int c) { const int st = (r >> 4) * 2 + (c >> 5), rr = r & 15, cc = c & 31, ob = rr * 64 + cc * 2; return st * 1024 + (ob ^ (((ob >> 9) & 1) << 5)); }
__host__ __device__ __forceinline__ void stage_rc(int b, int& R, int& C) { const int st = b / 1024, sb = b % 1024, swz = sb ^ (((sb >> 9) & 1) << 5); R = (st >> 1) * 16 + swz / 64; C = (st & 1) * 32 + (swz % 64) / 2; }
__host__ __device__ __forceinline__ int perm32(int rho) { const int n = rho >> 4, i = rho & 15; return 8 * (i >> 2) + 4 * n + (i & 3); }

struct Unit { int pm, pn; };
struct Gemm { const bf16_t* A; const bf16_t* Bt; int M, N, K; };

struct StaticOrder {
    int nM, nN, nwg, G, c;
    __host__ __device__ void init(int M, int N, int G_, int c_) { nM = M / BM; nN = N / BM; nwg = nM * nN; G = G_; c = c_; }
    __host__ __device__ bool next(int i, Unit& u) const {
        const long L = (long)i * G + c; if (L >= nwg) return false;
        int wgid = (int)L; { const int q = nwg / NXCD, r = nwg % NXCD, xcd = wgid % NXCD, off = wgid / NXCD; wgid = (xcd < r ? xcd * (q + 1) : r * (q + 1) + (xcd - r) * q) + off; }
        const int nig = WGM * nN, gid = wgid / nig, fm = gid * WGM, gsz = (nM - fm) < WGM ? (nM - fm) : WGM;
        u.pm = fm + ((wgid % nig) % gsz); u.pn = (wgid % nig) / gsz; return true;
    }
    __device__ __forceinline__ void a_ready(const Unit&) const {}
    __device__ __forceinline__ void done(const Unit&) const {}
};

__device__ __forceinline__ unsigned cvt_pk_bf16(float lo, float hi) { unsigned r; asm volatile("v_cvt_pk_bf16_f32 %0, %1, %2" : "=v"(r) : "v"(lo), "v"(hi)); return r; }
typedef float f32x2 __attribute__((ext_vector_type(2)));
typedef unsigned u32x2 __attribute__((ext_vector_type(2)));
struct EpiBf16 {
    static constexpr bool PERM = true, AFTER_DRAIN = false, PERMA = false;
    bf16_t* O; int ldc;
    __device__ __forceinline__ void operator()(const f32x4 (&acc)[2][2][4][2], const Unit& u, int wr, int wc, int fr, int fq) const {
        const int row0 = u.pm * BM + wr * 64 + fr; const int col0 = u.pn * BM + wc * 32 + 8 * fq;
#pragma unroll
        for (int ai = 0; ai < 2; ++ai)
#pragma unroll
            for (int m = 0; m < 4; ++m) { bf16_t* rowp = O + (size_t)(row0 + ai * HALF + m * 16) * ldc + col0;
#pragma unroll
                for (int bj = 0; bj < 2; ++bj) { const f32x4 v0 = acc[ai][bj][m][0], v1 = acc[ai][bj][m][1];
                    u32x4 w; w.x = cvt_pk_bf16(v0[0], v0[1]); w.y = cvt_pk_bf16(v0[2], v0[3]); w.z = cvt_pk_bf16(v1[0], v1[1]); w.w = cvt_pk_bf16(v1[2], v1[3]);
                    *(u32x4*)(rowp + bj * HALF) = w; } }
    }
};
template <bool REBUILD> struct EpiResBf {
    static constexpr bool PERM = true, AFTER_DRAIN = false, PERMA = false;
    const float* resf; const bf16_t* resb; bf16_t* out; const float* stat_; const float* g_; const float* b_;
    static constexpr int ldc = 1024; static constexpr float alpha = 1.4142135623730951f;
    __device__ __forceinline__ void operator()(const f32x4 (&acc)[2][2][4][2], const Unit& u, int wr, int wc, int fr, int fq) const {
        const float* stat = stat_; const float* g = g_; const float* b = b_; asm volatile("" : "+s"(stat), "+s"(g), "+s"(b));
        const int row0 = u.pm * BM + wr * 64 + fr; const int col0 = u.pn * BM + wc * 32 + 8 * fq;
#pragma unroll
        for (int bj = 0; bj < 2; ++bj) {
            const int col = col0 + bj * HALF;
            if (REBUILD) {
                const f32x4 g0 = *(const f32x4*)(g + col) * alpha, g1 = *(const f32x4*)(g + col + 4) * alpha, b0 = *(const f32x4*)(b + col) * alpha, b1 = *(const f32x4*)(b + col + 4) * alpha;
#pragma unroll
                for (int ai = 0; ai < 2; ++ai) {
                u32x4 rb[4]; f32x2 ms[4];
#pragma unroll
                for (int q = 0; q < 4; ++q) { const int row = row0 + ai * HALF + q * 16; rb[q] = *(const u32x4*)(resb + (size_t)row * ldc + col); ms[q] = *(const f32x2*)(stat + 2 * (size_t)row); }
#pragma unroll
                for (int q = 0; q < 4; ++q) { const int m = q; const int row = row0 + ai * HALF + m * 16;
                    f32x4 r0, r1; r0[0] = __uint_as_float(rb[q].x << 16); r0[1] = __uint_as_float(rb[q].x & 0xffff0000u); r0[2] = __uint_as_float(rb[q].y << 16); r0[3] = __uint_as_float(rb[q].y & 0xffff0000u);
                    r1[0] = __uint_as_float(rb[q].z << 16); r1[1] = __uint_as_float(rb[q].z & 0xffff0000u); r1[2] = __uint_as_float(rb[q].w << 16); r1[3] = __uint_as_float(rb[q].w & 0xffff0000u);
                    const f32x4 v0 = (r0 - ms[q].x) * ms[q].y * g0 + b0 + acc[ai][bj][m][0], v1 = (r1 - ms[q].x) * ms[q].y * g1 + b1 + acc[ai][bj][m][1];
                    u32x4 w; w.x = cvt_pk_bf16(v0[0], v0[1]); w.y = cvt_pk_bf16(v0[2], v0[3]); w.z = cvt_pk_bf16(v1[0], v1[1]); w.w = cvt_pk_bf16(v1[2], v1[3]);
                    *(u32x4*)(out + (size_t)row * ldc + col) = w; }
                }
            } else {
#pragma unroll
                for (int ai = 0; ai < 2; ++ai) {
                    f32x4 ra[4], rc[4];
#pragma unroll
                    for (int m = 0; m < 4; ++m) { const size_t off = (size_t)(row0 + ai * HALF + m * 16) * ldc + col; ra[m] = *(const f32x4*)(resf + off); rc[m] = *(const f32x4*)(resf + off + 4); }
#pragma unroll
                    for (int m = 0; m < 4; ++m) { const size_t off = (size_t)(row0 + ai * HALF + m * 16) * ldc + col;
                        const f32x4 v0 = ra[m] * alpha + acc[ai][bj][m][0], v1 = rc[m] * alpha + acc[ai][bj][m][1];
                        u32x4 w; w.x = cvt_pk_bf16(v0[0], v0[1]); w.y = cvt_pk_bf16(v0[2], v0[3]); w.z = cvt_pk_bf16(v1[0], v1[1]); w.w = cvt_pk_bf16(v1[2], v1[3]);
                        *(u32x4*)(out + off) = w; }
                }
            }
        }
    }
};
__device__ __forceinline__ float dpp_ror1(float v) { return __builtin_bit_cast(float, __builtin_amdgcn_update_dpp(0, __builtin_bit_cast(int, v), 0x121, 0xf, 0xf, false)); }
__device__ __forceinline__ float dpp_ror2(float v) { return __builtin_bit_cast(float, __builtin_amdgcn_update_dpp(0, __builtin_bit_cast(int, v), 0x122, 0xf, 0xf, false)); }
__device__ __forceinline__ float silu_f(float x) { return x * __builtin_amdgcn_rcpf(1.0f + __expf(-x)); }
__device__ __forceinline__ float dpp_shr1(float v) { return __builtin_bit_cast(float, __builtin_amdgcn_update_dpp(0, __builtin_bit_cast(int, v), 0x111, 0xf, 0xf, true)); }
struct EpiUpConv {
    static constexpr bool PERM = true, AFTER_DRAIN = false, PERMA = true;
    bf16_t* act; float* edge; const float* cw; const float* cb;
    __device__ __forceinline__ void operator()(const f32x4 (&acc)[2][2][4][2], const Unit& u, int wr, int wc, int fr, int fq) const {
        const int ch0 = u.pn * 128 + wc * 32 + 8 * fq;
        f32x4 w0[2][2], w1[2][2], w2[2][2], bb[2][2];
#pragma unroll
        for (int n = 0; n < 2; ++n)
#pragma unroll
            for (int bj = 0; bj < 2; ++bj) { const int col = bj * 2816 + ch0 + 4 * n;
                w0[n][bj] = *(const f32x4*)(cw + col); w1[n][bj] = *(const f32x4*)(cw + 5632 + col); w2[n][bj] = *(const f32x4*)(cw + 2 * 5632 + col); bb[n][bj] = *(const f32x4*)(cb + col); }
#pragma unroll
        for (int ai = 0; ai < 2; ++ai) {
            const int slab = u.pm * 4 + ai * 2 + wr;
            u32x2 pk[2][4];
#pragma unroll
            for (int n = 0; n < 2; ++n) {
                const int ch = ch0 + 4 * n;
                f32x4 hv[2][4];
#pragma unroll
                for (int bj = 0; bj < 2; ++bj) {
                    const int col = bj * 2816 + ch;
                    const f32x4 c0 = acc[ai][bj][0][n], c1 = acc[ai][bj][1][n], c2 = acc[ai][bj][2][n], c3 = acc[ai][bj][3][n];
                    f32x4 s2, s3;
#pragma unroll
                    for (int e = 0; e < 4; ++e) { s2[e] = dpp_shr1(c2[e]); s3[e] = dpp_shr1(c3[e]); }
                    hv[bj][0] = w2[n][bj] * c0 + w1[n][bj] * s3 + w0[n][bj] * s2 + bb[n][bj];
                    hv[bj][1] = w2[n][bj] * c1 + w1[n][bj] * c0 + w0[n][bj] * s3 + bb[n][bj];
                    hv[bj][2] = w2[n][bj] * c2 + w1[n][bj] * c1 + w0[n][bj] * c0 + bb[n][bj];
                    hv[bj][3] = w2[n][bj] * c3 + w1[n][bj] * c2 + w0[n][bj] * c1 + bb[n][bj];
                    if (fr == 0) { *(f32x4*)(edge + ((size_t)slab * 4 + 0) * 5632 + col) = c0; *(f32x4*)(edge + ((size_t)slab * 4 + 1) * 5632 + col) = c1; }
                    if (fr == 15) { *(f32x4*)(edge + ((size_t)slab * 4 + 2) * 5632 + col) = c2; *(f32x4*)(edge + ((size_t)slab * 4 + 3) * 5632 + col) = c3; }
                }
#pragma unroll
                for (int m = 0; m < 4; ++m) { pk[n][m].x = cvt_pk_bf16(silu_f(hv[0][m][0]) * hv[1][m][0], silu_f(hv[0][m][1]) * hv[1][m][1]); pk[n][m].y = cvt_pk_bf16(silu_f(hv[0][m][2]) * hv[1][m][2], silu_f(hv[0][m][3]) * hv[1][m][3]); }
            }
            const size_t row0 = (size_t)u.pm * BM + ai * HALF + wr * 64 + 4 * fr;
#pragma unroll
            for (int m = 0; m < 4; ++m) {
                if (!(m < 2 && fr == 0)) { u32x4 o; o.x = pk[0][m].x; o.y = pk[0][m].y; o.z = pk[1][m].x; o.w = pk[1][m].y; *(u32x4*)(act + (row0 + m) * 2816 + ch0) = o; }
            }
        }
    }
};
template <class Epi, class Sched, bool ALIGN_EPI = false, bool SP2 = false>
__device__ __forceinline__ void gemm_phase(PG8_LAS unsigned char* lds, const Gemm g, const Sched& S, const Epi& E) {
    const int tid = opaque_tid(), wid = __builtin_amdgcn_readfirstlane(tid >> 6), lane = tid & 63, wr = wid >> 2, wc = wid & 3, fr = lane & 15, fq = lane >> 4;
    const int K = g.K, nt = K / BK;
    unsigned voffA[2], voffB[2];
#pragma unroll
    for (int i = 0; i < 2; ++i) { int R, C; stage_rc(tid * 16 + i * 8192, R, C); const int Rb = Epi::PERM ? ((R & ~31) + perm32(R & 31)) : R;
        const int Ra = Epi::PERMA ? ((R & ~63) + 4 * (R & 15) + ((R >> 4) & 3)) : R;
        voffA[i] = (unsigned)(Ra * K + C) * 2u; voffB[i] = (unsigned)(Rb * K + C) * 2u; }
    const size_t kstep = (size_t)(BK * 2);
    const size_t hstep = (size_t)HALF * K * 2;
    const size_t tstep = 2 * hstep;
    const unsigned ldsw = (unsigned)wid * 1024u;
    const int aoff = lds_byte(wr * 64 + fr, fq * 8), boff = lds_byte(wc * 32 + fr, fq * 8);
#define PG8_SA(b, h) (((b) * 2 + (h)) * HTB)
#define PG8_SB(b, h) ((4 + (b) * 2 + (h)) * HTB)
#define PG8_STAGE(bufoff, gbase, voff) do { _Pragma("unroll") for (int _i = 0; _i < 2; ++_i) \
        __builtin_amdgcn_global_load_lds((const unsigned*)((const char*)(gbase) + (voff)[_i]), (PG8_LAS unsigned*)(lds + (bufoff) + ldsw + _i * 8192), 16, 0, 0); } while (0)
#define PG8_LDA(dst, b, h) do { _Pragma("unroll") for (int m = 0; m < 4; ++m) _Pragma("unroll") for (int k = 0; k < 2; ++k) dst[m][k] = *(const PG8_LAS bf16x8*)(lds + PG8_SA(b, h) + aoff + m * 2048 + k * 1024); } while (0)
#define PG8_LDB(dst, b, h) do { _Pragma("unroll") for (int n = 0; n < 2; ++n) _Pragma("unroll") for (int k = 0; k < 2; ++k) dst[n][k] = *(const PG8_LAS bf16x8*)(lds + PG8_SB(b, h) + boff + n * 2048 + k * 1024); } while (0)
#define PG8_MMA(ai, bj, At, Bt) do { __builtin_amdgcn_s_setprio(1); _Pragma("unroll") for (int m = 0; m < 4; ++m) _Pragma("unroll") for (int n = 0; n < 2; ++n) _Pragma("unroll") for (int k = 0; k < 2; ++k) \
        acc[ai][bj][m][n] = __builtin_amdgcn_mfma_f32_16x16x32_bf16(Bt[n][k], At[m][k], acc[ai][bj][m][n], 0, 0, 0); __builtin_amdgcn_s_setprio(0); } while (0)
#define PG8_WAIT_V(n) asm volatile("s_waitcnt vmcnt(" #n ")" ::: "memory")
#define PG8_WAIT_L(n) asm volatile("s_waitcnt lgkmcnt(" #n ")" ::: "memory")
#define PG8_BAR __builtin_amdgcn_s_barrier()
#define PG8_SCHED __builtin_amdgcn_sched_barrier(0)
    Unit cur, nxt; int ui = 0;
    if (!S.next(0, cur)) return;
    f32x4 acc[2][2][4][2];
#pragma unroll
    for (int a = 0; a < 2; ++a)
#pragma unroll
        for (int b = 0; b < 2; ++b)
#pragma unroll
            for (int m = 0; m < 4; ++m)
#pragma unroll
                for (int n = 0; n < 2; ++n) acc[a][b][m][n] = (f32x4){0.f, 0.f, 0.f, 0.f};
    bf16x8 At[4][2], B0[2][2], B1[2][2];
    const char* cA = (const char*)g.A + (size_t)cur.pm * tstep; const char* cB = (const char*)g.Bt + (size_t)cur.pn * tstep;
    S.a_ready(cur);
    if constexpr (SP2) {
        PG8_STAGE(PG8_SB(0, 0), cB, voffB); PG8_STAGE(PG8_SB(0, 1), cB + hstep, voffB); PG8_STAGE(PG8_SA(0, 0), cA, voffA); PG8_STAGE(PG8_SA(0, 1), cA + hstep, voffA);
        if (wr == 1) PG8_BAR;
        PG8_WAIT_V(2); PG8_BAR;
        PG8_STAGE(PG8_SB(1, 0), cB + kstep, voffB); PG8_STAGE(PG8_SA(1, 0), cA + kstep, voffA); PG8_STAGE(PG8_SB(1, 1), cB + hstep + kstep, voffB);
        PG8_WAIT_V(6); PG8_BAR;
    } else {
        PG8_STAGE(PG8_SB(0, 0), cB, voffB); PG8_STAGE(PG8_SA(0, 0), cA, voffA); PG8_STAGE(PG8_SB(0, 1), cB + hstep, voffB); PG8_STAGE(PG8_SA(0, 1), cA + hstep, voffA);
        if (wr == 1) PG8_BAR;
        PG8_WAIT_V(4); PG8_BAR;
        PG8_STAGE(PG8_SB(1, 0), cB + kstep, voffB); PG8_STAGE(PG8_SA(1, 0), cA + kstep, voffA); PG8_STAGE(PG8_SB(1, 1), cB + hstep + kstep, voffB);
        PG8_WAIT_V(6); PG8_BAR;
    }
    for (;;) {
        const bool has_next = S.next(ui + 1, nxt);
        const char* nA = has_next ? (const char*)g.A + (size_t)nxt.pm * tstep : cA; const char* nB = has_next ? (const char*)g.Bt + (size_t)nxt.pn * tstep : cB;
        for (int t = 0; t < nt; t += 2) {
            const bool last = (t == nt - 2);
            const char* a1 = cA + (size_t)(t + 1) * kstep;
            const char* a2 = last ? nA : cA + (size_t)(t + 2) * kstep; const char* b2 = last ? nB : cB + (size_t)(t + 2) * kstep;
            const char* a3 = a2 + kstep; const char* b3 = b2 + kstep;
            if (last && has_next) S.a_ready(nxt);
            if constexpr (SP2) {
            PG8_LDB(B0, 0, 0); PG8_LDB(B1, 0, 1); PG8_SCHED; PG8_LDA(At, 0, 0); PG8_STAGE(PG8_SA(1, 1), a1 + hstep, voffA);
            PG8_WAIT_V(8); PG8_WAIT_L(0); PG8_BAR; PG8_MMA(0, 0, At, B0); PG8_MMA(0, 1, At, B1); PG8_BAR; PG8_SCHED;
            PG8_LDA(At, 0, 1); PG8_STAGE(PG8_SB(0, 0), b2, voffB); PG8_STAGE(PG8_SB(0, 1), b2 + hstep, voffB); PG8_STAGE(PG8_SA(0, 0), a2, voffA);
            PG8_WAIT_V(8); PG8_WAIT_L(0); PG8_BAR; PG8_MMA(1, 0, At, B0); PG8_MMA(1, 1, At, B1); PG8_BAR; PG8_SCHED;
            PG8_LDB(B0, 1, 0); PG8_LDB(B1, 1, 1); PG8_SCHED; PG8_LDA(At, 1, 0); PG8_STAGE(PG8_SA(0, 1), a2 + hstep, voffA);
            PG8_WAIT_V(8); PG8_WAIT_L(0); PG8_BAR; PG8_MMA(0, 0, At, B0); PG8_MMA(0, 1, At, B1); PG8_BAR; PG8_SCHED;
            PG8_LDA(At, 1, 1); PG8_STAGE(PG8_SB(1, 0), b3, voffB); PG8_STAGE(PG8_SB(1, 1), b3 + hstep, voffB); PG8_STAGE(PG8_SA(1, 0), a3, voffA);
            PG8_WAIT_V(8); PG8_WAIT_L(0); PG8_BAR; PG8_MMA(1, 0, At, B0); PG8_MMA(1, 1, At, B1); PG8_BAR; PG8_SCHED;
            } else {
            PG8_LDB(B0, 0, 0); PG8_SCHED; PG8_LDA(At, 0, 0); PG8_STAGE(PG8_SA(1, 1), a1 + hstep, voffA);
            PG8_WAIT_L(8); PG8_BAR; PG8_WAIT_L(0); PG8_MMA(0, 0, At, B0); PG8_BAR; PG8_SCHED;
            PG8_LDB(B1, 0, 1); PG8_STAGE(PG8_SB(0, 0), b2, voffB);
            PG8_BAR; PG8_WAIT_L(0); PG8_MMA(0, 1, At, B1); PG8_BAR;
            PG8_LDA(At, 0, 1); PG8_STAGE(PG8_SA(0, 0), a2, voffA);
            PG8_BAR; PG8_WAIT_L(0); PG8_MMA(1, 0, At, B0); PG8_BAR; PG8_SCHED;
            PG8_STAGE(PG8_SB(0, 1), b2 + hstep, voffB);
            PG8_WAIT_V(6); PG8_BAR; PG8_MMA(1, 1, At, B1); PG8_BAR;
            PG8_LDB(B0, 1, 0); PG8_SCHED; PG8_LDA(At, 1, 0); PG8_STAGE(PG8_SA(0, 1), a2 + hstep, voffA);
            PG8_WAIT_L(8); PG8_BAR; PG8_WAIT_L(0); PG8_MMA(0, 0, At, B0); PG8_BAR; PG8_SCHED;
            PG8_LDB(B1, 1, 1); PG8_STAGE(PG8_SB(1, 0), b3, voffB);
            PG8_BAR; PG8_WAIT_L(0); PG8_MMA(0, 1, At, B1); PG8_BAR;
            PG8_LDA(At, 1, 1); PG8_STAGE(PG8_SA(1, 0), a3, voffA);
            PG8_BAR; PG8_WAIT_L(0); PG8_MMA(1, 0, At, B0); PG8_BAR; PG8_SCHED;
            PG8_STAGE(PG8_SB(1, 1), b3 + hstep, voffB);
            PG8_WAIT_V(6); PG8_BAR; PG8_MMA(1, 1, At, B1); PG8_BAR;
            }
        }
        if constexpr (ALIGN_EPI) { if (wr == 0) PG8_BAR; }
        if constexpr (!Epi::AFTER_DRAIN) { E(acc, cur, wr, wc, fr, fq); S.done(cur); }
        if (!has_next) break;
#pragma unroll
        for (int a = 0; a < 2; ++a)
#pragma unroll
            for (int b = 0; b < 2; ++b)
#pragma unroll
                for (int m = 0; m < 4; ++m)
#pragma unroll
                    for (int n = 0; n < 2; ++n) acc[a][b][m][n] = (f32x4){0.f, 0.f, 0.f, 0.f};
        cur = nxt; cA = nA; cB = nB; ++ui;
        if constexpr (ALIGN_EPI) { if (wr == 1) PG8_BAR; }
    }
    PG8_WAIT_V(0);
    if constexpr (!ALIGN_EPI) { if (wr == 0) PG8_BAR; }
    PG8_BAR;
    if constexpr (Epi::AFTER_DRAIN) { E.fused(acc, cur, wr, wc, fr, fq, lds, wid, lane); S.done(cur); }
#undef PG8_SA
#undef PG8_SB
#undef PG8_STAGE
#undef PG8_LDA
#undef PG8_LDB
#undef PG8_MMA
#undef PG8_WAIT_V
#undef PG8_WAIT_L
#undef PG8_BAR
#undef PG8_SCHED
}
}
#include <hip/hip_bf16.h>
#include <cmath>
namespace attn_body {
using bf16=__hip_bfloat16;
using bf16x8=__attribute__((ext_vector_type(8)))short;
using s16x4=__attribute__((ext_vector_type(4)))short;
using f32x16=__attribute__((ext_vector_type(16)))float;
using u32x4=__attribute__((ext_vector_type(4)))unsigned;
constexpr int BATCH=8,NHEAD=8,SEQ=4096,D=64,PQ=3840,PO=1024;
constexpr int NW=8,QBLK=32,QB=QBLK*NW,KVBLK=64,NQB=SEQ/QB;
constexpr int ATTN_UNIT_ROWS=QB;
__device__ __forceinline__ int crow(int r,int hi){return (r&3)+8*(r>>2)+4*hi;}
#define SBAR() __builtin_amdgcn_sched_barrier(0)
__device__ __forceinline__ void cmask(f32x16&p0,f32x16&p1,int jb,int qrel,int hi){
  const float NEG=-INFINITY; int kb=64*jb+4*hi;
  #pragma unroll
  for(int r=0;r<16;++r){int kv=kb+(r&3)+8*(r>>2); if(kv>qrel)p0[r]=NEG; if(kv+32>qrel)p1[r]=NEG;}
}

constexpr int NSLOT=3, SLOTB=8192, SEL_OFF=90112+64;
constexpr int LDS_K=0, LDS_V=NSLOT*SLOTB, LDS_WS=2*NSLOT*SLOTB, LDS_OST=LDS_WS+NW*64*4, LDS_BYTES=LDS_OST+NW*4096;
constexpr float C2=0.125f*1.4426950408889634f;
__device__ __forceinline__ void glds16(const void*gsrc,unsigned lds_dst){unsigned keep;
  asm volatile("s_mov_b32 %0, m0\n\ts_mov_b32 m0, %2\n\ts_nop 0\n\tglobal_load_lds_dwordx4 %1, off\n\ts_mov_b32 m0, %0":"=&s"(keep):"v"(gsrc),"s"(lds_dst):"memory");}
__device__ __forceinline__ float max3f(float a,float b,float c){float r;asm("v_max3_f32 %0, %1, %2, %3":"=v"(r):"v"(a),"v"(b),"v"(c));return r;}
__device__ __forceinline__ float max2f(float a,float b){float r;asm("v_max_f32_e32 %0, %1, %2":"=v"(r):"v"(a),"v"(b));return r;}
__device__ __forceinline__ float fadd_s(float a,float b){float r;asm("v_add_f32_e32 %0, %1, %2":"=v"(r):"v"(a),"v"(b));return r;}
__device__ __forceinline__ float fsub_s(float a,float b){float r;asm("v_sub_f32_e32 %0, %1, %2":"=v"(r):"v"(a),"v"(b));return r;}
typedef float f32x2_t __attribute__((ext_vector_type(2))); typedef __bf16 bf16x2_t __attribute__((ext_vector_type(2)));
__device__ __forceinline__ unsigned cvtpk_s(float lo,float hi){f32x2_t v={lo,hi};bf16x2_t b=__builtin_convertvector(v,bf16x2_t);return __builtin_bit_cast(unsigned,b);}
#define WAIT_BAR(N) asm volatile("s_waitcnt vmcnt(" #N ") lgkmcnt(0)\n\ts_barrier":::"memory")

__device__ __forceinline__ void qkt(f32x16&p0,f32x16&p1,const char*Kslot,const bf16x8*qr,const f32x16&negm,int r32,int hi){
  const char*kb=Kslot+hi*1024+r32*16;
  #pragma unroll
  for(int d0=0;d0<4;++d0){
    const bf16x8 b0=*reinterpret_cast<const bf16x8*>(kb+d0*2048);
    const bf16x8 b1=*reinterpret_cast<const bf16x8*>(kb+d0*2048+512);
    if(d0==0){p0=__builtin_amdgcn_mfma_f32_32x32x16_bf16(b0,qr[0],negm,0,0,0);p1=__builtin_amdgcn_mfma_f32_32x32x16_bf16(b1,qr[0],negm,0,0,0);}
    else{p0=__builtin_amdgcn_mfma_f32_32x32x16_bf16(b0,qr[d0],p0,0,0,0);p1=__builtin_amdgcn_mfma_f32_32x32x16_bf16(b1,qr[d0],p1,0,0,0);}}
}
typedef __attribute__((address_space(3))) const char* lds_cptr;
typedef short v4i16_t __attribute__((ext_vector_type(4)));
__device__ __forceinline__ void kload8(bf16x8*kf,lds_cptr kp){
  kf[0]=*(const __attribute__((address_space(3))) bf16x8*)(kp);      kf[1]=*(const __attribute__((address_space(3))) bf16x8*)(kp+512);
  kf[2]=*(const __attribute__((address_space(3))) bf16x8*)(kp+2048); kf[3]=*(const __attribute__((address_space(3))) bf16x8*)(kp+2560);
  kf[4]=*(const __attribute__((address_space(3))) bf16x8*)(kp+4096); kf[5]=*(const __attribute__((address_space(3))) bf16x8*)(kp+4608);
  kf[6]=*(const __attribute__((address_space(3))) bf16x8*)(kp+6144); kf[7]=*(const __attribute__((address_space(3))) bf16x8*)(kp+6656);
}
__device__ __forceinline__ void kload2(bf16x8*kf,lds_cptr kp,int j){ kf[2*j]=*(const __attribute__((address_space(3))) bf16x8*)(kp+j*2048); kf[2*j+1]=*(const __attribute__((address_space(3))) bf16x8*)(kp+j*2048+512); }
__device__ __forceinline__ s16x4 vtr(lds_cptr p){ return __builtin_bit_cast(s16x4,__builtin_amdgcn_ds_read_tr16_b64_v4i16((__attribute__((address_space(3))) v4i16_t*)p)); }
__device__ __forceinline__ float rowmax(const f32x16&p0,const f32x16&p1){
  float a=max3f(p0[0],p0[1],p1[0]),b=max3f(p0[2],p0[3],p1[1]);a=max3f(a,p1[2],p1[3]);
  #pragma unroll
  for(int r=4;r<16;r+=4){a=max3f(a,p0[r],p0[r+1]);b=max3f(b,p0[r+2],p0[r+3]);a=max3f(a,p1[r],p1[r+1]);b=max3f(b,p1[r+2],p1[r+3]);}
  const float m=max2f(a,b);
  auto rr=__builtin_amdgcn_permlane32_swap(__float_as_uint(m),__float_as_uint(m),false,false);
  return max2f(__uint_as_float(rr[0]),__uint_as_float(rr[1]));
}
__device__ __forceinline__ void pv(f32x16*o,int vb,bf16x8 pa0,bf16x8 pa1,bf16x8 pa2,bf16x8 pa3){
  #pragma unroll
  for(int d0=0;d0<2;++d0){s16x4 lo[4],hi[4];
    #pragma unroll
    for(int ks=0;ks<4;++ks){
      asm volatile("ds_read_b64_tr_b16 %0,%1 offset:%c2":"=&v"(lo[ks]):"v"(vb),"i"(d0*4096+ks*1024):"memory");
      asm volatile("ds_read_b64_tr_b16 %0,%1 offset:%c2":"=&v"(hi[ks]):"v"(vb),"i"(d0*4096+ks*1024+512):"memory");}
    asm volatile("s_waitcnt lgkmcnt(0)":::"memory");SBAR();
    #define PK(k) (bf16x8){lo[k][0],lo[k][1],lo[k][2],lo[k][3],hi[k][0],hi[k][1],hi[k][2],hi[k][3]}
    o[d0]=__builtin_amdgcn_mfma_f32_32x32x16_bf16(pa0,PK(0),o[d0],0,0,0);
    o[d0]=__builtin_amdgcn_mfma_f32_32x32x16_bf16(pa1,PK(1),o[d0],0,0,0);
    o[d0]=__builtin_amdgcn_mfma_f32_32x32x16_bf16(pa2,PK(2),o[d0],0,0,0);
    o[d0]=__builtin_amdgcn_mfma_f32_32x32x16_bf16(pa3,PK(3),o[d0],0,0,0);
    #undef PK
  }
}

#ifndef ATTN_STORE16
#define ATTN_STORE16(p,v) (*(u32x4*)(p)=(v))
#endif
template<int THRL> __device__ __forceinline__ void attn_unit(int b,int h,int qb,const bf16*Q,const bf16*__restrict__ K,const bf16*__restrict__ V,bf16*O,char*shm){
  const int tid=opaque_tid(),lane=tid&63,r32=lane&31,hi=lane>>5; const int wid=__builtin_amdgcn_readfirstlane(tid>>6);
  const long rowbase=(long)b*SEQ; const int q0=qb*QB;
  const bf16*Qw=Q+(rowbase+q0+wid*QBLK)*PQ+h*D;
  const bf16*Kh=K+rowbase*PQ+h*D,*Vh=V+rowbase*PQ+h*D;
  const unsigned lds0=(unsigned)(uintptr_t)shm;
  float*wsf=(float*)(shm+LDS_WS)+wid*64;
  const bf16*ksrc=Kh+(long)lane*PQ+wid*8;
  const bf16*vsrc=Vh+(long)(16*(wid&3)+(lane>>2))*PQ+(wid>>2)*32+(lane&3)*8;
  const unsigned kdst=lds0+LDS_K+wid*1024, vdst=lds0+LDS_V+wid*1024;
  #define KT(t) (((t)<4)?(NT-4+(t)):((t)-4))
  #define DMA_K(t,slot) glds16(ksrc+(long)KT(t)*KVBLK*PQ,(unsigned)__builtin_amdgcn_readfirstlane(kdst+(slot)))
  #define DMA_V(t,slot) glds16(vsrc+(long)KT(t)*KVBLK*PQ,(unsigned)__builtin_amdgcn_readfirstlane(vdst+(slot)))
  const int vb0=(int)(lds0+LDS_V)+((lane>>4)&1)*32+(lane&3)*8+(4*hi+((lane&15)>>2))*64;
  const char*Kbase=shm+LDS_K; bf16x8 kf[8];
  const lds_cptr shm3=(lds_cptr)shm; const lds_cptr kp0=shm3+LDS_K+hi*1024+r32*16; const lds_cptr vp0=shm3+LDS_V+((lane>>4)&1)*32+(lane&3)*8+(4*hi+((lane&15)>>2))*64;
  const int NT=(q0+QB)/KVBLK;
  DMA_K(0,0);DMA_V(0,0);DMA_K(1,SLOTB);
  bf16x8 qr[4];
  #pragma unroll
  for(int d0=0;d0<4;++d0)qr[d0]=*reinterpret_cast<const bf16x8*>(&Qw[(long)r32*PQ+d0*16+hi*8]);
  const unsigned selmask=((const unsigned*)(shm+SEL_OFF))[wid*QBLK+r32];
  float mhat=0.f,l_reg=0.f;f32x16 o[2];o[0]=f32x16{};o[1]=f32x16{};f32x16 negm=f32x16{};asm volatile("":"+v"(negm));
  const int qrel=wid*QBLK+r32;
  #define CMASK(P0,P1,t) do{const int t_=(t); if(t_<4){cmask(P0,P1,t_,qrel,hi);} else if(!((selmask>>((t_-4)>>2))&1u)){ _Pragma("unroll") for(int r_=0;r_<16;++r_){P0[r_]=-INFINITY;P1[r_]=-INFINITY;} } }while(0)
  bool resc=false;
  #define START(P0,P1) do{ const float rm=rowmax(P0,P1); resc=false; \
    { const float dl=rm; mhat=fadd_s(mhat,dl); \
      _Pragma("unroll") for(int r=0;r<16;++r){P0[r]=fsub_s(P0[r],dl);P1[r]=fsub_s(P1[r],dl);} \
      } \
    _Pragma("unroll") for(int r=0;r<16;++r)P0[r]=__builtin_amdgcn_exp2f(P0[r]); }while(0)
  #define RESC() do{ if(resc){ asm volatile("s_waitcnt lgkmcnt(0)":::"memory"); \
      _Pragma("unroll") for(int d_=0;d_<2;++d_) _Pragma("unroll") for(int r=0;r<16;++r)o[d_][r]*=wsf[crow(r,hi)]; } }while(0)
  f32x16 pA0,pA1,pB0,pB1;
  int sl_prev=0,sl_cur=0,sl_next=SLOTB;
  #define ROT() do{sl_prev=sl_cur;sl_cur=sl_next;sl_next=(sl_next==(NSLOT-1)*SLOTB)?0:sl_next+SLOTB;}while(0)
  DMA_K(2,2*SLOTB);
  WAIT_BAR(3);
  qkt(pA0,pA1,Kbase,qr,negm,r32,hi);asm volatile("s_nop 15\n\ts_nop 7":"+v"(pA0),"+v"(pA1));CMASK(pA0,pA1,0);
  START(pA0,pA1);
  _Pragma("unroll") for(int r=0;r<16;++r)pA1[r]=__builtin_amdgcn_exp2f(pA1[r]);
  WAIT_BAR(0);
  DMA_K(3,0);DMA_V(1,SLOTB);
  ROT();
  kload8(kf,kp0+sl_cur);
  WAIT_BAR(2);
  s16x4 vlo[8],vhi[8]; u32x4 pw0,pw1,pw2,pw3;
  #define PKW(P,B) cvtpk_s(P[B],P[B+1])
  #define PAF(k) __builtin_bit_cast(bf16x8,pw##k)
  #define VFR(i) (bf16x8){vlo[i][0],vlo[i][1],vlo[i][2],vlo[i][3],vhi[i][0],vhi[i][1],vhi[i][2],vhi[i][3]}
  #define PIN(x) asm volatile("":"+v"(x))
  #define MX3(a,b,c) __builtin_fmaxf(__builtin_fmaxf((a),(b)),(c))
  #define GAPA(MF,A0,A1,A2,A3,W0,W1,PW) do{ MF; sacc+=A0; sacc+=A1; sacc+=A2; sacc+=A3; PIN(sacc); W0; W1; PIN(PW); SBAR(); }while(0)
  #define EX(v) __builtin_amdgcn_exp2f(v)
  #define GAPB(MF,X,B) do{ MF; X[B]=EX(X[B]); X[B+1]=EX(X[B+1]); X[B+2]=EX(X[B+2]); X[B+3]=EX(X[B+3]); PIN(X); SBAR(); }while(0)
  #define VRD(i) do{ vlo[i]=vtr(vp_+(((i)>>2)*4096+((i)&3)*1024)); vhi[i]=vtr(vp_+(((i)>>2)*4096+((i)&3)*1024+512)); }while(0)
  #define KRD(G,j) do{ if(G){ kload2(kf,kp0+sl_next,j); SBAR(); } }while(0)
  #define STEP(C0,C1,P0,P1,t,GK,GV,GL) do{ \
    { const int t_=(t); if(((t_&3)==0)||resc||t_==1){ const float nm_=((t_<4)||((selmask>>((t_-4)>>2))&1u))?-mhat:-INFINITY; \
        _Pragma("unroll") for(int r=0;r<16;++r)negm[r]=nm_; asm volatile("":"+v"(negm)); } } \
    SBAR(); \
    const lds_cptr vp_=vp0+sl_prev; \
    VRD(0); SBAR(); float sacc=(P0[0]+P0[1]); \
    GAPA(C0=__builtin_amdgcn_mfma_f32_32x32x16_bf16(kf[0],qr[0],negm,0,0,0), P0[2],P0[3],P0[4],P0[5],     pw0[0]=PKW(P0,0), pw0[1]=PKW(P0,2), pw0); \
    VRD(4); SBAR(); GAPA(C1=__builtin_amdgcn_mfma_f32_32x32x16_bf16(kf[1],qr[0],negm,0,0,0), P0[6],P0[7],P0[8],P0[9],     pw0[2]=PKW(P0,4), pw0[3]=PKW(P0,6), pw0); \
    VRD(1); SBAR(); GAPA(C0=__builtin_amdgcn_mfma_f32_32x32x16_bf16(kf[2],qr[1],C0,0,0,0),   P0[10],P0[11],P0[12],P0[13], pw1[0]=PKW(P0,8), pw1[1]=PKW(P0,10), pw1); \
    VRD(5); SBAR(); GAPA(C1=__builtin_amdgcn_mfma_f32_32x32x16_bf16(kf[3],qr[1],C1,0,0,0),   P0[14],P0[15],P1[0],P1[1],   pw1[2]=PKW(P0,12),pw1[3]=PKW(P0,14), pw1); \
    VRD(2); SBAR(); GAPA(C0=__builtin_amdgcn_mfma_f32_32x32x16_bf16(kf[4],qr[2],C0,0,0,0),   P1[2],P1[3],P1[4],P1[5],     pw2[0]=PKW(P1,0), pw2[1]=PKW(P1,2), pw2); \
    VRD(6); SBAR(); GAPA(C1=__builtin_amdgcn_mfma_f32_32x32x16_bf16(kf[5],qr[2],C1,0,0,0),   P1[6],P1[7],P1[8],P1[9],     pw2[2]=PKW(P1,4), pw2[3]=PKW(P1,6), pw2); \
    VRD(3); SBAR(); GAPA(C0=__builtin_amdgcn_mfma_f32_32x32x16_bf16(kf[6],qr[3],C0,0,0,0),   P1[10],P1[11],P1[12],P1[13], pw3[0]=PKW(P1,8), pw3[1]=PKW(P1,10), pw3); \
    VRD(7); SBAR(); GAPA(C1=__builtin_amdgcn_mfma_f32_32x32x16_bf16(kf[7],qr[3],C1,0,0,0),   P1[14],P1[15],0.f,0.f,       pw3[2]=PKW(P1,12),pw3[3]=PKW(P1,14), pw3); \
    l_reg+=sacc; \
    if(GK){DMA_K((t)+3,sl_cur);} if(GV){DMA_V((t)+1,sl_next);} \
    { const int t_=(t); if(t_<4) cmask(C0,C1,t_,qrel,hi); } \
    { float a=MX3(C0[0],C0[1],C1[0]),b=MX3(C0[2],C0[3],C1[1]); a=MX3(a,C1[2],C1[3]); \
      _Pragma("unroll") for(int r=4;r<16;r+=4){a=MX3(a,C0[r],C0[r+1]);b=MX3(b,C0[r+2],C0[r+3]);a=MX3(a,C1[r],C1[r+1]);b=MX3(b,C1[r+2],C1[r+3]);} \
      float rm=__builtin_fmaxf(a,b); { auto rr=__builtin_amdgcn_permlane32_swap(__float_as_uint(rm),__float_as_uint(rm),false,false); rm=__builtin_fmaxf(__uint_as_float(rr[0]),__uint_as_float(rr[1])); } \
      resc=false; \
      if(__builtin_expect(__any(rm>(float)THRL),0)){ const float dl=__builtin_fmaxf(rm,0.f); mhat+=dl; \
        _Pragma("unroll") for(int r=0;r<16;++r){C0[r]-=dl;C1[r]-=dl;} \
        const float f=__builtin_amdgcn_exp2f(-dl); l_reg*=f; if(hi==0)wsf[r32]=f; resc=true; } } \
    SBAR(); \
    GAPB(o[0]=__builtin_amdgcn_mfma_f32_32x32x16_bf16(PAF(0),VFR(0),o[0],0,0,0), C0,0); \
    GAPB(o[1]=__builtin_amdgcn_mfma_f32_32x32x16_bf16(PAF(0),VFR(4),o[1],0,0,0), C0,4); \
    KRD(GL,0); GAPB(o[0]=__builtin_amdgcn_mfma_f32_32x32x16_bf16(PAF(1),VFR(1),o[0],0,0,0), C0,8); \
    KRD(GL,1); GAPB(o[1]=__builtin_amdgcn_mfma_f32_32x32x16_bf16(PAF(1),VFR(5),o[1],0,0,0), C0,12); \
    KRD(GL,2); GAPB(o[0]=__builtin_amdgcn_mfma_f32_32x32x16_bf16(PAF(2),VFR(2),o[0],0,0,0), C1,0); \
    KRD(GL,3); GAPB(o[1]=__builtin_amdgcn_mfma_f32_32x32x16_bf16(PAF(2),VFR(6),o[1],0,0,0), C1,4); \
    GAPB(o[0]=__builtin_amdgcn_mfma_f32_32x32x16_bf16(PAF(3),VFR(3),o[0],0,0,0), C1,8); \
    GAPB(o[1]=__builtin_amdgcn_mfma_f32_32x32x16_bf16(PAF(3),VFR(7),o[1],0,0,0), C1,12); \
    }while(0)
  int t=1;
  for(;t+5<NT;t+=2){
    STEP(pB0,pB1,pA0,pA1,t,true,true,true);     WAIT_BAR(2); RESC(); ROT();
    STEP(pA0,pA1,pB0,pB1,t+1,true,true,true);   WAIT_BAR(2); RESC(); ROT();
  }
  #define ENDW(tt) do{ if((tt)+3<NT){WAIT_BAR(2);} else if((tt)+2<NT){WAIT_BAR(1);} else {WAIT_BAR(0);} }while(0)
  for(;t+1<NT;t+=2){
    STEP(pB0,pB1,pA0,pA1,t,(t+3<NT),(t+1<NT),(t+1<NT));       ENDW(t);   RESC(); ROT();
    STEP(pA0,pA1,pB0,pB1,t+1,(t+4<NT),(t+2<NT),(t+2<NT));     ENDW(t+1); RESC(); ROT();
  }
  STEP(pB0,pB1,pA0,pA1,NT-1,false,false,false); RESC();
  { float sacc=pB0[0]+pB0[1]; _Pragma("unroll") for(int r=2;r<16;++r)sacc+=pB0[r]; _Pragma("unroll") for(int r=0;r<16;++r)sacc+=pB1[r]; l_reg+=sacc;
    pw0=(u32x4){PKW(pB0,0),PKW(pB0,2),PKW(pB0,4),PKW(pB0,6)};pw1=(u32x4){PKW(pB0,8),PKW(pB0,10),PKW(pB0,12),PKW(pB0,14)};pw2=(u32x4){PKW(pB1,0),PKW(pB1,2),PKW(pB1,4),PKW(pB1,6)};pw3=(u32x4){PKW(pB1,8),PKW(pB1,10),PKW(pB1,12),PKW(pB1,14)};
    SBAR(); pv(o,vb0+sl_cur,PAF(0),PAF(1),PAF(2),PAF(3)); }
  #undef PKW
  #undef PAF
  #undef VFR
  #undef PIN
  #undef MX3
  #undef GAPA
  #undef GAPB
  #undef EX
  #undef VRD
  #undef KRD
  #undef STEP
  #undef ENDW
  {auto rr=__builtin_amdgcn_permlane32_swap(__float_as_uint(l_reg),__float_as_uint(l_reg),false,false);l_reg=__uint_as_float(rr[0])+__uint_as_float(rr[1]);}
  if(hi==0)wsf[32+r32]=l_reg;asm volatile("s_waitcnt lgkmcnt(0)":::"memory");
  float rli[16];
  #pragma unroll
  for(int r=0;r<16;++r)rli[r]=__builtin_amdgcn_rcpf(wsf[32+crow(r,hi)]);
  bf16*Ow=O+(rowbase+q0+wid*QBLK)*PO+h*D;
  { bf16*stg=(bf16*)(shm+LDS_OST)+wid*2048;
    #pragma unroll
    for(int r=0;r<16;++r){const int orow=crow(r,hi);
      #pragma unroll
      for(int d0=0;d0<2;++d0)stg[orow*64+d0*32+r32]=__float2bfloat16(o[d0][r]*rli[r]);}
    asm volatile("s_waitcnt lgkmcnt(0)":::"memory");
    #pragma unroll
    for(int i=0;i<4;++i){const int row=i*8+(lane>>3),ch=lane&7; const u32x4 v=*(const u32x4*)(stg+row*64+ch*8); ATTN_STORE16(Ow+(long)row*PO+ch*8,v);} }
  asm volatile("s_waitcnt lgkmcnt(0)\n\ts_barrier":::"memory");
  #undef DMA_K
  #undef KT
  #undef DMA_V
  #undef CMASK
  #undef START
  #undef RESC
  #undef ROT
}
constexpr int ATTN_LDS_BYTES=LDS_BYTES;
struct AttnTensors { const bf16* Q; const bf16* K; const bf16* V; bf16* O; };
#undef SBAR
#undef WAIT_BAR
}
typedef unsigned short bf16;
typedef unsigned v4u __attribute__((ext_vector_type(4)));
typedef unsigned v2u __attribute__((ext_vector_type(2)));
typedef float f32x4 __attribute__((ext_vector_type(4)));
typedef short bf16x8 __attribute__((ext_vector_type(8)));
constexpr int NB = 8, SEQL = 4096, DMODEL = 1024, NLAYER = 2, MTOK = NB * SEQL;
constexpr int NIN = 3592, NINP = 3840, DFF = 2816, NUP = 5632;
constexpr int C_QA = 0, C_KA = 512, C_VA = 1024, C_Z = 1536, C_QB = 2048, C_KB = 2560, C_VB = 3072, C_AL = 3584, C_BL = 3588;
constexpr float ALPHA = 1.4142135623730951f, LN_EPS = 1e-5f, NORM_EPS = 1e-6f;
constexpr size_t MiB = 1u << 20;
constexpr size_t WS_CTL = 0, WS_KMEAN = 256 * 1024, WS_GLAST = 512 * 1024, WS_STAT = 576 * 1024;
constexpr size_t WS_W = 1 * MiB, W_LAYER = 26 * MiB, W_IN = 0, W_OUT = 7864320, W_UP = W_OUT + 2 * MiB, W_DOWN = W_UP + 11 * MiB;
constexpr size_t WS_XBF = 53 * MiB;
constexpr size_t WS_PROJ = 117 * MiB;
constexpr size_t WS_GDN = 357 * MiB;
constexpr size_t WS_YX = WS_PROJ;
constexpr size_t WS_ACT = 245 * MiB;
constexpr size_t WS_EDGE = 421 * MiB;
constexpr size_t WS_ROPE = 501 * MiB;
constexpr size_t WS_END = 502 * MiB;
constexpr int CHUNK_REC = 73728;
constexpr int LDS_BYTES = 155648;
constexpr int NTHREADS = 512;

__device__ __forceinline__ float bf2f(unsigned short u) { return __uint_as_float(((unsigned)u) << 16); }
typedef float pk_f32x2 __attribute__((ext_vector_type(2))); typedef __bf16 pk_bf16x2 __attribute__((ext_vector_type(2)));
__device__ __forceinline__ unsigned pk2(float lo, float hi) { const pk_f32x2 v = {lo, hi}; const pk_bf16x2 b = __builtin_convertvector(v, pk_bf16x2); return __builtin_bit_cast(unsigned, b); }
__device__ __forceinline__ unsigned f2bf(float f) { return pk2(f, 0.f); }
__device__ __forceinline__ float wave_sum(float v) {
#pragma unroll
    for (int o = 1; o < 64; o <<= 1) v += __shfl_xor(v, o);
    return v;
}
__device__ __forceinline__ f32x4 mfma16(bf16x8 a, bf16x8 b, f32x4 c) { return __builtin_amdgcn_mfma_f32_16x16x32_bf16(a, b, c, 0, 0, 0); }

template <int MAPID> __device__ __forceinline__ int wmap(int n) {
    if (MAPID == 0) return n;
    if (MAPID == 1) { if (n < 1536) return n; if (n < 3584) return n + 8; if (n < 3592) return n - 3584 + 1536; return -1; }
    { const int pn = n >> 8, rem = n & 255; return (rem >> 7) * DFF + pn * 128 + (rem & 127); }
}
template <int MAPID> __device__ __forceinline__ void transpose_item(const float* W, int K, int N, int NP, bf16* WT, float* scr, int item, int lane) {
    const int nblk = NP / 32, kb = item / nblk, nb = item % nblk, k0 = 64 * kb, n0 = 32 * nb;
    const int src = wmap<MAPID>(n0 + (lane & 31));
#pragma unroll
    for (int i = 0; i < 32; ++i) { const int kk = 2 * i + (lane >> 5); scr[kk * 33 + (lane & 31)] = (src >= 0) ? W[(size_t)(k0 + kk) * N + src] : 0.f; }
    asm volatile("s_waitcnt lgkmcnt(0)" ::: "memory");
    const int c = lane & 7;
#pragma unroll
    for (int j = 0; j < 4; ++j) { const int n = (lane >> 3) + 8 * j; const float* s = scr + (8 * c) * 33 + n;
        v4u o; o.x = pk2(s[0 * 33], s[1 * 33]); o.y = pk2(s[2 * 33], s[3 * 33]); o.z = pk2(s[4 * 33], s[5 * 33]); o.w = pk2(s[6 * 33], s[7 * 33]);
        *(v4u*)(WT + (size_t)(n0 + n) * K + k0 + 8 * c) = o; }
    asm volatile("s_waitcnt lgkmcnt(0)" ::: "memory");
}
struct Ptrs {
    const float *x, *w_in, *conv_w, *a_log, *dt_bias, *norm_g, *w_out, *ln1_g, *ln1_b, *w_up, *fconv_w, *fconv_b, *w_down, *ln2_g, *ln2_b;
    float* out; unsigned char* ws;
};
__device__ __forceinline__ void p0_prologue(const Ptrs& P, unsigned char* lds, int G) {
    const int tid = opaque_tid(), lane = tid & 63, wave = __builtin_amdgcn_readfirstlane(tid >> 6);
    if (wave < 4) {
        float* scr = (float*)(lds + wave * 16384);
        const int gw = blockIdx.x * 4 + wave, NGW = G * 4;
        constexpr int I_IN = 16 * (NINP / 32), I_OUT = 16 * 32, I_UP = 16 * (NUP / 32), I_DN = (DFF / 64) * 32, I_L = I_IN + I_OUT + I_UP + I_DN;
        for (int it = gw; it < NLAYER * I_L; it += NGW) {
            const int l = it / I_L; int r = it % I_L;
            unsigned char* wb = P.ws + WS_W + (size_t)l * W_LAYER;
            if (r < I_IN) { transpose_item<1>(P.w_in + (size_t)l * DMODEL * NIN, DMODEL, NIN, NINP, (bf16*)(wb + W_IN), scr, r, lane); continue; } r -= I_IN;
            if (r < I_OUT) { transpose_item<0>(P.w_out + (size_t)l * DMODEL * DMODEL, DMODEL, DMODEL, DMODEL, (bf16*)(wb + W_OUT), scr, r, lane); continue; } r -= I_OUT;
            if (r < I_UP) { transpose_item<2>(P.w_up + (size_t)l * DMODEL * NUP, DMODEL, NUP, NUP, (bf16*)(wb + W_UP), scr, r, lane); continue; } r -= I_UP;
            transpose_item<0>(P.w_down + (size_t)l * DFF * DMODEL, DFF, DMODEL, DMODEL, (bf16*)(wb + W_DOWN), scr, r, lane);
        }
    } else {
        const int t2 = tid - 256, NT2 = G * 256;
        for (int e = blockIdx.x * 256 + t2; e < SEQL * 8; e += NT2) {
            const int pos = e >> 3, i = e & 7; const float inv = powf(500000.0f, -(float)i / 8.0f);
            float sn, cs; sincosf((float)pos * inv, &sn, &cs);
            pg8::f32x2 t; t.x = cs; t.y = sn; ((pg8::f32x2*)(P.ws + WS_ROPE))[e] = t;
        }
        bf16* xb = (bf16*)(P.ws + WS_XBF);
        const size_t nvec = (size_t)MTOK * DMODEL / 8;
#pragma unroll 4
        for (size_t v = (size_t)blockIdx.x * 256 + t2; v < nvec; v += (size_t)NT2) {
            const f32x4 a = *(const f32x4*)(P.x + v * 8), b = *(const f32x4*)(P.x + v * 8 + 4);
            v4u o; o.x = pk2(a[0], a[1]); o.y = pk2(a[2], a[3]); o.z = pk2(b[0], b[1]); o.w = pk2(b[2], b[3]);
            *(v4u*)(xb + v * 8) = o;
        }
    }
}

__device__ __forceinline__ void ln_unpack(f32x4 (&v)[4], const v4u& a, const v4u& b2) {
    v[0][0] = __uint_as_float(a[0] << 16); v[0][1] = __uint_as_float(a[0] & 0xffff0000u); v[0][2] = __uint_as_float(a[1] << 16); v[0][3] = __uint_as_float(a[1] & 0xffff0000u);
    v[1][0] = __uint_as_float(a[2] << 16); v[1][1] = __uint_as_float(a[2] & 0xffff0000u); v[1][2] = __uint_as_float(a[3] << 16); v[1][3] = __uint_as_float(a[3] & 0xffff0000u);
    v[2][0] = __uint_as_float(b2[0] << 16); v[2][1] = __uint_as_float(b2[0] & 0xffff0000u); v[2][2] = __uint_as_float(b2[1] << 16); v[2][3] = __uint_as_float(b2[1] & 0xffff0000u);
    v[3][0] = __uint_as_float(b2[2] << 16); v[3][1] = __uint_as_float(b2[2] & 0xffff0000u); v[3][2] = __uint_as_float(b2[3] << 16); v[3][3] = __uint_as_float(b2[3] & 0xffff0000u);
}
__device__ __forceinline__ void ln_phase(const bf16* y, float* outf, bf16* outb, float* stat, const float* gam, const float* bet, int G) {
    const int tid = opaque_tid(), lane = tid & 63, wave = tid >> 6;
    f32x4 gv[4], bv[4];
#pragma unroll
    for (int j = 0; j < 4; ++j) { const int c = (j >> 1) * 512 + 8 * lane + 4 * (j & 1); gv[j] = *(const f32x4*)(gam + c); bv[j] = *(const f32x4*)(bet + c); }
    const int NW = G * 8;
    for (int m0 = blockIdx.x * 8 + wave; m0 < MTOK; m0 += 2 * NW) {
        const int m1 = m0 + NW;
        const bf16* y0 = y + (size_t)m0 * DMODEL + 8 * lane; const bf16* y1 = y + (size_t)m1 * DMODEL + 8 * lane;
        const v4u a0 = *(const v4u*)y0, c0 = *(const v4u*)(y0 + 512), a1 = *(const v4u*)y1, c1 = *(const v4u*)(y1 + 512);
        f32x4 v[2][4]; ln_unpack(v[0], a0, c0); ln_unpack(v[1], a1, c1);
        float s[2] = {0.f, 0.f};
#pragma unroll
        for (int q = 0; q < 2; ++q)
#pragma unroll
            for (int j = 0; j < 4; ++j) s[q] += (v[q][j][0] + v[q][j][1]) + (v[q][j][2] + v[q][j][3]);
#pragma unroll
        for (int o = 1; o < 64; o <<= 1) { s[0] += __shfl_xor(s[0], o); s[1] += __shfl_xor(s[1], o); }
        const float mean[2] = {s[0] * (1.f / DMODEL), s[1] * (1.f / DMODEL)};
        float s2[2] = {0.f, 0.f};
#pragma unroll
        for (int q = 0; q < 2; ++q)
#pragma unroll
            for (int j = 0; j < 4; ++j) { v[q][j] = v[q][j] - mean[q]; s2[q] += (v[q][j][0] * v[q][j][0] + v[q][j][1] * v[q][j][1]) + (v[q][j][2] * v[q][j][2] + v[q][j][3] * v[q][j][3]); }
#pragma unroll
        for (int o = 1; o < 64; o <<= 1) { s2[0] += __shfl_xor(s2[0], o); s2[1] += __shfl_xor(s2[1], o); }
#pragma unroll
        for (int q = 0; q < 2; ++q) {
            const int m = q ? m1 : m0;
            const float rstd = 1.f / sqrtf(s2[q] * (1.f / DMODEL) + LN_EPS);
            if (stat != nullptr && lane == 0) { pg8::f32x2 ms; ms.x = mean[q]; ms.y = rstd; *(pg8::f32x2*)(stat + 2 * (size_t)m) = ms; }
            f32x4 o[4];
#pragma unroll
            for (int j = 0; j < 4; ++j) o[j] = v[q][j] * rstd * gv[j] + bv[j];
            if (outf != nullptr) { float* of = outf + (size_t)m * DMODEL + 8 * lane; *(f32x4*)of = o[0]; *(f32x4*)(of + 4) = o[1]; *(f32x4*)(of + 512) = o[2]; *(f32x4*)(of + 516) = o[3]; }
            if (outb != nullptr) { bf16* ob = outb + (size_t)m * DMODEL + 8 * lane; v4u w0, w1; w0[0] = pk2(o[0][0], o[0][1]); w0[1] = pk2(o[0][2], o[0][3]); w0[2] = pk2(o[1][0], o[1][1]); w0[3] = pk2(o[1][2], o[1][3]);
                w1[0] = pk2(o[2][0], o[2][1]); w1[1] = pk2(o[2][2], o[2][3]); w1[2] = pk2(o[3][0], o[3][1]); w1[3] = pk2(o[3][2], o[3][3]); *(v4u*)ob = w0; *(v4u*)(ob + 512) = w1; }
        }
    }
}

__device__ __forceinline__ void fix_phase(const float* edge, bf16* act, const float* cw, const float* cb, int G) {
    const int total = 512 * 2 * (DFF / 4);
    const int tid = opaque_tid();
    for (int it = blockIdx.x * NTHREADS + tid; it < total; it += G * NTHREADS) {
        const int c4 = it % (DFF / 4), rr = (it / (DFF / 4)) & 1, s = it / (DFF / 2);
        const int ch = 4 * c4; const bool first = (s % 64) == 0;
        f32x4 h[2];
#pragma unroll
        for (int bj = 0; bj < 2; ++bj) {
            const int col = bj * DFF + ch;
            const f32x4 z4 = (f32x4){0.f, 0.f, 0.f, 0.f};
            const f32x4 cur = *(const f32x4*)(edge + ((size_t)s * 4 + rr) * NUP + col);
            f32x4 p1, p2;
            if (rr == 1) { p1 = *(const f32x4*)(edge + ((size_t)s * 4 + 0) * NUP + col); p2 = first ? z4 : *(const f32x4*)(edge + ((size_t)(s - 1) * 4 + 3) * NUP + col); }
            else { p1 = first ? z4 : *(const f32x4*)(edge + ((size_t)(s - 1) * 4 + 3) * NUP + col); p2 = first ? z4 : *(const f32x4*)(edge + ((size_t)(s - 1) * 4 + 2) * NUP + col); }
            h[bj] = *(const f32x4*)(cw + 2 * NUP + col) * cur + *(const f32x4*)(cw + NUP + col) * p1 + *(const f32x4*)(cw + col) * p2 + *(const f32x4*)(cb + col);
        }
        v2u o; o.x = pk2(pg8::silu_f(h[0][0]) * h[1][0], pg8::silu_f(h[0][1]) * h[1][1]); o.y = pk2(pg8::silu_f(h[0][2]) * h[1][2], pg8::silu_f(h[0][3]) * h[1][3]);
        *(v2u*)(act + ((size_t)s * 64 + rr) * DFF + ch) = o;
    }
}

__device__ __forceinline__ void logits_group(int grp, const bf16* xb, const bf16* wt, bf16* proj) {
    const int tid = opaque_tid(), lane = tid & 63, wid = tid >> 6, g = lane >> 4, ln = lane & 15;
    const bf16* ap = xb + ((size_t)grp * 128 + wid * 16 + ln) * DMODEL + 8 * g;
    const bf16* bp = wt + (size_t)(3584 + ln) * DMODEL + 8 * g;
    f32x4 acc0 = (f32x4){0.f, 0.f, 0.f, 0.f}, acc1 = acc0;
#pragma unroll 1
    for (int k16 = 0; k16 < 2; ++k16) {
        bf16x8 fa[16], fb[16];
#pragma unroll
        for (int kk = 0; kk < 16; ++kk) { const int ko = (k16 * 16 + kk) * 32; fa[kk] = *(const bf16x8*)(ap + ko); fb[kk] = *(const bf16x8*)(bp + ko); }
#pragma unroll
        for (int kk = 0; kk < 16; kk += 2) { acc0 = mfma16(fa[kk], fb[kk], acc0); acc1 = mfma16(fa[kk + 1], fb[kk + 1], acc1); }
    }
    const f32x4 acc = acc0 + acc1;
    if (ln < 8) {
#pragma unroll
        for (int j = 0; j < 4; ++j) proj[((size_t)grp * 128 + wid * 16 + 4 * g + j) * NINP + 3584 + ln] = (bf16)f2bf(acc[j]);
    }
}

__device__ __forceinline__ void moba_prep_item(bf16* proj, float* kmean, const float* rope, int item, unsigned char* lds) {
    const int tid = opaque_tid(); const int j = item & 15, h = (item >> 4) & 7, b = item >> 7;
    const int r = tid >> 1, part = tid & 1;
    float* tile = (float*)lds;
    float* psum = (float*)(lds + 256 * 65 * 4);
    const int pos = 256 * j + r;
    bf16* qp = proj + ((size_t)b * SEQL + pos) * NINP + C_QB + h * 64 + 32 * part;
    bf16* kp = proj + ((size_t)b * SEQL + pos) * NINP + C_KB + h * 64 + 32 * part;
    float q[32], k[32];
#pragma unroll
    for (int v = 0; v < 4; ++v) { const v4u a = *(const v4u*)(qp + 8 * v), c = *(const v4u*)(kp + 8 * v);
#pragma unroll
        for (int e = 0; e < 4; ++e) { q[8 * v + 2 * e] = bf2f((unsigned short)(a[e] & 0xffffu)); q[8 * v + 2 * e + 1] = bf2f((unsigned short)(a[e] >> 16));
                                      k[8 * v + 2 * e] = bf2f((unsigned short)(c[e] & 0xffffu)); k[8 * v + 2 * e + 1] = bf2f((unsigned short)(c[e] >> 16)); } }
    if (part == 0) {
#pragma unroll
        for (int i = 0; i < 8; ++i) {
            const pg8::f32x2 t2 = ((const pg8::f32x2*)rope)[pos * 8 + i]; const float cs = t2.x, sn = t2.y;
            const float q1 = q[i], q2 = q[i + 8], k1 = k[i], k2 = k[i + 8];
            q[i] = q1 * cs - q2 * sn; q[i + 8] = q2 * cs + q1 * sn; k[i] = k1 * cs - k2 * sn; k[i + 8] = k2 * cs + k1 * sn;
        }
    }
    const float C2 = 0.125f * 1.4426950408889634f;
#pragma unroll
    for (int v = 0; v < 4; ++v) { v4u a, c;
#pragma unroll
        for (int e = 0; e < 4; ++e) { a[e] = pk2(q[8 * v + 2 * e] * C2, q[8 * v + 2 * e + 1] * C2); c[e] = pk2(k[8 * v + 2 * e], k[8 * v + 2 * e + 1]); }
        *(v4u*)(qp + 8 * v) = a; *(v4u*)(kp + 8 * v) = c; }
#pragma unroll
    for (int i = 0; i < 32; ++i) tile[r * 65 + 32 * part + i] = k[i];
    __syncthreads();
    { const int d = tid & 63, seg = tid >> 6; float s = 0.f;
#pragma unroll 8
      for (int rr = 0; rr < 32; ++rr) s += tile[(seg * 32 + rr) * 65 + d];
      psum[seg * 64 + d] = s; }
    __syncthreads();
    if (tid < 64) { float s = 0.f;
#pragma unroll
        for (int w = 0; w < 8; ++w) s += psum[w * 64 + tid];
        const float mv = s * (1.0f / 256.0f); const unsigned hb = pk2(mv, 0.f) & 0xffffu; const float hf = __uint_as_float(hb << 16);
        bf16* kmh = (bf16*)kmean; const size_t ix = ((size_t)(b * 8 + h) * 16 + j) * 64 + tid;
        kmh[ix] = (bf16)hb; kmh[ix + 65536] = (bf16)pk2(mv - hf, 0.f); }
    __syncthreads();
}

constexpr int GSC_OFF = 98304;
__device__ __forceinline__ void moba_select(int b, int h, int qb, const bf16* proj, const bf16* kmh_bh, unsigned char* lds) {
    const int tid = opaque_tid(), lane = tid & 63, wid = tid >> 6, g = lane >> 4, ln = lane & 15;
    const bf16* qp = proj + ((size_t)b * SEQL + qb * 256 + wid * 32 + ln) * NINP + C_QB + h * 64 + 8 * g;
    bf16x8 fa[2][2], fh[2], fl[2];
#pragma unroll
    for (int mt = 0; mt < 2; ++mt)
#pragma unroll
        for (int kk = 0; kk < 2; ++kk) fa[mt][kk] = *(const bf16x8*)(qp + (size_t)mt * 16 * NINP + 32 * kk);
#pragma unroll
    for (int kk = 0; kk < 2; ++kk) { fh[kk] = *(const bf16x8*)(kmh_bh + ln * 64 + 32 * kk + 8 * g); fl[kk] = *(const bf16x8*)(kmh_bh + 65536 + ln * 64 + 32 * kk + 8 * g); }
    float* gsc = (float*)(lds + GSC_OFF) + wid * (32 * 17);
#pragma unroll
    for (int mt = 0; mt < 2; ++mt) {
        f32x4 a = (f32x4){0.f, 0.f, 0.f, 0.f};
#pragma unroll
        for (int kk = 0; kk < 2; ++kk) { a = mfma16(fa[mt][kk], fl[kk], a); a = mfma16(fa[mt][kk], fh[kk], a); }
#pragma unroll
        for (int j = 0; j < 4; ++j) gsc[(16 * mt + 4 * g + j) * 17 + ln] = a[j];
    }
    asm volatile("s_waitcnt lgkmcnt(0)" ::: "memory");
    if (lane < 32) {
        float gate[16];
#pragma unroll
        for (int j = 0; j < 16; ++j) gate[j] = gsc[lane * 17 + j];
        unsigned selmask = 0u;
#pragma unroll
        for (int rk = 0; rk < 3; ++rk) { float best = -INFINITY; int bi = -1;
#pragma unroll
            for (int j = 0; j < 16; ++j) { const bool ok = (j < qb) && !((selmask >> j) & 1u) && (gate[j] > best); if (ok) { best = gate[j]; bi = j; } }
            if (bi >= 0) selmask |= (1u << bi); }
        ((unsigned*)(lds + attn_body::SEL_OFF))[wid * 32 + lane] = selmask;
    }
}
namespace gdn {
constexpr int LQD = 0, LQN = 17408, LKN = 34816, LVBT = 52224, LKBG = 70656, LKDT = 89088, LAF = 107520, LTINV = 124928, LATT = 134144, LGATE = 143360, LSLOT5 = 144384;
constexpr int SLOT0 = LQN, SLOT1 = LQN + 9216, SLOT2 = LQN + 18432;
constexpr int SQ = 136, ST = 72, SA = 68;
__device__ __forceinline__ bf16x8 ld16(const unsigned char* p) { return *(const bf16x8*)p; }

__device__ __forceinline__ void prep_load(v4u (&X)[3][4][2], float& al, float& bl, const bf16* proj, int it, int tid) {
    const int n = it & 63, h = (it >> 6) & 3, b = it >> 8; const int t0 = n * 64; const size_t rowb = (size_t)b * SEQL;
    const int r = tid >> 3, part = tid & 7;
#pragma unroll
    for (int sec = 0; sec < 3; ++sec)
#pragma unroll
        for (int off = 0; off < 4; ++off) {
            const int t = t0 + r - 3 + off; const int tc = t < 0 ? 0 : t;
            const bf16* xp = proj + (rowb + tc) * NINP + sec * 512 + h * 128 + part * 16;
            X[sec][off][0] = *(const v4u*)xp; X[sec][off][1] = *(const v4u*)(xp + 8);
        }
    const bf16* pr = proj + (rowb + t0 + (tid & 63)) * NINP;
    al = bf2f(pr[C_AL + h]); bl = bf2f(pr[C_BL + h]);
}
__device__ __forceinline__ void prep_item(v4u (&X)[3][4][2], float& al_in, float& bl_in, int nit, const float (&wreg)[3], const bf16* proj, unsigned char* rec, float* glast_out, float a_log_h, float dt_bias_h, int b, int h, int n, unsigned char* lds) {
    const int tid = opaque_tid(), lane = tid & 63, wid = tid >> 6, g = lane >> 4, ln = lane & 15;
    bf16* Qn = (bf16*)(lds + LQN); bf16* Qd = (bf16*)(lds + LQD); bf16* Kn = (bf16*)(lds + LKN);
    bf16* VbT = (bf16*)(lds + LVBT); bf16* KbgT = (bf16*)(lds + LKBG); bf16* KdT = (bf16*)(lds + LKDT);
    float* Af = (float*)(lds + LAF); bf16* Wl = (bf16*)(lds + LAF); bf16* Tinv = (bf16*)(lds + SLOT0);     bf16* Att = (bf16*)(lds + LATT);
    float* gcum = (float*)(lds + LGATE); float* beta = gcum + 64; float* expg = gcum + 128; float* kdf = gcum + 192;
    const int t0 = n * 64; const size_t rowb = (size_t)b * SEQL;
    {
        float* wl = (float*)(lds + LAF);
#pragma unroll
        for (int k = 0; k < 3; ++k) wl[tid + 512 * k] = wreg[k];
    }
    if (wid == 0) {
        const float al = al_in, bl = bl_in;
        const float xx = al + dt_bias_h; const float sp = (xx > 20.f) ? xx : __logf(1.0f + __expf(xx));
        float gv = -__expf(a_log_h) * sp;
#pragma unroll
        for (int o = 1; o < 64; o <<= 1) { const float t = __shfl_up(gv, o); if (lane >= o) gv += t; }
        const float gl = __shfl(gv, 63);
        gcum[lane] = gv; beta[lane] = 1.0f / (1.0f + __expf(-bl)); expg[lane] = __expf(gv); kdf[lane] = __expf(gl - gv);
        if (lane == 0) *glast_out = gl;
    }
    __syncthreads();
    for (int rpa_ = 0; rpa_ < ((PROBE_MASK & 1024) ? 2 : 1); ++rpa_)
    {
        const int r = tid >> 3, part = tid & 7;
        if (n == 0 && r < 3) {
#pragma unroll
            for (int sec = 0; sec < 3; ++sec)
#pragma unroll
                for (int off = 0; off < 3; ++off) if (r - 3 + off < 0) { X[sec][off][0] = (v4u){0u, 0u, 0u, 0u}; X[sec][off][1] = X[sec][off][0]; }
        }
        const float be = beta[r], eg = expg[r], kd = kdf[r];
#pragma unroll
        for (int sec = 0; sec < 3; ++sec) {
            float y[16];
#pragma unroll
            for (int i = 0; i < 16; ++i) y[i] = 0.f;
#pragma unroll
            for (int off = 0; off < 4; ++off) {
                const v4u x0 = X[sec][off][0], x1 = X[sec][off][1];
                const float* wp = (const float*)(lds + LAF) + (sec * 4 + off) * 128 + part * 16;
#pragma unroll
                for (int v = 0; v < 4; ++v) { const f32x4 w4 = *(const f32x4*)(wp + 4 * v);
                    const unsigned ua = (v < 2) ? x0[2 * v] : x1[2 * v - 4], ub = (v < 2) ? x0[2 * v + 1] : x1[2 * v - 3];
                    y[4 * v + 0] += w4[0] * bf2f((unsigned short)(ua & 0xffffu)); y[4 * v + 1] += w4[1] * bf2f((unsigned short)(ua >> 16));
                    y[4 * v + 2] += w4[2] * bf2f((unsigned short)(ub & 0xffffu)); y[4 * v + 3] += w4[3] * bf2f((unsigned short)(ub >> 16)); }
            }
            float ssq = 0.f;
#pragma unroll
            for (int i = 0; i < 16; ++i) { y[i] = y[i] * __builtin_amdgcn_rcpf(1.0f + __expf(-y[i])); ssq += y[i] * y[i]; }
            if (sec < 2) { ssq += __shfl_xor(ssq, 1); ssq += __shfl_xor(ssq, 2); ssq += __shfl_xor(ssq, 4); }
            const float rs = rsqrtf(ssq + NORM_EPS);
            if (sec == 0) {
                const float sc = rs * 0.08838834764831845f;
                v4u a0, a1, d0, d1;
#pragma unroll
                for (int e = 0; e < 4; ++e) { a0[e] = pk2(y[2 * e] * sc, y[2 * e + 1] * sc); a1[e] = pk2(y[8 + 2 * e] * sc, y[9 + 2 * e] * sc);
                                              d0[e] = pk2(y[2 * e] * sc * eg, y[2 * e + 1] * sc * eg); d1[e] = pk2(y[8 + 2 * e] * sc * eg, y[9 + 2 * e] * sc * eg); }
                *(v4u*)(Qn + r * SQ + part * 16) = a0; *(v4u*)(Qn + r * SQ + part * 16 + 8) = a1;
                *(v4u*)(Qd + r * SQ + part * 16) = d0; *(v4u*)(Qd + r * SQ + part * 16 + 8) = d1;
            } else if (sec == 1) {
                v4u a0, a1;
#pragma unroll
                for (int e = 0; e < 4; ++e) { a0[e] = pk2(y[2 * e] * rs, y[2 * e + 1] * rs); a1[e] = pk2(y[8 + 2 * e] * rs, y[9 + 2 * e] * rs); }
                *(v4u*)(Kn + r * SQ + part * 16) = a0; *(v4u*)(Kn + r * SQ + part * 16 + 8) = a1;
                const int rsw = ((((r >> 3) ^ part) & 7) << 3) | (r & 7);
#pragma unroll
                for (int i = 0; i < 16; ++i) { const float kn = y[i] * rs; const int d = part * 16 + i;
                    KbgT[d * ST + rsw] = (bf16)f2bf(kn * be * eg); KdT[d * ST + rsw] = (bf16)f2bf(kn * kd); }
            } else {
                const int rsw = ((((r >> 3) ^ part) & 7) << 3) | (r & 7);
#pragma unroll
                for (int i = 0; i < 16; ++i) VbT[(part * 16 + i) * ST + rsw] = (bf16)f2bf(y[i] * be);
            }
        }
    }
    prep_load(X, al_in, bl_in, proj, nit, tid);
    __syncthreads();
    {
        const int Ti = wid >> 1;
        f32x4 aK[2], aQ[2];
#pragma unroll
        for (int tt = 0; tt < 2; ++tt) {
            const int Tj = 2 * (wid & 1) + tt;
            aK[tt] = (f32x4){0.f, 0.f, 0.f, 0.f}; aQ[tt] = aK[tt];
            if (Tj <= Ti) {
#pragma unroll
                for (int kk = 0; kk < 4; ++kk) {
                    const bf16x8 fk = ld16((const unsigned char*)(Kn + (16 * Ti + ln) * SQ + 32 * kk + 8 * g));
                    const bf16x8 fq = ld16((const unsigned char*)(Qn + (16 * Ti + ln) * SQ + 32 * kk + 8 * g));
                    const bf16x8 fb = ld16((const unsigned char*)(Kn + (16 * Tj + ln) * SQ + 32 * kk + 8 * g));
                    aK[tt] = mfma16(fk, fb, aK[tt]); aQ[tt] = mfma16(fq, fb, aQ[tt]);
                }
            }
        }
        __syncthreads();
        bf16* Prow[2] = {(bf16*)(lds + SLOT0), (bf16*)(lds + SLOT2)}; bf16* Ptr[2] = {(bf16*)(lds + SLOT1), (bf16*)(lds + LAF)};
        bf16* Rtr[2] = {(bf16*)(lds + LSLOT5), (bf16*)(lds + LTINV)};
        f32x4 racc[2];
#pragma unroll
        for (int tt = 0; tt < 2; ++tt) {
            const int Tj = 2 * (wid & 1) + tt; const int jj = 16 * Tj + ln; const float gj = gcum[jj];
            f32x4 nv4;
#pragma unroll
            for (int j = 0; j < 4; ++j) { const int i = 16 * Ti + 4 * g + j; const float dcy = __expf(fminf(gcum[i] - gj, 0.f));
                const float nv = (i > jj) ? -(beta[i] * aK[tt][j] * dcy) : 0.f;
                Att[i * ST + jj] = (bf16)f2bf((i >= jj) ? aQ[tt][j] * dcy : 0.f);
                racc[tt][j] = nv + ((i == jj) ? 1.f : 0.f); nv4[j] = nv; }
            const unsigned w0 = pk2(nv4[0], nv4[1]), w1 = pk2(nv4[2], nv4[3]);
            Prow[0][(16 * Ti + 4 * g + 0) * ST + jj] = (bf16)(w0 & 0xffffu); Prow[0][(16 * Ti + 4 * g + 1) * ST + jj] = (bf16)(w0 >> 16);
            Prow[0][(16 * Ti + 4 * g + 2) * ST + jj] = (bf16)(w1 & 0xffffu); Prow[0][(16 * Ti + 4 * g + 3) * ST + jj] = (bf16)(w1 >> 16);
            v2u tw; tw[0] = w0; tw[1] = w1; *(v2u*)(Ptr[0] + jj * ST + 16 * Ti + 4 * g) = tw;
            v2u rw; rw[0] = pk2(racc[tt][0], racc[tt][1]); rw[1] = pk2(racc[tt][2], racc[tt][3]); *(v2u*)(Rtr[0] + jj * ST + 16 * Ti + 4 * g) = rw;
        }
        __syncthreads();
#pragma unroll
        for (int k = 1; k <= 6; ++k) {
            const int pb = (k - 1) & 1, pdst = k & 1;
            const int rb = (k & 1), rdst = (k + 1) & 1;
            const int rsrc = (k <= 2) ? 0 : rb;
            const int rwr = (k <= 2) ? 1 : rdst;
            bf16x8 fa[2];
#pragma unroll
            for (int kk = 0; kk < 2; ++kk) fa[kk] = ld16((const unsigned char*)(Prow[pb] + (16 * Ti + ln) * ST + 32 * kk + 8 * g));
#pragma unroll
            for (int tt = 0; tt < 2; ++tt) {
                const int Tj = 2 * (wid & 1) + tt; const int jj = 16 * Tj + ln;
                if (k <= 5) {
                    f32x4 a = (f32x4){0.f, 0.f, 0.f, 0.f};
#pragma unroll
                    for (int kk = 0; kk < 2; ++kk) a = mfma16(fa[kk], ld16((const unsigned char*)(Ptr[pb] + (16 * Tj + ln) * ST + 32 * kk + 8 * g)), a);
                    const unsigned w0 = pk2(a[0], a[1]), w1 = pk2(a[2], a[3]);
                    Prow[pdst][(16 * Ti + 4 * g + 0) * ST + jj] = (bf16)(w0 & 0xffffu); Prow[pdst][(16 * Ti + 4 * g + 1) * ST + jj] = (bf16)(w0 >> 16);
                    Prow[pdst][(16 * Ti + 4 * g + 2) * ST + jj] = (bf16)(w1 & 0xffffu); Prow[pdst][(16 * Ti + 4 * g + 3) * ST + jj] = (bf16)(w1 >> 16);
                    v2u tw; tw[0] = w0; tw[1] = w1; *(v2u*)(Ptr[pdst] + jj * ST + 16 * Ti + 4 * g) = tw;
                }
                if (k >= 2) {
                    f32x4 a = racc[tt];
#pragma unroll
                    for (int kk = 0; kk < 2; ++kk) a = mfma16(fa[kk], ld16((const unsigned char*)(Rtr[rsrc] + (16 * Tj + ln) * ST + 32 * kk + 8 * g)), a);
                    racc[tt] = a;
                    const unsigned w0 = pk2(a[0], a[1]), w1 = pk2(a[2], a[3]);
                    if (k < 6) { v2u rw; rw[0] = w0; rw[1] = w1; *(v2u*)(Rtr[rwr] + jj * ST + 16 * Ti + 4 * g) = rw; }
                    else { bf16* Rf = Prow[0];
                        Rf[(16 * Ti + 4 * g + 0) * ST + jj] = (bf16)(w0 & 0xffffu); Rf[(16 * Ti + 4 * g + 1) * ST + jj] = (bf16)(w0 >> 16);
                        Rf[(16 * Ti + 4 * g + 2) * ST + jj] = (bf16)(w1 & 0xffffu); Rf[(16 * Ti + 4 * g + 3) * ST + jj] = (bf16)(w1 >> 16); }
                }
            }
            __syncthreads();
        }
    }
    for (int rpe_ = 0; rpe_ < ((PROBE_MASK & 2048) ? 2 : 1); ++rpe_) {
    {
        f32x4 aU[4], aW[4];
#pragma unroll
        for (int T = 0; T < 4; ++T) { aU[T] = (f32x4){0.f, 0.f, 0.f, 0.f}; aW[T] = aU[T]; }
#pragma unroll
        for (int kk = 0; kk < 2; ++kk) {
            const bf16x8 bU = ld16((const unsigned char*)(VbT + (16 * wid + ln) * ST + (((4 * kk + g) ^ wid) & 7) * 8));
            const bf16x8 bW = ld16((const unsigned char*)(KbgT + (16 * wid + ln) * ST + (((4 * kk + g) ^ wid) & 7) * 8));
#pragma unroll
            for (int T = 0; T < 4; ++T) { const bf16x8 a = ld16((const unsigned char*)(Tinv + (16 * T + ln) * ST + 32 * kk + 8 * g)); aU[T] = mfma16(a, bU, aU[T]); aW[T] = mfma16(a, bW, aW[T]); }
        }
        v4u u0, u1;
        u0[0] = pk2(aU[0][0], aU[0][1]); u0[1] = pk2(aU[0][2], aU[0][3]); u0[2] = pk2(aU[1][0], aU[1][1]); u0[3] = pk2(aU[1][2], aU[1][3]);
        u1[0] = pk2(aU[2][0], aU[2][1]); u1[1] = pk2(aU[2][2], aU[2][3]); u1[2] = pk2(aU[3][0], aU[3][1]); u1[3] = pk2(aU[3][2], aU[3][3]);
        *(v4u*)(rec + (wid * 64 + lane) * 32) = u0; *(v4u*)(rec + (wid * 64 + lane) * 32 + 16) = u1;
#pragma unroll
        for (int T = 0; T < 4; ++T)
#pragma unroll
            for (int j = 0; j < 4; ++j) Wl[(16 * T + 4 * g + j) * SQ + 16 * wid + ln] = (bf16)f2bf(aW[T][j]);
    }
    __syncthreads();
#pragma unroll
    for (int it = 0; it < 7; ++it) {
        const int p = tid + 512 * it;
        const bf16* src; int stride, T, kk, idx; int dst;
        if (p < 1024) { idx = p; src = Wl; stride = SQ; T = idx >> 8; kk = (idx >> 6) & 3; dst = 16384 + idx * 16; }
        else if (p < 2048) { idx = p - 1024; src = Qd; stride = SQ; T = idx >> 8; kk = (idx >> 6) & 3; dst = 32768 + idx * 16; }
        else if (p < 2560) { idx = p - 2048; src = Att; stride = ST; T = idx >> 7; kk = (idx >> 6) & 1; dst = 49152 + idx * 16; }
        else { idx = p - 2560; src = KdT; stride = ST; T = idx >> 7; kk = (idx >> 6) & 1; dst = 57344 + idx * 16; }
        const int l = idx & 63, gg = l >> 4, m = l & 15;
        const int sw = (p >= 2560) ? (T & 7) : 0;
        const bf16* sp = src + (16 * T + m) * stride + 4 * (gg & 1);
        const v2u lo = *(const v2u*)(sp + (((4 * kk + (gg >> 1)) ^ sw) << 3)), hi = *(const v2u*)(sp + (((4 * kk + 2 + (gg >> 1)) ^ sw) << 3));
        v4u o; o[0] = lo[0]; o[1] = lo[1]; o[2] = hi[0]; o[3] = hi[1];
        *(v4u*)(rec + dst) = o;
    }
    __syncthreads();
    }
}

constexpr int SZ = 272;
__device__ __forceinline__ bf16x8 packS(const f32x4& a, const f32x4& b) {
    v4u r; r[0] = pg8::cvt_pk_bf16(a[0], a[1]); r[1] = pg8::cvt_pk_bf16(a[2], a[3]); r[2] = pg8::cvt_pk_bf16(b[0], b[1]); r[3] = pg8::cvt_pk_bf16(b[2], b[3]);
    return __builtin_bit_cast(bf16x8, r);
}
__device__ __forceinline__ float row16_sum(float v) {
    v += __builtin_bit_cast(float, __builtin_amdgcn_update_dpp(0, __builtin_bit_cast(int, v), 0x128, 0xf, 0xf, false));
    v += __builtin_bit_cast(float, __builtin_amdgcn_update_dpp(0, __builtin_bit_cast(int, v), 0x124, 0xf, 0xf, false));
    v += __builtin_bit_cast(float, __builtin_amdgcn_update_dpp(0, __builtin_bit_cast(int, v), 0x122, 0xf, 0xf, false));
    v += __builtin_bit_cast(float, __builtin_amdgcn_update_dpp(0, __builtin_bit_cast(int, v), 0x121, 0xf, 0xf, false));
    return v;
}
constexpr int SB2 = 32768;
__device__ __forceinline__ void scan_bh(int bh, unsigned char* gdnbase, const float* glast, unsigned char* lds) {
    const int tid = opaque_tid(), lane = tid & 63, wid = tid >> 6;
    f32x4 S[8];
#pragma unroll
    for (int T = 0; T < 8; ++T) S[T] = (f32x4){0.f, 0.f, 0.f, 0.f};
    unsigned char* rec0 = gdnbase + (size_t)bh * 64 * CHUNK_REC;
    v4u st[4];
#pragma unroll
    for (int i = 0; i < 2; ++i) { st[i] = *(const v4u*)(rec0 + 16384 + (size_t)(tid + 512 * i) * 16); st[2 + i] = *(const v4u*)(rec0 + 57344 + (size_t)(tid + 512 * i) * 16); }
    v4u u0 = *(const v4u*)(rec0 + (wid * 64 + lane) * 32), u1 = *(const v4u*)(rec0 + (wid * 64 + lane) * 32 + 16);
    float gl = glast[bh * 64];
#pragma unroll
    for (int i = 0; i < 2; ++i) { *(v4u*)(lds + (tid + 512 * i) * 16) = st[i]; *(v4u*)(lds + 16384 + (tid + 512 * i) * 16) = st[2 + i]; }
    __syncthreads();
    for (int c = 0; c < 64; ++c) {
        unsigned char* buf = lds + (c & 1) * SB2;
        unsigned char* obuf = lds + ((c + 1) & 1) * SB2;
        const int cn = (c + 1 < 64) ? c + 1 : 63;
        unsigned char* rec = rec0 + (size_t)c * CHUNK_REC;
        const unsigned char* recn = rec0 + (size_t)cn * CHUNK_REC;
        const float gln = glast[bh * 64 + cn];
#pragma unroll
        for (int i = 0; i < 2; ++i) { st[i] = *(const v4u*)(recn + 16384 + (size_t)(tid + 512 * i) * 16); st[2 + i] = *(const v4u*)(recn + 57344 + (size_t)(tid + 512 * i) * 16); }
        const v4u un0 = *(const v4u*)(recn + (wid * 64 + lane) * 32), un1 = *(const v4u*)(recn + (wid * 64 + lane) * 32 + 16);
        const float dec = __expf(gl);
        bf16x8 bS[4];
#pragma unroll
        for (int kk = 0; kk < 4; ++kk) { bS[kk] = packS(S[2 * kk], S[2 * kk + 1]); *(bf16x8*)(rec + ((wid * 4 + kk) * 64 + lane) * 16) = bS[kk]; }
        f32x4 Vn[4];
#pragma unroll
        for (int T = 0; T < 4; ++T) {
            f32x4 p = (f32x4){0.f, 0.f, 0.f, 0.f};
#pragma unroll
            for (int kk = 0; kk < 4; ++kk) p = mfma16(ld16(buf + ((T * 4 + kk) * 64 + lane) * 16), bS[kk], p);
            const unsigned ua = (T < 2) ? u0[2 * T] : u1[2 * T - 4], ub = (T < 2) ? u0[2 * T + 1] : u1[2 * T - 3];
            Vn[T][0] = __uint_as_float(ua << 16) - p[0]; Vn[T][1] = __uint_as_float(ua & 0xffff0000u) - p[1];
            Vn[T][2] = __uint_as_float(ub << 16) - p[2]; Vn[T][3] = __uint_as_float(ub & 0xffff0000u) - p[3];
        }
        bf16x8 bV[2];
        bV[0] = packS(Vn[0], Vn[1]); bV[1] = packS(Vn[2], Vn[3]);
        *(bf16x8*)(rec + 57344 + ((wid * 2 + 0) * 64 + lane) * 16) = bV[0]; *(bf16x8*)(rec + 57344 + ((wid * 2 + 1) * 64 + lane) * 16) = bV[1];
#pragma unroll
        for (int T = 0; T < 8; ++T) {
            f32x4 a = S[T] * dec;
#pragma unroll
            for (int kk = 0; kk < 2; ++kk) a = mfma16(ld16(buf + 16384 + ((T * 2 + kk) * 64 + lane) * 16), bV[kk], a);
            S[T] = a;
        }
#pragma unroll
        for (int i = 0; i < 2; ++i) { *(v4u*)(obuf + (tid + 512 * i) * 16) = st[i]; *(v4u*)(obuf + 16384 + (tid + 512 * i) * 16) = st[2 + i]; }
        asm volatile("s_waitcnt vmcnt(0)" ::: "memory");
        __syncthreads();
        u0 = un0; u1 = un1; gl = gln;
    }
}
constexpr int OQ = 0, OAT = 16384, OZ = 24576, ORED = OZ + 64 * SZ;
struct OutRegs { v4u q0, q1, a0, z0, z1; bf16x8 bS[4], bV[2]; };
__device__ __forceinline__ void out_load(OutRegs& R, int it, const unsigned char* gdnbase, const bf16* proj, int tid) {
    const int lane = tid & 63, wid = tid >> 6; const int n = it & 63, h = (it >> 6) & 3, b = it >> 8;
    const unsigned char* rec = gdnbase + (size_t)it * CHUNK_REC; const size_t tokb = (size_t)b * SEQL + n * 64; const int zr0 = tid >> 4, zs = tid & 15;
    R.q0 = *(const v4u*)(rec + 32768 + (size_t)tid * 16); R.q1 = *(const v4u*)(rec + 32768 + (size_t)(tid + 512) * 16); R.a0 = *(const v4u*)(rec + 49152 + (size_t)tid * 16);
    const bf16* zp = proj + (tokb + zr0) * NINP + C_Z + h * 128 + zs * 8;
    R.z0 = *(const v4u*)zp; R.z1 = *(const v4u*)(zp + (size_t)32 * NINP);
#pragma unroll
    for (int kk = 0; kk < 4; ++kk) R.bS[kk] = *(const bf16x8*)(rec + ((wid * 4 + kk) * 64 + lane) * 16);
#pragma unroll
    for (int kk = 0; kk < 2; ++kk) R.bV[kk] = *(const bf16x8*)(rec + 57344 + ((wid * 2 + kk) * 64 + lane) * 16);
}
__device__ __forceinline__ void out_phase(const unsigned char* gdnbase, const bf16* proj, bf16* concat, const float* normg, int G, unsigned char* lds) {
    const int tid = opaque_tid(), lane = tid & 63, wid = tid >> 6, g = lane >> 4, ln = lane & 15;
    const int zr0 = tid >> 4, zs = tid & 15;
    const float ng = normg[16 * wid + ln];
    if ((int)blockIdx.x >= 2048) return;
    OutRegs R; out_load(R, (int)blockIdx.x, gdnbase, proj, tid);
    for (int it = blockIdx.x; it < 2048; it += G) {
        const int n = it & 63, h = (it >> 6) & 3, b = it >> 8;
        const size_t tokb = (size_t)b * SEQL + n * 64;
        *(v4u*)(lds + OQ + tid * 16) = R.q0; *(v4u*)(lds + OQ + (tid + 512) * 16) = R.q1; *(v4u*)(lds + OAT + tid * 16) = R.a0;
        *(v4u*)(lds + OZ + zr0 * SZ + zs * 16) = R.z0; *(v4u*)(lds + OZ + (zr0 + 32) * SZ + zs * 16) = R.z1;
        bf16x8 bS[4], bV[2];
#pragma unroll
        for (int kk = 0; kk < 4; ++kk) bS[kk] = R.bS[kk];
#pragma unroll
        for (int kk = 0; kk < 2; ++kk) bV[kk] = R.bV[kk];
        __syncthreads();
        out_load(R, (it + G < 2048) ? it + G : it, gdnbase, proj, tid);
        f32x4 O[4];
#pragma unroll
        for (int T = 0; T < 4; ++T) {
            f32x4 a = (f32x4){0.f, 0.f, 0.f, 0.f};
#pragma unroll
            for (int kk = 0; kk < 4; ++kk) a = mfma16(ld16(lds + OQ + ((T * 4 + kk) * 64 + lane) * 16), bS[kk], a);
#pragma unroll
            for (int kk = 0; kk < 2; ++kk) a = mfma16(ld16(lds + OAT + ((T * 2 + kk) * 64 + lane) * 16), bV[kk], a);
            O[T] = a;
        }
        float* red = (float*)(lds + ORED);
#pragma unroll
        for (int T = 0; T < 4; ++T)
#pragma unroll
            for (int j = 0; j < 4; ++j) { const float s = row16_sum(O[T][j] * O[T][j]); if (ln == 0) red[(16 * T + 4 * g + j) * 8 + wid] = s; }
        __syncthreads();
        bf16* zt = (bf16*)(lds + OZ);
#pragma unroll
        for (int T = 0; T < 4; ++T)
#pragma unroll
            for (int j = 0; j < 4; ++j) { const int row = 16 * T + 4 * g + j;
                const f32x4 r0 = *(const f32x4*)(red + row * 8), r1 = *(const f32x4*)(red + row * 8 + 4);
                const float tot = ((r0[0] + r0[1]) + (r0[2] + r0[3])) + ((r1[0] + r1[1]) + (r1[2] + r1[3]));
                const float rstd = rsqrtf(tot * (1.0f / 128.0f) + NORM_EPS);
                bf16* zp = zt + row * (SZ / 2) + 16 * wid + ln;
                const float z = bf2f(*zp);
                const float val = O[T][j] * rstd * ng * z * __builtin_amdgcn_rcpf(1.0f + __expf(-z));
                *zp = (bf16)f2bf(val); }
        __syncthreads();
        {
            const v4u o0 = *(const v4u*)(lds + OZ + zr0 * SZ + zs * 16), o1 = *(const v4u*)(lds + OZ + (zr0 + 32) * SZ + zs * 16);
            bf16* od = concat + (tokb + zr0) * DMODEL + h * 128 + zs * 8;
            *(v4u*)od = o0; *(v4u*)(od + (size_t)32 * DMODEL) = o1;
        }
        __syncthreads();
    }
}
}
#define GAS __attribute__((address_space(1)))
#define LAS __attribute__((address_space(3)))
typedef unsigned short bf16;
typedef unsigned v4u __attribute__((ext_vector_type(4)));
typedef float f32x4 __attribute__((ext_vector_type(4)));
typedef short bf16x8 __attribute__((ext_vector_type(8)));
typedef GAS unsigned gu32;
typedef GAS unsigned long long gu64;
#define RLX_AGENT __ATOMIC_RELAXED, __HIP_MEMORY_SCOPE_AGENT
#define LDS_WAIT() asm volatile("s_waitcnt lgkmcnt(0)" ::: "memory")
#define VM_WAIT() asm volatile("s_waitcnt vmcnt(0)" ::: "memory")
__device__ __forceinline__ unsigned long long rt() { return __builtin_amdgcn_s_memrealtime(); }
#define XB_TMO      128
#define XB_XCNT(j)  (256  + 64 * (j))
#define XB_XSUB(j)  (1280 + 64 * (j))
#define XB_XGEN(j)  (2304 + 64 * (j))
#define XB_TOP      3328
#define XB_TOPGEN   3392
#define XCD_BAR_WORDS 3456
#define XB_SPIN_CAP (1u << 18)

__device__ __forceinline__ unsigned xb_ld(unsigned* p)              { return __hip_atomic_load(p, __ATOMIC_RELAXED, __HIP_MEMORY_SCOPE_AGENT); }
__device__ __forceinline__ unsigned xb_add(unsigned* p, unsigned v) { return __hip_atomic_fetch_add(p, v, __ATOMIC_RELAXED, __HIP_MEMORY_SCOPE_AGENT); }
__device__ __forceinline__ unsigned xb_xcc_id() { return (unsigned)__builtin_amdgcn_s_getreg((3 << 11) | 20) & 0xFu; }
#define XB_SPIN(cond, bar) do { unsigned _sp = 0; while (cond) { __builtin_amdgcn_s_sleep(1); \
    if ((++_sp & 255u) == 0u) { if (xb_ld(&(bar)[XB_TMO])) break; if (_sp > XB_SPIN_CAP) { atomicAdd(&(bar)[XB_TMO], 1u); break; } } } } while (0)

struct XcdBarrier {
    unsigned* bar; unsigned x;
    volatile LAS unsigned* st;
};

__device__ __forceinline__ XcdBarrier xcd_barrier_post(unsigned* bar, volatile LAS unsigned* st) {
    XcdBarrier b; b.bar = bar; b.x = xb_xcc_id(); b.st = st;
    if (threadIdx.x == 0) (void)xb_add(&bar[XB_XCNT(b.x)], 1u);
    return b;
}
__device__ __forceinline__ void xcd_barrier_complete(unsigned* bar, unsigned x, unsigned& nloc, unsigned& nx) {
    const unsigned G = gridDim.x * gridDim.y * gridDim.z;
    unsigned sum, cnt, mine, sp = 0u;
    for (;;) {
        sum = 0u; cnt = 0u; mine = 0u;
#pragma unroll
        for (unsigned j = 0; j < 16; ++j) { const unsigned c = xb_ld(&bar[XB_XCNT(j)]); sum += c; cnt += (c > 0u) ? 1u : 0u; mine = (j == x) ? c : mine; }
        if (sum == G) break;
        __builtin_amdgcn_s_sleep(1);
        if ((++sp & 255u) == 0u) { if (xb_ld(&bar[XB_TMO])) break; if (sp > XB_SPIN_CAP) { atomicAdd(&bar[XB_TMO], 1u); break; } }
    }
    nloc = mine > 0u ? mine : 1u; nx = cnt > 0u ? cnt : 1u;
}

__device__ __forceinline__ void xcd_barrier(const XcdBarrier& b) {
    asm volatile("s_waitcnt vmcnt(0)" ::: "memory");
    __syncthreads();
    if (threadIdx.x == 0) {
        unsigned* bar = b.bar;
        __builtin_amdgcn_s_waitcnt(0);
        unsigned nloc = b.st[0], nx = b.st[1];
        if (nloc == 0u) { xcd_barrier_complete(bar, b.x, nloc, nx); b.st[0] = nloc; b.st[1] = nx; }
        const unsigned old = xb_add(&bar[XB_XSUB(b.x)], 1u);
        const unsigned gen = old / nloc;
        if (old + 1u == (gen + 1u) * nloc) {
            __builtin_amdgcn_fence(__ATOMIC_RELEASE, "agent");
            asm volatile("s_waitcnt vmcnt(0)" ::: "memory");
            const unsigned og = xb_add(&bar[XB_TOP], 1u);
            const unsigned tg = og / nx;
            if (og + 1u == (tg + 1u) * nx) xb_add(&bar[XB_TOPGEN], 1u);
            else XB_SPIN(xb_ld(&bar[XB_TOPGEN]) == tg, bar);
            __builtin_amdgcn_fence(__ATOMIC_ACQUIRE, "agent");
            xb_add(&bar[XB_XGEN(b.x)], 1u);
            asm volatile("s_waitcnt vmcnt(0)" ::: "memory");
        } else {
            XB_SPIN(xb_ld(&bar[XB_XGEN(b.x)]) == gen, bar);
            __builtin_amdgcn_fence(__ATOMIC_ACQUIRE, "agent");
            asm volatile("s_waitcnt vmcnt(0)" ::: "memory");
        }
    }
    __syncthreads();
}

constexpr int CW_BAR = 4096, BAR_LDS_OFF = LDS_BYTES - 64;
struct Args { Ptrs p; int pad0, pad1; };
#define LP() (&args.p)
#define WSP(off) (LP()->ws + (off))
#define GSYNC() xcd_barrier(bar)
template <int l> __device__ __forceinline__ void layer_body(const Args& args, const XcdBarrier& bar, unsigned char* lds, PG8_LAS unsigned char* ldsl, const int G) {
        { pg8::Gemm gm{(const bf16*)WSP(WS_XBF), (const bf16*)(WSP(WS_W) + (size_t)l * W_LAYER + W_IN), MTOK, 3584, DMODEL}; pg8::StaticOrder S; S.init(MTOK, 3584, G, (int)blockIdx.x);
          pg8::EpiBf16 E{(bf16*)WSP(WS_PROJ), NINP};
          pg8::gemm_phase<pg8::EpiBf16, pg8::StaticOrder, true, true>(ldsl, gm, S, E);
          if (PROBE_MASK & 1) { __syncthreads(); pg8::gemm_phase<pg8::EpiBf16, pg8::StaticOrder, true, true>(ldsl, gm, S, E); } }
        for (int grp = blockIdx.x; grp < MTOK / 128; grp += G) logits_group(grp, (const bf16*)WSP(WS_XBF), (const bf16*)(WSP(WS_W) + (size_t)l * W_LAYER + W_IN), (bf16*)WSP(WS_PROJ));
        GSYNC();
        if (blockIdx.x == 0 && threadIdx.x == 0) { ((unsigned*)WSP(WS_CTL))[64 + l] = 0u; ((unsigned*)WSP(WS_CTL))[80 + l] = 0u; }
        for (int rep_ = 0; rep_ < ((PROBE_MASK & 2) ? 2 : 1); ++rep_)
        if ((int)blockIdx.x < 2048) {
            const Ptrs* pp = LP(); const bf16* projc = (const bf16*)(pp->ws + WS_PROJ);
            const int tid_ = opaque_tid(); const int h0 = ((int)blockIdx.x >> 6) & 3;
            float wreg[3];
#pragma unroll
            for (int k = 0; k < 3; ++k) { const int idx = tid_ + 512 * k, sec = idx >> 9, off = (idx >> 7) & 3, ch = idx & 127; wreg[k] = pp->conv_w[(size_t)l * 4 * 1536 + off * 1536 + sec * 512 + h0 * 128 + ch]; }
            v4u X[3][4][2]; float alr, blr;
            gdn::prep_load(X, alr, blr, projc, (int)blockIdx.x, tid_);
            for (int it = blockIdx.x; it < 2048; it += G) {
                const int n = it & 63, h = (it >> 6) & 3, b = it >> 8;
                const int nit = (it + G < 2048) ? it + G : it;
                gdn::prep_item(X, alr, blr, nit, wreg, projc, pp->ws + WS_GDN + (size_t)it * CHUNK_REC, (float*)(pp->ws + WS_GLAST) + it, pp->a_log[l * 4 + h], pp->dt_bias[l * 4 + h], b, h, n, lds);
            }
        }
        for (int it = blockIdx.x; it < 1024; it += G) moba_prep_item((bf16*)WSP(WS_PROJ), (float*)WSP(WS_KMEAN), (const float*)WSP(WS_ROPE), it, lds);
        GSYNC();
        for (int rep_ = 0; rep_ < ((PROBE_MASK & (4 | 64 | 128)) ? 2 : 1); ++rep_) {
        if (blockIdx.x < 32 && (rep_ == 0 || (PROBE_MASK & (4 | 64)))) { const Ptrs* pp = LP(); gdn::scan_bh((int)blockIdx.x, pp->ws + WS_GDN, (const float*)(pp->ws + WS_GLAST), lds); }
        {
            volatile unsigned* sh_u = (volatile unsigned*)(lds + 90112);
            if (rep_ == 0 || (PROBE_MASK & (4 | 128))) for (;;) {
                __syncthreads();
                if (threadIdx.x == 0) *sh_u = atomicAdd((unsigned*)WSP(WS_CTL) + 64 + 16 * rep_ + l, 1u);
                __syncthreads();
                const unsigned u = (unsigned)__builtin_amdgcn_readfirstlane((int)*sh_u);
                if (u >= 1024u) break;
                const int qb = 15 - (int)(u >> 6), bh = (int)(u & 63u), b = bh >> 3, h = bh & 7;
                const bf16* proj = (const bf16*)WSP(WS_PROJ);
                moba_select(b, h, qb, proj, (const bf16*)WSP(WS_KMEAN) + (size_t)bh * 16 * 64, lds);
                if (PROBE_MASK & 4096) { __syncthreads(); moba_select(b, h, qb, proj, (const bf16*)WSP(WS_KMEAN) + (size_t)bh * 16 * 64, lds); }
                __syncthreads();
                attn_body::attn_unit<8>(b, h, qb, (const attn_body::bf16*)(proj + C_QB), (const attn_body::bf16*)(proj + C_KB), (const attn_body::bf16*)(proj + C_VB),
                                        (attn_body::bf16*)((bf16*)WSP(WS_XBF) + 512), (char*)lds);
            }
        }
        }
        GSYNC();
        for (int rep_ = 0; rep_ < ((PROBE_MASK & 512) ? 2 : 1); ++rep_)
        { const Ptrs* pp = LP(); gdn::out_phase(pp->ws + WS_GDN, (const bf16*)(pp->ws + WS_PROJ), (bf16*)(pp->ws + WS_XBF), pp->norm_g + l * 128, G, lds); }
        GSYNC();
        { const Ptrs* pp = LP();
          pg8::Gemm gm{(const bf16*)(pp->ws + WS_XBF), (const bf16*)(pp->ws + WS_W + (size_t)l * W_LAYER + W_OUT), MTOK, DMODEL, DMODEL}; pg8::StaticOrder S; S.init(MTOK, DMODEL, G, (int)blockIdx.x);
          typedef pg8::EpiResBf<(l > 0)> EpiD;
          EpiD E{pp->x, (const bf16*)pp->out, (bf16*)(pp->ws + WS_YX), (const float*)(pp->ws + WS_STAT), pp->ln2_g + (l > 0 ? l - 1 : 0) * DMODEL, pp->ln2_b + (l > 0 ? l - 1 : 0) * DMODEL};
          pg8::gemm_phase<EpiD, pg8::StaticOrder, true, true>(ldsl, gm, S, E);
          if (PROBE_MASK & 16) { __syncthreads(); pg8::gemm_phase<EpiD, pg8::StaticOrder, true, true>(ldsl, gm, S, E); } }
        GSYNC();
        { const Ptrs* pp = LP(); ln_phase((const bf16*)(pp->ws + WS_YX), nullptr, (bf16*)(pp->ws + WS_XBF), (float*)(pp->ws + WS_STAT), pp->ln1_g + l * DMODEL, pp->ln1_b + l * DMODEL, G); }
        GSYNC();
        { const Ptrs* pp = LP();
          pg8::Gemm gm{(const bf16*)(pp->ws + WS_XBF), (const bf16*)(pp->ws + WS_W + (size_t)l * W_LAYER + W_UP), MTOK, NUP, DMODEL}; pg8::StaticOrder S; S.init(MTOK, NUP, G, (int)blockIdx.x);
          pg8::EpiUpConv E{(bf16*)(pp->ws + WS_ACT), (float*)(pp->ws + WS_EDGE), pp->fconv_w + (size_t)l * 3 * NUP, pp->fconv_b + (size_t)l * NUP};
          pg8::gemm_phase<pg8::EpiUpConv, pg8::StaticOrder, true, true>(ldsl, gm, S, E);
          if (PROBE_MASK & 8) { __syncthreads(); pg8::gemm_phase<pg8::EpiUpConv, pg8::StaticOrder, true, true>(ldsl, gm, S, E); } }
        GSYNC();
        { const Ptrs* pp = LP(); fix_phase((const float*)(pp->ws + WS_EDGE), (bf16*)(pp->ws + WS_ACT), pp->fconv_w + (size_t)l * 3 * NUP, pp->fconv_b + (size_t)l * NUP, G); }
        GSYNC();
        { const Ptrs* pp = LP();
          pg8::Gemm gm{(const bf16*)(pp->ws + WS_ACT), (const bf16*)(pp->ws + WS_W + (size_t)l * W_LAYER + W_DOWN), MTOK, DMODEL, DFF}; pg8::StaticOrder S; S.init(MTOK, DMODEL, G, (int)blockIdx.x);
          pg8::EpiResBf<true> E{nullptr, (const bf16*)(pp->ws + WS_YX), (l + 1 < NLAYER) ? (bf16*)pp->out : (bf16*)(pp->ws + WS_YX), (const float*)(pp->ws + WS_STAT), pp->ln1_g + l * DMODEL, pp->ln1_b + l * DMODEL};
          pg8::gemm_phase<pg8::EpiResBf<true>, pg8::StaticOrder, true, true>(ldsl, gm, S, E); }
        GSYNC();
        { const Ptrs* pp = LP();
          if (l + 1 < NLAYER) ln_phase((const bf16*)pp->out, nullptr, (bf16*)(pp->ws + WS_XBF), (float*)(pp->ws + WS_STAT), pp->ln2_g + l * DMODEL, pp->ln2_b + l * DMODEL, G);
          else ln_phase((const bf16*)(pp->ws + WS_YX), pp->out, nullptr, nullptr, pp->ln2_g + l * DMODEL, pp->ln2_b + l * DMODEL, G); }
        if (PROBE_MASK & 256) { for (int q_ = 0; q_ < 8; ++q_) GSYNC(); }
        if (l + 1 < NLAYER) GSYNC();
}
__global__ void __launch_bounds__(NTHREADS, 2) hybrid_fwd(Args args) {
    extern __shared__ __attribute__((aligned(16))) unsigned char lds[];
    cg::grid_group grid = cg::this_grid();
    const int G = gridDim.x;
    PG8_LAS unsigned char* ldsl = (PG8_LAS unsigned char*)lds;

    if (threadIdx.x < 16) ((volatile LAS unsigned*)(ldsl + BAR_LDS_OFF))[threadIdx.x] = 0u;
    __syncthreads();
    const XcdBarrier bar = xcd_barrier_post((unsigned*)WSP(WS_CTL) + CW_BAR, (volatile LAS unsigned*)(ldsl + BAR_LDS_OFF));
    { const Ptrs P = *LP(); p0_prologue(P, lds, G); }
    if (args.pad0 != 0) grid.sync();
    xcd_barrier(bar);

    layer_body<0>(args, bar, lds, ldsl, G);
    layer_body<1>(args, bar, lds, ldsl, G);
}

extern "C" void kernel_launch(void* const* d_in, const int* in_sizes, int n_in, void* d_out, int out_size, void* d_ws, size_t ws_size, hipStream_t stream) {
    static int grid = 0;
    if (grid == 0) {
        if (n_in != 15 || ws_size < WS_END) { fprintf(stderr, "kernel_launch: unexpected inputs (n_in %d, ws %zu)\n", n_in, ws_size); grid = -1; return; }
        int dev = 0, cus = 0, per_cu = 0;
        hipGetDevice(&dev); hipDeviceGetAttribute(&cus, hipDeviceAttributeMultiprocessorCount, dev);
        if (hipFuncSetAttribute((const void*)hybrid_fwd, hipFuncAttributeMaxDynamicSharedMemorySize, LDS_BYTES) != hipSuccess) { fprintf(stderr, "kernel_launch: hipFuncSetAttribute failed\n"); grid = -1; return; }
        if (hipOccupancyMaxActiveBlocksPerMultiprocessor(&per_cu, (const void*)hybrid_fwd, NTHREADS, LDS_BYTES) != hipSuccess || per_cu < 1) { fprintf(stderr, "kernel_launch: occupancy query says %d\n", per_cu); per_cu = 1; }
        (void)hipGetLastError();
        grid = 256;
    }
    if (grid < 0) return;
    if (hipMemsetAsync(d_ws, 0, 65536, stream) != hipSuccess) { fprintf(stderr, "kernel_launch: hipMemsetAsync failed\n"); return; }
    Args a{};
    const float* const* in = (const float* const*)d_in;
    a.p.x = in[0]; a.p.w_in = in[1]; a.p.conv_w = in[2]; a.p.a_log = in[3]; a.p.dt_bias = in[4]; a.p.norm_g = in[5]; a.p.w_out = in[6];
    a.p.ln1_g = in[7]; a.p.ln1_b = in[8]; a.p.w_up = in[9]; a.p.fconv_w = in[10]; a.p.fconv_b = in[11]; a.p.w_down = in[12]; a.p.ln2_g = in[13]; a.p.ln2_b = in[14];
    a.p.out = (float*)d_out; a.p.ws = (unsigned char*)d_ws;
    void* kargs[] = {&a};
    hipError_t e = hipLaunchCooperativeKernel((const void*)hybrid_fwd, dim3(grid), dim3(NTHREADS), kargs, LDS_BYTES, stream);
    if (e != hipSuccess) fprintf(stderr, "kernel_launch: cooperative launch failed: %s (grid %d)\n", hipGetErrorString(e), grid);
}
```

```cpp
#include <hip/hip_runtime.h>
#include <hip/hip_cooperative_groups.h>
#include <hip/hip_bf16.h>
#include <cstdio>
#include <cstdint>
#include <cmath>
namespace cg = cooperative_groups;
#ifndef PROBE_MASK
#define PROBE_MASK 0
#endif
__device__ __forceinline__ int opaque_tid() { int t = threadIdx.x; asm volatile("" : "+v"(t)); return t; }
namespace pg8 {
#define PG8_LAS __attribute__((address_space(3)))
typedef unsigned short bf16_t;
typedef short bf16x8 __attribute__((ext_vector_type(8)));
typedef float f32x4 __attribute__((ext_vector_type(4)));
typedef unsigned u32x4 __attribute__((ext_vector_type(4)));
constexpr int BM = 256, BK = 64, HALF = 128, HTB = HALF * BK * 2  , STAGE_BYTES = 8 * HTB, NXCD = 8, WGM = 8;

__host__ __device__ __forceinline__ int lds_byte(int r, int c) { const int st = (r >> 4) * 2 + (c >> 5), rr = r & 15, cc = c & 31, ob = rr * 64 + cc * 2; return st * 1024 + (ob ^ (((ob >> 9) & 1) << 5)); }
__host__ __device__ __forceinline__ void stage_rc(int b, int& R, int& C) { const int st = b / 1024, sb = b % 1024, swz = sb ^ (((sb >> 9) & 1) << 5); R = (st >> 1) * 16 + swz / 64; C = (st & 1) * 32 + (swz % 64) / 2; }
__host__ __device__ __forceinline__ int perm32(int rho) { const int n = rho >> 4, i = rho & 15; return 8 * (i >> 2) + 4 * n + (i & 3); }

struct Unit { int pm, pn; };
struct Gemm { const bf16_t* A; const bf16_t* Bt; int M, N, K; };

struct StaticOrder {
    int nM, nN, nwg, G, c;
    __host__ __device__ void init(int M, int N, int G_, int c_) { nM = M / BM; nN = N / BM; nwg = nM * nN; G = G_; c = c_; }
    __host__ __device__ bool next(int i, Unit& u) const {
        const long L = (long)i * G + c; if (L >= nwg) return false;
        int wgid = (int)L; { const int q = nwg / NXCD, r = nwg % NXCD, xcd = wgid % NXCD, off = wgid / NXCD; wgid = (xcd < r ? xcd * (q + 1) : r * (q + 1) + (xcd - r) * q) + off; }
        const int nig = WGM * nN, gid = wgid / nig, fm = gid * WGM, gsz = (nM - fm) < WGM ? (nM - fm) : WGM;
        u.pm = fm + ((wgid % nig) % gsz); u.pn = (wgid % nig) / gsz; return true;
    }
    __device__ __forceinline__ void a_ready(const Unit&) const {}
    __device__ __forceinline__ void done(const Unit&) const {}
};

__device__ __forceinline__ unsigned cvt_pk_bf16(float lo, float hi) { unsigned r; asm volatile("v_cvt_pk_bf16_f32 %0, %1, %2" : "=v"(r) : "v"(lo), "v"(hi)); return r; }
typedef float f32x2 __attribute__((ext_vector_type(2)));
typedef unsigned u32x2 __attribute__((ext_vector_type(2)));
struct EpiBf16 {
    static constexpr bool PERM = true, AFTER_DRAIN = false, PERMA = false;
    bf16_t* O; int ldc;
    __device__ __forceinline__ void operator()(const f32x4 (&acc)[2][2][4][2], const Unit& u, int wr, int wc, int fr, int fq) const {
        const int row0 = u.pm * BM + wr * 64 + fr; const int col0 = u.pn * BM + wc * 32 + 8 * fq;
#pragma unroll
        for (int ai = 0; ai < 2; ++ai)
#pragma unroll
            for (int m = 0; m < 4; ++m) { bf16_t* rowp = O + (size_t)(row0 + ai * HALF + m * 16) * ldc + col0;
#pragma unroll
                for (int bj = 0; bj < 2; ++bj) { const f32x4 v0 = acc[ai][bj][m][0], v1 = acc[ai][bj][m][1];
                    u32x4 w; w.x = cvt_pk_bf16(v0[0], v0[1]); w.y = cvt_pk_bf16(v0[2], v0[3]); w.z = cvt_pk_bf16(v1[0], v1[1]); w.w = cvt_pk_bf16(v1[2], v1[3]);
                    *(u32x4*)(rowp + bj * HALF) = w; } }
    }
};
template <bool REBUILD> struct EpiResBf {
    static constexpr bool PERM = true, AFTER_DRAIN = false, PERMA = false;
    const float* resf; const bf16_t* resb; bf16_t* out; const float* stat_; const float* g_; const float* b_;
    static constexpr int ldc = 1024; static constexpr float alpha = 1.4142135623730951f;
    __device__ __forceinline__ void operator()(const f32x4 (&acc)[2][2][4][2], const Unit& u, int wr, int wc, int fr, int fq) const {
        const float* stat = stat_; const float* g = g_; const float* b = b_; asm volatile("" : "+s"(stat), "+s"(g), "+s"(b));
        const int row0 = u.pm * BM + wr * 64 + fr; const int col0 = u.pn * BM + wc * 32 + 8 * fq;
#pragma unroll
        for (int bj = 0; bj < 2; ++bj) {
            const int col = col0 + bj * HALF;
            if (REBUILD) {
                const f32x4 g0 = *(const f32x4*)(g + col) * alpha, g1 = *(const f32x4*)(g + col + 4) * alpha, b0 = *(const f32x4*)(b + col) * alpha, b1 = *(const f32x4*)(b + col + 4) * alpha;
#pragma unroll
                for (int ai = 0; ai < 2; ++ai) {
                u32x4 rb[4]; f32x2 ms[4];
#pragma unroll
                for (int q = 0; q < 4; ++q) { const int row = row0 + ai * HALF + q * 16; rb[q] = *(const u32x4*)(resb + (size_t)row * ldc + col); ms[q] = *(const f32x2*)(stat + 2 * (size_t)row); }
#pragma unroll
                for (int q = 0; q < 4; ++q) { const int m = q; const int row = row0 + ai * HALF + m * 16;
                    f32x4 r0, r1; r0[0] = __uint_as_float(rb[q].x << 16); r0[1] = __uint_as_float(rb[q].x & 0xffff0000u); r0[2] = __uint_as_float(rb[q].y << 16); r0[3] = __uint_as_float(rb[q].y & 0xffff0000u);
                    r1[0] = __uint_as_float(rb[q].z << 16); r1[1] = __uint_as_float(rb[q].z & 0xffff0000u); r1[2] = __uint_as_float(rb[q].w << 16); r1[3] = __uint_as_float(rb[q].w & 0xffff0000u);
                    const f32x4 v0 = (r0 - ms[q].x) * ms[q].y * g0 + b0 + acc[ai][bj][m][0], v1 = (r1 - ms[q].x) * ms[q].y * g1 + b1 + acc[ai][bj][m][1];
                    u32x4 w; w.x = cvt_pk_bf16(v0[0], v0[1]); w.y = cvt_pk_bf16(v0[2], v0[3]); w.z = cvt_pk_bf16(v1[0], v1[1]); w.w = cvt_pk_bf16(v1[2], v1[3]);
                    *(u32x4*)(out + (size_t)row * ldc + col) = w; }
                }
            } else {
#pragma unroll
                for (int ai = 0; ai < 2; ++ai) {
                    f32x4 ra[4], rc[4];
#pragma unroll
                    for (int m = 0; m < 4; ++m) { const size_t off = (size_t)(row0 + ai * HALF + m * 16) * ldc + col; ra[m] = *(const f32x4*)(resf + off); rc[m] = *(const f32x4*)(resf + off + 4); }
#pragma unroll
                    for (int m = 0; m < 4; ++m) { const size_t off = (size_t)(row0 + ai * HALF + m * 16) * ldc + col;
                        const f32x4 v0 = ra[m] * alpha + acc[ai][bj][m][0], v1 = rc[m] * alpha + acc[ai][bj][m][1];
                        u32x4 w; w.x = cvt_pk_bf16(v0[0], v0[1]); w.y = cvt_pk_bf16(v0[2], v0[3]); w.z = cvt_pk_bf16(v1[0], v1[1]); w.w = cvt_pk_bf16(v1[2], v1[3]);
                        *(u32x4*)(out + off) = w; }
                }
            }
        }
    }
};
__device__ __forceinline__ float dpp_ror1(float v) { return __builtin_bit_cast(float, __builtin_amdgcn_update_dpp(0, __builtin_bit_cast(int, v), 0x121, 0xf, 0xf, false)); }
__device__ __forceinline__ float dpp_ror2(float v) { return __builtin_bit_cast(float, __builtin_amdgcn_update_dpp(0, __builtin_bit_cast(int, v), 0x122, 0xf, 0xf, false)); }
__device__ __forceinline__ float silu_f(float x) { return x * __builtin_amdgcn_rcpf(1.0f + __expf(-x)); }
__device__ __forceinline__ float dpp_shr1(float v) { return __builtin_bit_cast(float, __builtin_amdgcn_update_dpp(0, __builtin_bit_cast(int, v), 0x111, 0xf, 0xf, true)); }
struct EpiUpConv {
    static constexpr bool PERM = true, AFTER_DRAIN = false, PERMA = true;
    bf16_t* act; float* edge; const float* cw; const float* cb;
    __device__ __forceinline__ void operator()(const f32x4 (&acc)[2][2][4][2], const Unit& u, int wr, int wc, int fr, int fq) const {
        const int ch0 = u.pn * 128 + wc * 32 + 8 * fq;
        f32x4 w0[2][2], w1[2][2], w2[2][2], bb[2][2];
#pragma unroll
        for (int n = 0; n < 2; ++n)
#pragma unroll
            for (int bj = 0; bj < 2; ++bj) { const int col = bj * 2816 + ch0 + 4 * n;
                w0[n][bj] = *(const f32x4*)(cw + col); w1[n][bj] = *(const f32x4*)(cw + 5632 + col); w2[n][bj] = *(const f32x4*)(cw + 2 * 5632 + col); bb[n][bj] = *(const f32x4*)(cb + col); }
#pragma unroll
        for (int ai = 0; ai < 2; ++ai) {
            const int slab = u.pm * 4 + ai * 2 + wr;
            u32x2 pk[2][4];
#pragma unroll
            for (int n = 0; n < 2; ++n) {
                const int ch = ch0 + 4 * n;
                f32x4 hv[2][4];
#pragma unroll
                for (int bj = 0; bj < 2; ++bj) {
                    const int col = bj * 2816 + ch;
                    const f32x4 c0 = acc[ai][bj][0][n], c1 = acc[ai][bj][1][n], c2 = acc[ai][bj][2][n], c3 = acc[ai][bj][3][n];
                    f32x4 s2, s3;
#pragma unroll
                    for (int e = 0; e < 4; ++e) { s2[e] = dpp_shr1(c2[e]); s3[e] = dpp_shr1(c3[e]); }
                    hv[bj][0] = w2[n][bj] * c0 + w1[n][bj] * s3 + w0[n][bj] * s2 + bb[n][bj];
                    hv[bj][1] = w2[n][bj] * c1 + w1[n][bj] * c0 + w0[n][bj] * s3 + bb[n][bj];
                    hv[bj][2] = w2[n][bj] * c2 + w1[n][bj] * c1 + w0[n][bj] * c0 + bb[n][bj];
                    hv[bj][3] = w2[n][bj] * c3 + w1[n][bj] * c2 + w0[n][bj] * c1 + bb[n][bj];
                    if (fr == 0 || fr == 15) { const bool lo = (fr == 0); float* ep = edge + ((size_t)slab * 4 + (lo ? 0 : 2)) * 5632 + col;
                        *(f32x4*)ep = lo ? c0 : c2; *(f32x4*)(ep + 5632) = lo ? c1 : c3; }
                }
#pragma unroll
                for (int m = 0; m < 4; ++m) { pk[n][m].x = cvt_pk_bf16(silu_f(hv[0][m][0]) * hv[1][m][0], silu_f(hv[0][m][1]) * hv[1][m][1]); pk[n][m].y = cvt_pk_bf16(silu_f(hv[0][m][2]) * hv[1][m][2], silu_f(hv[0][m][3]) * hv[1][m][3]); }
            }
            const size_t row0 = (size_t)u.pm * BM + ai * HALF + wr * 64 + 4 * fr;
#pragma unroll
            for (int m = 0; m < 4; ++m) {
                if (!(m < 2 && fr == 0)) { u32x4 o; o.x = pk[0][m].x; o.y = pk[0][m].y; o.z = pk[1][m].x; o.w = pk[1][m].y; *(u32x4*)(act + (row0 + m) * 2816 + ch0) = o; }
            }
        }
    }
};
template <class Epi, class Sched, bool ALIGN_EPI = false, bool SP2 = false>
__device__ __forceinline__ void gemm_phase(PG8_LAS unsigned char* lds, const Gemm g, const Sched& S, const Epi& E) {
    const int tid = opaque_tid(), wid = __builtin_amdgcn_readfirstlane(tid >> 6), lane = tid & 63, wr = wid >> 2, wc = wid & 3, fr = lane & 15, fq = lane >> 4;
    const int K = g.K, nt = K / BK;
    unsigned voffA[2], voffB[2];
#pragma unroll
    for (int i = 0; i < 2; ++i) { int R, C; stage_rc(tid * 16 + i * 8192, R, C); const int Rb = Epi::PERM ? ((R & ~31) + perm32(R & 31)) : R;
        const int Ra = Epi::PERMA ? ((R & ~63) + 4 * (R & 15) + ((R >> 4) & 3)) : R;
        voffA[i] = (unsigned)(Ra * K + C) * 2u; voffB[i] = (unsigned)(Rb * K + C) * 2u; }
    const size_t kstep = (size_t)(BK * 2);
    const size_t hstep = (size_t)HALF * K * 2;
    const size_t tstep = 2 * hstep;
    const unsigned ldsw = (unsigned)wid * 1024u;
    const int aoff = lds_byte(wr * 64 + fr, fq * 8), boff = lds_byte(wc * 32 + fr, fq * 8);
#define PG8_SA(b, h) (((b) * 2 + (h)) * HTB)
#define PG8_SB(b, h) ((4 + (b) * 2 + (h)) * HTB)
#define PG8_STAGE(bufoff, gbase, voff) do { _Pragma("unroll") for (int _i = 0; _i < 2; ++_i) \
        __builtin_amdgcn_global_load_lds((const unsigned*)((const char*)(gbase) + (voff)[_i]), (PG8_LAS unsigned*)(lds + (bufoff) + ldsw + _i * 8192), 16, 0, 0); } while (0)
#define PG8_LDA(dst, b, h) do { _Pragma("unroll") for (int m = 0; m < 4; ++m) _Pragma("unroll") for (int k = 0; k < 2; ++k) dst[m][k] = *(const PG8_LAS bf16x8*)(lds + PG8_SA(b, h) + aoff + m * 2048 + k * 1024); } while (0)
#define PG8_LDB(dst, b, h) do { _Pragma("unroll") for (int n = 0; n < 2; ++n) _Pragma("unroll") for (int k = 0; k < 2; ++k) dst[n][k] = *(const PG8_LAS bf16x8*)(lds + PG8_SB(b, h) + boff + n * 2048 + k * 1024); } while (0)
#define PG8_MMA(ai, bj, At, Bt) do { __builtin_amdgcn_s_setprio(1); _Pragma("unroll") for (int m = 0; m < 4; ++m) _Pragma("unroll") for (int n = 0; n < 2; ++n) _Pragma("unroll") for (int k = 0; k < 2; ++k) \
        acc[ai][bj][m][n] = __builtin_amdgcn_mfma_f32_16x16x32_bf16(Bt[n][k], At[m][k], acc[ai][bj][m][n], 0, 0, 0); __builtin_amdgcn_s_setprio(0); } while (0)
#define PG8_WAIT_V(n) asm volatile("s_waitcnt vmcnt(" #n ")" ::: "memory")
#define PG8_WAIT_L(n) asm volatile("s_waitcnt lgkmcnt(" #n ")" ::: "memory")
#define PG8_BAR __builtin_amdgcn_s_barrier()
#define PG8_SCHED __builtin_amdgcn_sched_barrier(0)
    Unit cur, nxt; int ui = 0;
    if (!S.next(0, cur)) return;
    f32x4 acc[2][2][4][2];
#pragma unroll
    for (int a = 0; a < 2; ++a)
#pragma unroll
        for (int b = 0; b < 2; ++b)
#pragma unroll
            for (int m = 0; m < 4; ++m)
#pragma unroll
                for (int n = 0; n < 2; ++n) acc[a][b][m][n] = (f32x4){0.f, 0.f, 0.f, 0.f};
    bf16x8 At[4][2], B0[2][2], B1[2][2];
    const char* cA = (const char*)g.A + (size_t)cur.pm * tstep; const char* cB = (const char*)g.Bt + (size_t)cur.pn * tstep;
    S.a_ready(cur);
    if constexpr (SP2) {
        PG8_STAGE(PG8_SB(0, 0), cB, voffB); PG8_STAGE(PG8_SB(0, 1), cB + hstep, voffB); PG8_STAGE(PG8_SA(0, 0), cA, voffA); PG8_STAGE(PG8_SA(0, 1), cA + hstep, voffA);
        if (wr == 1) PG8_BAR;
        PG8_WAIT_V(2); PG8_BAR;
        PG8_STAGE(PG8_SB(1, 0), cB + kstep, voffB); PG8_STAGE(PG8_SA(1, 0), cA + kstep, voffA); PG8_STAGE(PG8_SB(1, 1), cB + hstep + kstep, voffB);
        PG8_WAIT_V(6); PG8_BAR;
    } else {
        PG8_STAGE(PG8_SB(0, 0), cB, voffB); PG8_STAGE(PG8_SA(0, 0), cA, voffA); PG8_STAGE(PG8_SB(0, 1), cB + hstep, voffB); PG8_STAGE(PG8_SA(0, 1), cA + hstep, voffA);
        if (wr == 1) PG8_BAR;
        PG8_WAIT_V(4); PG8_BAR;
        PG8_STAGE(PG8_SB(1, 0), cB + kstep, voffB); PG8_STAGE(PG8_SA(1, 0), cA + kstep, voffA); PG8_STAGE(PG8_SB(1, 1), cB + hstep + kstep, voffB);
        PG8_WAIT_V(6); PG8_BAR;
    }
    for (;;) {
        const bool has_next = S.next(ui + 1, nxt);
        const char* nA = has_next ? (const char*)g.A + (size_t)nxt.pm * tstep : cA; const char* nB = has_next ? (const char*)g.Bt + (size_t)nxt.pn * tstep : cB;
        for (int t = 0; t < nt; t += 2) {
            const bool last = (t == nt - 2);
            const char* a1 = cA + (size_t)(t + 1) * kstep;
            const char* a2 = last ? nA : cA + (size_t)(t + 2) * kstep; const char* b2 = last ? nB : cB + (size_t)(t + 2) * kstep;
            const char* a3 = a2 + kstep; const char* b3 = b2 + kstep;
            if (last && has_next) S.a_ready(nxt);
            if constexpr (SP2) {
            PG8_LDB(B0, 0, 0); PG8_LDB(B1, 0, 1); PG8_SCHED; PG8_LDA(At, 0, 0); PG8_STAGE(PG8_SA(1, 1), a1 + hstep, voffA);
            PG8_WAIT_V(8); PG8_WAIT_L(0); PG8_BAR; PG8_MMA(0, 0, At, B0); PG8_MMA(0, 1, At, B1); PG8_BAR; PG8_SCHED;
            PG8_LDA(At, 0, 1); PG8_STAGE(PG8_SB(0, 0), b2, voffB); PG8_STAGE(PG8_SB(0, 1), b2 + hstep, voffB); PG8_STAGE(PG8_SA(0, 0), a2, voffA);
            PG8_WAIT_V(8); PG8_WAIT_L(0); PG8_BAR; PG8_MMA(1, 0, At, B0); PG8_MMA(1, 1, At, B1); PG8_BAR; PG8_SCHED;
            PG8_LDB(B0, 1, 0); PG8_LDB(B1, 1, 1); PG8_SCHED; PG8_LDA(At, 1, 0); PG8_STAGE(PG8_SA(0, 1), a2 + hstep, voffA);
            PG8_WAIT_V(8); PG8_WAIT_L(0); PG8_BAR; PG8_MMA(0, 0, At, B0); PG8_MMA(0, 1, At, B1); PG8_BAR; PG8_SCHED;
            PG8_LDA(At, 1, 1); PG8_STAGE(PG8_SB(1, 0), b3, voffB); PG8_STAGE(PG8_SB(1, 1), b3 + hstep, voffB); PG8_STAGE(PG8_SA(1, 0), a3, voffA);
            PG8_WAIT_V(8); PG8_WAIT_L(0); PG8_BAR; PG8_MMA(1, 0, At, B0); PG8_MMA(1, 1, At, B1); PG8_BAR; PG8_SCHED;
            } else {
            PG8_LDB(B0, 0, 0); PG8_SCHED; PG8_LDA(At, 0, 0); PG8_STAGE(PG8_SA(1, 1), a1 + hstep, voffA);
            PG8_WAIT_L(8); PG8_BAR; PG8_WAIT_L(0); PG8_MMA(0, 0, At, B0); PG8_BAR; PG8_SCHED;
            PG8_LDB(B1, 0, 1); PG8_STAGE(PG8_SB(0, 0), b2, voffB);
            PG8_BAR; PG8_WAIT_L(0); PG8_MMA(0, 1, At, B1); PG8_BAR;
            PG8_LDA(At, 0, 1); PG8_STAGE(PG8_SA(0, 0), a2, voffA);
            PG8_BAR; PG8_WAIT_L(0); PG8_MMA(1, 0, At, B0); PG8_BAR; PG8_SCHED;
            PG8_STAGE(PG8_SB(0, 1), b2 + hstep, voffB);
            PG8_WAIT_V(6); PG8_BAR; PG8_MMA(1, 1, At, B1); PG8_BAR;
            PG8_LDB(B0, 1, 0); PG8_SCHED; PG8_LDA(At, 1, 0); PG8_STAGE(PG8_SA(0, 1), a2 + hstep, voffA);
            PG8_WAIT_L(8); PG8_BAR; PG8_WAIT_L(0); PG8_MMA(0, 0, At, B0); PG8_BAR; PG8_SCHED;
            PG8_LDB(B1, 1, 1); PG8_STAGE(PG8_SB(1, 0), b3, voffB);
            PG8_BAR; PG8_WAIT_L(0); PG8_MMA(0, 1, At, B1); PG8_BAR;
            PG8_LDA(At, 1, 1); PG8_STAGE(PG8_SA(1, 0), a3, voffA);
            PG8_BAR; PG8_WAIT_L(0); PG8_MMA(1, 0, At, B0); PG8_BAR; PG8_SCHED;
            PG8_STAGE(PG8_SB(1, 1), b3 + hstep, voffB);
            PG8_WAIT_V(6); PG8_BAR; PG8_MMA(1, 1, At, B1); PG8_BAR;
            }
        }
        if constexpr (ALIGN_EPI) { if (wr == 0) PG8_BAR; }
        if constexpr (!Epi::AFTER_DRAIN) { E(acc, cur, wr, wc, fr, fq); S.done(cur); }
        if (!has_next) break;
#pragma unroll
        for (int a = 0; a < 2; ++a)
#pragma unroll
            for (int b = 0; b < 2; ++b)
#pragma unroll
                for (int m = 0; m < 4; ++m)
#pragma unroll
                    for (int n = 0; n < 2; ++n) acc[a][b][m][n] = (f32x4){0.f, 0.f, 0.f, 0.f};
        cur = nxt; cA = nA; cB = nB; ++ui;
        if constexpr (ALIGN_EPI) { if (wr == 1) PG8_BAR; }
    }
    PG8_WAIT_V(0);
    if constexpr (!ALIGN_EPI) { if (wr == 0) PG8_BAR; }
    PG8_BAR;
    if constexpr (Epi::AFTER_DRAIN) { E.fused(acc, cur, wr, wc, fr, fq, lds, wid, lane); S.done(cur); }
#undef PG8_SA
#undef PG8_SB
#undef PG8_STAGE
#undef PG8_LDA
#undef PG8_LDB
#undef PG8_MMA
#undef PG8_WAIT_V
#undef PG8_WAIT_L
#undef PG8_BAR
#undef PG8_SCHED
}
}
#include <hip/hip_bf16.h>
#include <cmath>
namespace attn_body {
using bf16=__hip_bfloat16;
using bf16x8=__attribute__((ext_vector_type(8)))short;
using s16x4=__attribute__((ext_vector_type(4)))short;
using f32x16=__attribute__((ext_vector_type(16)))float;
using u32x4=__attribute__((ext_vector_type(4)))unsigned;
constexpr int BATCH=8,NHEAD=8,SEQ=4096,D=64,PQ=3840,PO=1024;
constexpr int NW=8,QBLK=32,QB=QBLK*NW,KVBLK=64,NQB=SEQ/QB;
constexpr int ATTN_UNIT_ROWS=QB;
__device__ __forceinline__ int crow(int r,int hi){return (r&3)+8*(r>>2)+4*hi;}
#define SBAR() __builtin_amdgcn_sched_barrier(0)
__device__ __forceinline__ void cmask(f32x16&p0,f32x16&p1,int jb,int qrel,int hi){
  const float NEG=-INFINITY; int kb=64*jb+4*hi;
  #pragma unroll
  for(int r=0;r<16;++r){int kv=kb+(r&3)+8*(r>>2); if(kv>qrel)p0[r]=NEG; if(kv+32>qrel)p1[r]=NEG;}
}

constexpr int NSLOT=3, SLOTB=8192, SEL_OFF=90112+64;
constexpr int LDS_K=0, LDS_V=NSLOT*SLOTB, LDS_WS=2*NSLOT*SLOTB, LDS_OST=LDS_WS+NW*64*4, LDS_BYTES=LDS_OST+NW*4096;
constexpr float C2=0.125f*1.4426950408889634f;
__device__ __forceinline__ void glds16(const void*gsrc,unsigned lds_dst){unsigned keep;
  asm volatile("s_mov_b32 %0, m0\n\ts_mov_b32 m0, %2\n\ts_nop 0\n\tglobal_load_lds_dwordx4 %1, off\n\ts_mov_b32 m0, %0":"=&s"(keep):"v"(gsrc),"s"(lds_dst):"memory");}
__device__ __forceinline__ float max3f(float a,float b,float c){float r;asm("v_max3_f32 %0, %1, %2, %3":"=v"(r):"v"(a),"v"(b),"v"(c));return r;}
__device__ __forceinline__ float max2f(float a,float b){float r;asm("v_max_f32_e32 %0, %1, %2":"=v"(r):"v"(a),"v"(b));return r;}
__device__ __forceinline__ float fadd_s(float a,float b){float r;asm("v_add_f32_e32 %0, %1, %2":"=v"(r):"v"(a),"v"(b));return r;}
__device__ __forceinline__ float fsub_s(float a,float b){float r;asm("v_sub_f32_e32 %0, %1, %2":"=v"(r):"v"(a),"v"(b));return r;}
typedef float f32x2_t __attribute__((ext_vector_type(2))); typedef __bf16 bf16x2_t __attribute__((ext_vector_type(2)));
__device__ __forceinline__ unsigned cvtpk_s(float lo,float hi){f32x2_t v={lo,hi};bf16x2_t b=__builtin_convertvector(v,bf16x2_t);return __builtin_bit_cast(unsigned,b);}
#define WAIT_BAR(N) asm volatile("s_waitcnt vmcnt(" #N ") lgkmcnt(0)\n\ts_barrier":::"memory")

__device__ __forceinline__ void qkt(f32x16&p0,f32x16&p1,const char*Kslot,const bf16x8*qr,const f32x16&negm,int r32,int hi){
  const char*kb=Kslot+hi*1024+r32*16;
  #pragma unroll
  for(int d0=0;d0<4;++d0){
    const bf16x8 b0=*reinterpret_cast<const bf16x8*>(kb+d0*2048);
    const bf16x8 b1=*reinterpret_cast<const bf16x8*>(kb+d0*2048+512);
    if(d0==0){p0=__builtin_amdgcn_mfma_f32_32x32x16_bf16(b0,qr[0],negm,0,0,0);p1=__builtin_amdgcn_mfma_f32_32x32x16_bf16(b1,qr[0],negm,0,0,0);}
    else{p0=__builtin_amdgcn_mfma_f32_32x32x16_bf16(b0,qr[d0],p0,0,0,0);p1=__builtin_amdgcn_mfma_f32_32x32x16_bf16(b1,qr[d0],p1,0,0,0);}}
}
typedef __attribute__((address_space(3))) const char* lds_cptr;
typedef short v4i16_t __attribute__((ext_vector_type(4)));
__device__ __forceinline__ void kload8(bf16x8*kf,lds_cptr kp){
  kf[0]=*(const __attribute__((address_space(3))) bf16x8*)(kp);      kf[1]=*(const __attribute__((address_space(3))) bf16x8*)(kp+512);
  kf[2]=*(const __attribute__((address_space(3))) bf16x8*)(kp+2048); kf[3]=*(const __attribute__((address_space(3))) bf16x8*)(kp+2560);
  kf[4]=*(const __attribute__((address_space(3))) bf16x8*)(kp+4096); kf[5]=*(const __attribute__((address_space(3))) bf16x8*)(kp+4608);
  kf[6]=*(const __attribute__((address_space(3))) bf16x8*)(kp+6144); kf[7]=*(const __attribute__((address_space(3))) bf16x8*)(kp+6656);
}
__device__ __forceinline__ void kload2(bf16x8*kf,lds_cptr kp,int j){ kf[2*j]=*(const __attribute__((address_space(3))) bf16x8*)(kp+j*2048); kf[2*j+1]=*(const __attribute__((address_space(3))) bf16x8*)(kp+j*2048+512); }
__device__ __forceinline__ s16x4 vtr(lds_cptr p){ return __builtin_bit_cast(s16x4,__builtin_amdgcn_ds_read_tr16_b64_v4i16((__attribute__((address_space(3))) v4i16_t*)p)); }
__device__ __forceinline__ float rowmax(const f32x16&p0,const f32x16&p1){
  float a=max3f(p0[0],p0[1],p1[0]),b=max3f(p0[2],p0[3],p1[1]);a=max3f(a,p1[2],p1[3]);
  #pragma unroll
  for(int r=4;r<16;r+=4){a=max3f(a,p0[r],p0[r+1]);b=max3f(b,p0[r+2],p0[r+3]);a=max3f(a,p1[r],p1[r+1]);b=max3f(b,p1[r+2],p1[r+3]);}
  const float m=max2f(a,b);
  auto rr=__builtin_amdgcn_permlane32_swap(__float_as_uint(m),__float_as_uint(m),false,false);
  return max2f(__uint_as_float(rr[0]),__uint_as_float(rr[1]));
}
__device__ __forceinline__ void pv(f32x16*o,int vb,bf16x8 pa0,bf16x8 pa1,bf16x8 pa2,bf16x8 pa3){
  #pragma unroll
  for(int d0=0;d0<2;++d0){s16x4 lo[4],hi[4];
    #pragma unroll
    for(int ks=0;ks<4;++ks){
      asm volatile("ds_read_b64_tr_b16 %0,%1 offset:%c2":"=&v"(lo[ks]):"v"(vb),"i"(d0*4096+ks*1024):"memory");
      asm volatile("ds_read_b64_tr_b16 %0,%1 offset:%c2":"=&v"(hi[ks]):"v"(vb),"i"(d0*4096+ks*1024+512):"memory");}
    asm volatile("s_waitcnt lgkmcnt(0)":::"memory");SBAR();
    #define PK(k) (bf16x8){lo[k][0],lo[k][1],lo[k][2],lo[k][3],hi[k][0],hi[k][1],hi[k][2],hi[k][3]}
    o[d0]=__builtin_amdgcn_mfma_f32_32x32x16_bf16(pa0,PK(0),o[d0],0,0,0);
    o[d0]=__builtin_amdgcn_mfma_f32_32x32x16_bf16(pa1,PK(1),o[d0],0,0,0);
    o[d0]=__builtin_amdgcn_mfma_f32_32x32x16_bf16(pa2,PK(2),o[d0],0,0,0);
    o[d0]=__builtin_amdgcn_mfma_f32_32x32x16_bf16(pa3,PK(3),o[d0],0,0,0);
    #undef PK
  }
}

#ifndef ATTN_STORE16
#define ATTN_STORE16(p,v) (*(u32x4*)(p)=(v))
#endif
template<int THRL> __device__ __forceinline__ void attn_unit(int b,int h,int qb,const bf16*Q,const bf16*__restrict__ K,const bf16*__restrict__ V,bf16*O,char*shm){
  const int tid=opaque_tid(),lane=tid&63,r32=lane&31,hi=lane>>5; const int wid=__builtin_amdgcn_readfirstlane(tid>>6);
  const long rowbase=(long)b*SEQ; const int q0=qb*QB;
  const bf16*Qw=Q+(rowbase+q0+wid*QBLK)*PQ+h*D;
  const bf16*Kh=K+rowbase*PQ+h*D,*Vh=V+rowbase*PQ+h*D;
  const unsigned lds0=(unsigned)(uintptr_t)shm;
  float*wsf=(float*)(shm+LDS_WS)+wid*64;
  const bf16*ksrc=Kh+(long)lane*PQ+wid*8;
  const bf16*vsrc=Vh+(long)(16*(wid&3)+(lane>>2))*PQ+(wid>>2)*32+(lane&3)*8;
  const unsigned kdst=lds0+LDS_K+wid*1024, vdst=lds0+LDS_V+wid*1024;
  #define KT(t) (((t)<4)?(NT-4+(t)):((t)-4))
  #define DMA_K(t,slot) glds16(ksrc+(long)KT(t)*KVBLK*PQ,(unsigned)__builtin_amdgcn_readfirstlane(kdst+(slot)))
  #define DMA_V(t,slot) glds16(vsrc+(long)KT(t)*KVBLK*PQ,(unsigned)__builtin_amdgcn_readfirstlane(vdst+(slot)))
  const int vb0=(int)(lds0+LDS_V)+((lane>>4)&1)*32+(lane&3)*8+(4*hi+((lane&15)>>2))*64;
  const char*Kbase=shm+LDS_K; bf16x8 kf[8];
  const lds_cptr shm3=(lds_cptr)shm; const lds_cptr kp0=shm3+LDS_K+hi*1024+r32*16; const lds_cptr vp0=shm3+LDS_V+((lane>>4)&1)*32+(lane&3)*8+(4*hi+((lane&15)>>2))*64;
  const int NT=(q0+QB)/KVBLK;
  DMA_K(0,0);DMA_V(0,0);DMA_K(1,SLOTB);
  bf16x8 qr[4];
  #pragma unroll
  for(int d0=0;d0<4;++d0)qr[d0]=*reinterpret_cast<const bf16x8*>(&Qw[(long)r32*PQ+d0*16+hi*8]);
  const unsigned selmask=((const unsigned*)(shm+SEL_OFF))[wid*QBLK+r32];
  float mhat=0.f,l_reg=0.f;f32x16 o[2];o[0]=f32x16{};o[1]=f32x16{};f32x16 negm=f32x16{};asm volatile("":"+v"(negm));
  const int qrel=wid*QBLK+r32;
  #define CMASK(P0,P1,t) do{const int t_=(t); if(t_<4){cmask(P0,P1,t_,qrel,hi);} else if(!((selmask>>((t_-4)>>2))&1u)){ _Pragma("unroll") for(int r_=0;r_<16;++r_){P0[r_]=-INFINITY;P1[r_]=-INFINITY;} } }while(0)
  bool resc=false;
  #define START(P0,P1) do{ const float rm=rowmax(P0,P1); resc=false; \
    { const float dl=rm; mhat=fadd_s(mhat,dl); \
      _Pragma("unroll") for(int r=0;r<16;++r){P0[r]=fsub_s(P0[r],dl);P1[r]=fsub_s(P1[r],dl);} \
      } \
    _Pragma("unroll") for(int r=0;r<16;++r)P0[r]=__builtin_amdgcn_exp2f(P0[r]); }while(0)
  #define RESC() do{ if(resc){ asm volatile("s_waitcnt lgkmcnt(0)":::"memory"); \
      _Pragma("unroll") for(int d_=0;d_<2;++d_) _Pragma("unroll") for(int r=0;r<16;++r)o[d_][r]*=wsf[crow(r,hi)]; } }while(0)
  f32x16 pA0,pA1,pB0,pB1;
  int sl_prev=0,sl_cur=0,sl_next=SLOTB;
  #define ROT() do{sl_prev=sl_cur;sl_cur=sl_next;sl_next=(sl_next==(NSLOT-1)*SLOTB)?0:sl_next+SLOTB;}while(0)
  DMA_K(2,2*SLOTB);
  WAIT_BAR(3);
  qkt(pA0,pA1,Kbase,qr,negm,r32,hi);asm volatile("s_nop 15\n\ts_nop 7":"+v"(pA0),"+v"(pA1));CMASK(pA0,pA1,0);
  START(pA0,pA1);
  _Pragma("unroll") for(int r=0;r<16;++r)pA1[r]=__builtin_amdgcn_exp2f(pA1[r]);
  WAIT_BAR(0);
  DMA_K(3,0);DMA_V(1,SLOTB);
  ROT();
  kload8(kf,kp0+sl_cur);
  WAIT_BAR(2);
  s16x4 vlo[8],vhi[8]; u32x4 pw0,pw1,pw2,pw3;
  #define PKW(P,B) cvtpk_s(P[B],P[B+1])
  #define PAF(k) __builtin_bit_cast(bf16x8,pw##k)
  #define VFR(i) (bf16x8){vlo[i][0],vlo[i][1],vlo[i][2],vlo[i][3],vhi[i][0],vhi[i][1],vhi[i][2],vhi[i][3]}
  #define PIN(x) asm volatile("":"+v"(x))
  #define MX3(a,b,c) __builtin_fmaxf(__builtin_fmaxf((a),(b)),(c))
  #define GAPA(MF,A0,A1,A2,A3,W0,W1,PW) do{ MF; sacc+=A0; sacc+=A1; sacc+=A2; sacc+=A3; PIN(sacc); W0; W1; PIN(PW); SBAR(); }while(0)
  #define EX(v) __builtin_amdgcn_exp2f(v)
  #define GAPB(MF,X,B) do{ MF; X[B]=EX(X[B]); X[B+1]=EX(X[B+1]); X[B+2]=EX(X[B+2]); X[B+3]=EX(X[B+3]); PIN(X); SBAR(); }while(0)
  #define VRD(i) do{ vlo[i]=vtr(vp_+(((i)>>2)*4096+((i)&3)*1024)); vhi[i]=vtr(vp_+(((i)>>2)*4096+((i)&3)*1024+512)); }while(0)
  #define KRD(G,j) do{ if(G){ kload2(kf,kp0+sl_next,j); SBAR(); } }while(0)
  #define STEP(C0,C1,P0,P1,t,GK,GV,GL) do{ \
    { const int t_=(t); if(((t_&3)==0)||resc||t_==1){ const float nm_=((t_<4)||((selmask>>((t_-4)>>2))&1u))?-mhat:-INFINITY; \
        _Pragma("unroll") for(int r=0;r<16;++r)negm[r]=nm_; asm volatile("":"+v"(negm)); } } \
    SBAR(); \
    const lds_cptr vp_=vp0+sl_prev; \
    VRD(0); SBAR(); float sacc=(P0[0]+P0[1]); \
    GAPA(C0=__builtin_amdgcn_mfma_f32_32x32x16_bf16(kf[0],qr[0],negm,0,0,0), P0[2],P0[3],P0[4],P0[5],     pw0[0]=PKW(P0,0), pw0[1]=PKW(P0,2), pw0); \
    VRD(4); SBAR(); GAPA(C1=__builtin_amdgcn_mfma_f32_32x32x16_bf16(kf[1],qr[0],negm,0,0,0), P0[6],P0[7],P0[8],P0[9],     pw0[2]=PKW(P0,4), pw0[3]=PKW(P0,6), pw0); \
    VRD(1); SBAR(); GAPA(C0=__builtin_amdgcn_mfma_f32_32x32x16_bf16(kf[2],qr[1],C0,0,0,0),   P0[10],P0[11],P0[12],P0[13], pw1[0]=PKW(P0,8), pw1[1]=PKW(P0,10), pw1); \
    VRD(5); SBAR(); GAPA(C1=__builtin_amdgcn_mfma_f32_32x32x16_bf16(kf[3],qr[1],C1,0,0,0),   P0[14],P0[15],P1[0],P1[1],   pw1[2]=PKW(P0,12),pw1[3]=PKW(P0,14), pw1); \
    VRD(2); SBAR(); GAPA(C0=__builtin_amdgcn_mfma_f32_32x32x16_bf16(kf[4],qr[2],C0,0,0,0),   P1[2],P1[3],P1[4],P1[5],     pw2[0]=PKW(P1,0), pw2[1]=PKW(P1,2), pw2); \
    VRD(6); SBAR(); GAPA(C1=__builtin_amdgcn_mfma_f32_32x32x16_bf16(kf[5],qr[2],C1,0,0,0),   P1[6],P1[7],P1[8],P1[9],     pw2[2]=PKW(P1,4), pw2[3]=PKW(P1,6), pw2); \
    VRD(3); SBAR(); GAPA(C0=__builtin_amdgcn_mfma_f32_32x32x16_bf16(kf[6],qr[3],C0,0,0,0),   P1[10],P1[11],P1[12],P1[13], pw3[0]=PKW(P1,8), pw3[1]=PKW(P1,10), pw3); \
    VRD(7); SBAR(); GAPA(C1=__builtin_amdgcn_mfma_f32_32x32x16_bf16(kf[7],qr[3],C1,0,0,0),   P1[14],P1[15],0.f,0.f,       pw3[2]=PKW(P1,12),pw3[3]=PKW(P1,14), pw3); \
    l_reg+=sacc; \
    if(GK){DMA_K((t)+3,sl_cur);} if(GV){DMA_V((t)+1,sl_next);} \
    { const int t_=(t); if(t_<4) cmask(C0,C1,t_,qrel,hi); } \
    { float a=MX3(C0[0],C0[1],C1[0]),b=MX3(C0[2],C0[3],C1[1]); a=MX3(a,C1[2],C1[3]); \
      _Pragma("unroll") for(int r=4;r<16;r+=4){a=MX3(a,C0[r],C0[r+1]);b=MX3(b,C0[r+2],C0[r+3]);a=MX3(a,C1[r],C1[r+1]);b=MX3(b,C1[r+2],C1[r+3]);} \
      float rm=__builtin_fmaxf(a,b); { auto rr=__builtin_amdgcn_permlane32_swap(__float_as_uint(rm),__float_as_uint(rm),false,false); rm=__builtin_fmaxf(__uint_as_float(rr[0]),__uint_as_float(rr[1])); } \
      resc=false; \
      if(__builtin_expect(__any(rm>(float)THRL),0)){ const float dl=__builtin_fmaxf(rm,0.f); mhat+=dl; \
        _Pragma("unroll") for(int r=0;r<16;++r){C0[r]-=dl;C1[r]-=dl;} \
        const float f=__builtin_amdgcn_exp2f(-dl); l_reg*=f; if(hi==0)wsf[r32]=f; resc=true; } } \
    SBAR(); \
    GAPB(o[0]=__builtin_amdgcn_mfma_f32_32x32x16_bf16(PAF(0),VFR(0),o[0],0,0,0), C0,0); \
    GAPB(o[1]=__builtin_amdgcn_mfma_f32_32x32x16_bf16(PAF(0),VFR(4),o[1],0,0,0), C0,4); \
    KRD(GL,0); GAPB(o[0]=__builtin_amdgcn_mfma_f32_32x32x16_bf16(PAF(1),VFR(1),o[0],0,0,0), C0,8); \
    KRD(GL,1); GAPB(o[1]=__builtin_amdgcn_mfma_f32_32x32x16_bf16(PAF(1),VFR(5),o[1],0,0,0), C0,12); \
    KRD(GL,2); GAPB(o[0]=__builtin_amdgcn_mfma_f32_32x32x16_bf16(PAF(2),VFR(2),o[0],0,0,0), C1,0); \
    KRD(GL,3); GAPB(o[1]=__builtin_amdgcn_mfma_f32_32x32x16_bf16(PAF(2),VFR(6),o[1],0,0,0), C1,4); \
    GAPB(o[0]=__builtin_amdgcn_mfma_f32_32x32x16_bf16(PAF(3),VFR(3),o[0],0,0,0), C1,8); \
    GAPB(o[1]=__builtin_amdgcn_mfma_f32_32x32x16_bf16(PAF(3),VFR(7),o[1],0,0,0), C1,12); \
    }while(0)
  int t=1;
  for(;t+5<NT;t+=2){
    STEP(pB0,pB1,pA0,pA1,t,true,true,true);     WAIT_BAR(2); RESC(); ROT();
    STEP(pA0,pA1,pB0,pB1,t+1,true,true,true);   WAIT_BAR(2); RESC(); ROT();
  }
  #define ENDW(tt) do{ if((tt)+3<NT){WAIT_BAR(2);} else if((tt)+2<NT){WAIT_BAR(1);} else {WAIT_BAR(0);} }while(0)
  for(;t+1<NT;t+=2){
    STEP(pB0,pB1,pA0,pA1,t,(t+3<NT),(t+1<NT),(t+1<NT));       ENDW(t);   RESC(); ROT();
    STEP(pA0,pA1,pB0,pB1,t+1,(t+4<NT),(t+2<NT),(t+2<NT));     ENDW(t+1); RESC(); ROT();
  }
  STEP(pB0,pB1,pA0,pA1,NT-1,false,false,false); RESC();
  { float sacc=pB0[0]+pB0[1]; _Pragma("unroll") for(int r=2;r<16;++r)sacc+=pB0[r]; _Pragma("unroll") for(int r=0;r<16;++r)sacc+=pB1[r]; l_reg+=sacc;
    pw0=(u32x4){PKW(pB0,0),PKW(pB0,2),PKW(pB0,4),PKW(pB0,6)};pw1=(u32x4){PKW(pB0,8),PKW(pB0,10),PKW(pB0,12),PKW(pB0,14)};pw2=(u32x4){PKW(pB1,0),PKW(pB1,2),PKW(pB1,4),PKW(pB1,6)};pw3=(u32x4){PKW(pB1,8),PKW(pB1,10),PKW(pB1,12),PKW(pB1,14)};
    SBAR(); pv(o,vb0+sl_cur,PAF(0),PAF(1),PAF(2),PAF(3)); }
  #undef PKW
  #undef PAF
  #undef VFR
  #undef PIN
  #undef MX3
  #undef GAPA
  #undef GAPB
  #undef EX
  #undef VRD
  #undef KRD
  #undef STEP
  #undef ENDW
  {auto rr=__builtin_amdgcn_permlane32_swap(__float_as_uint(l_reg),__float_as_uint(l_reg),false,false);l_reg=__uint_as_float(rr[0])+__uint_as_float(rr[1]);}
  if(hi==0)wsf[32+r32]=l_reg;asm volatile("s_waitcnt lgkmcnt(0)":::"memory");
  float rli[16];
  #pragma unroll
  for(int r=0;r<16;++r)rli[r]=__builtin_amdgcn_rcpf(wsf[32+crow(r,hi)]);
  bf16*Ow=O+(rowbase+q0+wid*QBLK)*PO+h*D;
  { bf16*stg=(bf16*)(shm+LDS_OST)+wid*2048;
    #pragma unroll
    for(int r=0;r<16;++r){const int orow=crow(r,hi);
      #pragma unroll
      for(int d0=0;d0<2;++d0)stg[orow*64+d0*32+r32]=__float2bfloat16(o[d0][r]*rli[r]);}
    asm volatile("s_waitcnt lgkmcnt(0)":::"memory");
    #pragma unroll
    for(int i=0;i<4;++i){const int row=i*8+(lane>>3),ch=lane&7; const u32x4 v=*(const u32x4*)(stg+row*64+ch*8); ATTN_STORE16(Ow+(long)row*PO+ch*8,v);} }
  asm volatile("s_waitcnt lgkmcnt(0)\n\ts_barrier":::"memory");
  #undef DMA_K
  #undef KT
  #undef DMA_V
  #undef CMASK
  #undef START
  #undef RESC
  #undef ROT
}
constexpr int ATTN_LDS_BYTES=LDS_BYTES;
struct AttnTensors { const bf16* Q; const bf16* K; const bf16* V; bf16* O; };
#undef SBAR
#undef WAIT_BAR
}
typedef unsigned short bf16;
typedef unsigned v4u __attribute__((ext_vector_type(4)));
typedef unsigned v2u __attribute__((ext_vector_type(2)));
typedef float f32x4 __attribute__((ext_vector_type(4)));
typedef short bf16x8 __attribute__((ext_vector_type(8)));
constexpr int NB = 8, SEQL = 4096, DMODEL = 1024, NLAYER = 2, MTOK = NB * SEQL;
constexpr int NIN = 3592, NINP = 3840, DFF = 2816, NUP = 5632;
constexpr int C_QA = 0, C_KA = 512, C_VA = 1024, C_Z = 1536, C_QB = 2048, C_KB = 2560, C_VB = 3072, C_AL = 3584, C_BL = 3588;
constexpr float ALPHA = 1.4142135623730951f, LN_EPS = 1e-5f, NORM_EPS = 1e-6f;
constexpr size_t MiB = 1u << 20;
constexpr size_t WS_CTL = 0, WS_KMEAN = 256 * 1024, WS_GLAST = 512 * 1024, WS_STAT = 576 * 1024;
constexpr size_t WS_W = 1 * MiB, W_LAYER = 26 * MiB, W_IN = 0, W_OUT = 7864320, W_UP = W_OUT + 2 * MiB, W_DOWN = W_UP + 11 * MiB;
constexpr size_t WS_XBF = 53 * MiB;
constexpr size_t WS_PROJ = 117 * MiB;
constexpr size_t WS_GDN = 357 * MiB;
constexpr size_t WS_YX = WS_PROJ;
constexpr size_t WS_ACT = 245 * MiB;
constexpr size_t WS_EDGE = 421 * MiB;
constexpr size_t WS_ROPE = 501 * MiB;
constexpr size_t WS_END = 502 * MiB;
constexpr int CHUNK_REC = 73728;
constexpr int LDS_BYTES = 155648;
constexpr int NTHREADS = 512;

__device__ __forceinline__ float bf2f(unsigned short u) { return __uint_as_float(((unsigned)u) << 16); }
typedef float pk_f32x2 __attribute__((ext_vector_type(2))); typedef __bf16 pk_bf16x2 __attribute__((ext_vector_type(2)));
__device__ __forceinline__ unsigned pk2(float lo, float hi) { const pk_f32x2 v = {lo, hi}; const pk_bf16x2 b = __builtin_convertvector(v, pk_bf16x2); return __builtin_bit_cast(unsigned, b); }
__device__ __forceinline__ unsigned f2bf(float f) { return pk2(f, 0.f); }
__device__ __forceinline__ float wave_sum(float v) {
#pragma unroll
    for (int o = 1; o < 64; o <<= 1) v += __shfl_xor(v, o);
    return v;
}
__device__ __forceinline__ f32x4 mfma16(bf16x8 a, bf16x8 b, f32x4 c) { return __builtin_amdgcn_mfma_f32_16x16x32_bf16(a, b, c, 0, 0, 0); }

template <int MAPID> __device__ __forceinline__ int wmap(int n) {
    if (MAPID == 0) return n;
    if (MAPID == 1) { if (n < 1536) return n; if (n < 3584) return n + 8; if (n < 3592) return n - 3584 + 1536; return -1; }
    { const int pn = n >> 8, rem = n & 255; return (rem >> 7) * DFF + pn * 128 + (rem & 127); }
}
template <int MAPID> __device__ __forceinline__ void transpose_item(const float* W, int K, int N, int NP, bf16* WT, float* scr, int item, int lane) {
    const int nblk = NP / 32, kb = item / nblk, nb = item % nblk, k0 = 64 * kb, n0 = 32 * nb;
    const int src = wmap<MAPID>(n0 + (lane & 31));
#pragma unroll
    for (int i = 0; i < 32; ++i) { const int kk = 2 * i + (lane >> 5); scr[kk * 33 + (lane & 31)] = (src >= 0) ? W[(size_t)(k0 + kk) * N + src] : 0.f; }
    asm volatile("s_waitcnt lgkmcnt(0)" ::: "memory");
    const int c = lane & 7;
#pragma unroll
    for (int j = 0; j < 4; ++j) { const int n = (lane >> 3) + 8 * j; const float* s = scr + (8 * c) * 33 + n;
        v4u o; o.x = pk2(s[0 * 33], s[1 * 33]); o.y = pk2(s[2 * 33], s[3 * 33]); o.z = pk2(s[4 * 33], s[5 * 33]); o.w = pk2(s[6 * 33], s[7 * 33]);
        *(v4u*)(WT + (size_t)(n0 + n) * K + k0 + 8 * c) = o; }
    asm volatile("s_waitcnt lgkmcnt(0)" ::: "memory");
}
struct Ptrs {
    const float *x, *w_in, *conv_w, *a_log, *dt_bias, *norm_g, *w_out, *ln1_g, *ln1_b, *w_up, *fconv_w, *fconv_b, *w_down, *ln2_g, *ln2_b;
    float* out; unsigned char* ws;
};
__device__ __forceinline__ void p0_prologue(const Ptrs& P, unsigned char* lds, int G) {
    const int tid = opaque_tid(), lane = tid & 63, wave = __builtin_amdgcn_readfirstlane(tid >> 6);
    if (wave < 4) {
        float* scr = (float*)(lds + wave * 16384);
        const int gw = blockIdx.x * 4 + wave, NGW = G * 4;
        constexpr int I_IN = 16 * (NINP / 32), I_OUT = 16 * 32, I_UP = 16 * (NUP / 32), I_DN = (DFF / 64) * 32, I_L = I_IN + I_OUT + I_UP + I_DN;
        for (int it = gw; it < NLAYER * I_L; it += NGW) {
            const int l = it / I_L; int r = it % I_L;
            unsigned char* wb = P.ws + WS_W + (size_t)l * W_LAYER;
            if (r < I_IN) { transpose_item<1>(P.w_in + (size_t)l * DMODEL * NIN, DMODEL, NIN, NINP, (bf16*)(wb + W_IN), scr, r, lane); continue; } r -= I_IN;
            if (r < I_OUT) { transpose_item<0>(P.w_out + (size_t)l * DMODEL * DMODEL, DMODEL, DMODEL, DMODEL, (bf16*)(wb + W_OUT), scr, r, lane); continue; } r -= I_OUT;
            if (r < I_UP) { transpose_item<2>(P.w_up + (size_t)l * DMODEL * NUP, DMODEL, NUP, NUP, (bf16*)(wb + W_UP), scr, r, lane); continue; } r -= I_UP;
            transpose_item<0>(P.w_down + (size_t)l * DFF * DMODEL, DFF, DMODEL, DMODEL, (bf16*)(wb + W_DOWN), scr, r, lane);
        }
    } else {
        const int t2 = tid - 256, NT2 = G * 256;
        for (int e = blockIdx.x * 256 + t2; e < SEQL * 8; e += NT2) {
            const int pos = e >> 3, i = e & 7; const float inv = powf(500000.0f, -(float)i / 8.0f);
            float sn, cs; sincosf((float)pos * inv, &sn, &cs);
            pg8::f32x2 t; t.x = cs; t.y = sn; ((pg8::f32x2*)(P.ws + WS_ROPE))[e] = t;
        }
        bf16* xb = (bf16*)(P.ws + WS_XBF);
        const size_t nvec = (size_t)MTOK * DMODEL / 8;
#pragma unroll 4
        for (size_t v = (size_t)blockIdx.x * 256 + t2; v < nvec; v += (size_t)NT2) {
            const f32x4 a = *(const f32x4*)(P.x + v * 8), b = *(const f32x4*)(P.x + v * 8 + 4);
            v4u o; o.x = pk2(a[0], a[1]); o.y = pk2(a[2], a[3]); o.z = pk2(b[0], b[1]); o.w = pk2(b[2], b[3]);
            *(v4u*)(xb + v * 8) = o;
        }
    }
}

__device__ __forceinline__ void ln_unpack(f32x4 (&v)[4], const v4u& a, const v4u& b2) {
    v[0][0] = __uint_as_float(a[0] << 16); v[0][1] = __uint_as_float(a[0] & 0xffff0000u); v[0][2] = __uint_as_float(a[1] << 16); v[0][3] = __uint_as_float(a[1] & 0xffff0000u);
    v[1][0] = __uint_as_float(a[2] << 16); v[1][1] = __uint_as_float(a[2] & 0xffff0000u); v[1][2] = __uint_as_float(a[3] << 16); v[1][3] = __uint_as_float(a[3] & 0xffff0000u);
    v[2][0] = __uint_as_float(b2[0] << 16); v[2][1] = __uint_as_float(b2[0] & 0xffff0000u); v[2][2] = __uint_as_float(b2[1] << 16); v[2][3] = __uint_as_float(b2[1] & 0xffff0000u);
    v[3][0] = __uint_as_float(b2[2] << 16); v[3][1] = __uint_as_float(b2[2] & 0xffff0000u); v[3][2] = __uint_as_float(b2[3] << 16); v[3][3] = __uint_as_float(b2[3] & 0xffff0000u);
}
__device__ __forceinline__ void ln_phase(const bf16* y, float* outf, bf16* outb, float* stat, const float* gam, const float* bet, int G) {
    const int tid = opaque_tid(), lane = tid & 63, wave = tid >> 6;
    f32x4 gv[4], bv[4];
#pragma unroll
    for (int j = 0; j < 4; ++j) { const int c = (j >> 1) * 512 + 8 * lane + 4 * (j & 1); gv[j] = *(const f32x4*)(gam + c); bv[j] = *(const f32x4*)(bet + c); }
    const int NW = G * 8;
    for (int m0 = blockIdx.x * 8 + wave; m0 < MTOK; m0 += 2 * NW) {
        const int m1 = m0 + NW;
        const bf16* y0 = y + (size_t)m0 * DMODEL + 8 * lane; const bf16* y1 = y + (size_t)m1 * DMODEL + 8 * lane;
        const v4u a0 = *(const v4u*)y0, c0 = *(const v4u*)(y0 + 512), a1 = *(const v4u*)y1, c1 = *(const v4u*)(y1 + 512);
        f32x4 v[2][4]; ln_unpack(v[0], a0, c0); ln_unpack(v[1], a1, c1);
        float s[2] = {0.f, 0.f};
#pragma unroll
        for (int q = 0; q < 2; ++q)
#pragma unroll
            for (int j = 0; j < 4; ++j) s[q] += (v[q][j][0] + v[q][j][1]) + (v[q][j][2] + v[q][j][3]);
#pragma unroll
        for (int o = 1; o < 64; o <<= 1) { s[0] += __shfl_xor(s[0], o); s[1] += __shfl_xor(s[1], o); }
        const float mean[2] = {s[0] * (1.f / DMODEL), s[1] * (1.f / DMODEL)};
        float s2[2] = {0.f, 0.f};
#pragma unroll
        for (int q = 0; q < 2; ++q)
#pragma unroll
            for (int j = 0; j < 4; ++j) { v[q][j] = v[q][j] - mean[q]; s2[q] += (v[q][j][0] * v[q][j][0] + v[q][j][1] * v[q][j][1]) + (v[q][j][2] * v[q][j][2] + v[q][j][3] * v[q][j][3]); }
#pragma unroll
        for (int o = 1; o < 64; o <<= 1) { s2[0] += __shfl_xor(s2[0], o); s2[1] += __shfl_xor(s2[1], o); }
#pragma unroll
        for (int q = 0; q < 2; ++q) {
            const int m = q ? m1 : m0;
            const float rstd = 1.f / sqrtf(s2[q] * (1.f / DMODEL) + LN_EPS);
            if (stat != nullptr && lane == 0) { pg8::f32x2 ms; ms.x = mean[q]; ms.y = rstd; *(pg8::f32x2*)(stat + 2 * (size_t)m) = ms; }
            f32x4 o[4];
#pragma unroll
            for (int j = 0; j < 4; ++j) o[j] = v[q][j] * rstd * gv[j] + bv[j];
            if (outf != nullptr) { float* of = outf + (size_t)m * DMODEL + 8 * lane; *(f32x4*)of = o[0]; *(f32x4*)(of + 4) = o[1]; *(f32x4*)(of + 512) = o[2]; *(f32x4*)(of + 516) = o[3]; }
            if (outb != nullptr) { bf16* ob = outb + (size_t)m * DMODEL + 8 * lane; v4u w0, w1; w0[0] = pk2(o[0][0], o[0][1]); w0[1] = pk2(o[0][2], o[0][3]); w0[2] = pk2(o[1][0], o[1][1]); w0[3] = pk2(o[1][2], o[1][3]);
                w1[0] = pk2(o[2][0], o[2][1]); w1[1] = pk2(o[2][2], o[2][3]); w1[2] = pk2(o[3][0], o[3][1]); w1[3] = pk2(o[3][2], o[3][3]); *(v4u*)ob = w0; *(v4u*)(ob + 512) = w1; }
        }
    }
}

__device__ __forceinline__ void fix_phase(const float* edge, bf16* act, const float* cw, const float* cb, int G) {
    const int total = 512 * 2 * (DFF / 4);
    const int tid = opaque_tid();
    for (int it = blockIdx.x * NTHREADS + tid; it < total; it += G * NTHREADS) {
        const int c4 = it % (DFF / 4), rr = (it / (DFF / 4)) & 1, s = it / (DFF / 2);
        const int ch = 4 * c4; const bool first = (s % 64) == 0;
        f32x4 h[2];
#pragma unroll
        for (int bj = 0; bj < 2; ++bj) {
            const int col = bj * DFF + ch;
            const f32x4 z4 = (f32x4){0.f, 0.f, 0.f, 0.f};
            const f32x4 cur = *(const f32x4*)(edge + ((size_t)s * 4 + rr) * NUP + col);
            f32x4 p1, p2;
            if (rr == 1) { p1 = *(const f32x4*)(edge + ((size_t)s * 4 + 0) * NUP + col); p2 = first ? z4 : *(const f32x4*)(edge + ((size_t)(s - 1) * 4 + 3) * NUP + col); }
            else { p1 = first ? z4 : *(const f32x4*)(edge + ((size_t)(s - 1) * 4 + 3) * NUP + col); p2 = first ? z4 : *(const f32x4*)(edge + ((size_t)(s - 1) * 4 + 2) * NUP + col); }
            h[bj] = *(const f32x4*)(cw + 2 * NUP + col) * cur + *(const f32x4*)(cw + NUP + col) * p1 + *(const f32x4*)(cw + col) * p2 + *(const f32x4*)(cb + col);
        }
        v2u o; o.x = pk2(pg8::silu_f(h[0][0]) * h[1][0], pg8::silu_f(h[0][1]) * h[1][1]); o.y = pk2(pg8::silu_f(h[0][2]) * h[1][2], pg8::silu_f(h[0][3]) * h[1][3]);
        *(v2u*)(act + ((size_t)s * 64 + rr) * DFF + ch) = o;
    }
}

__device__ __forceinline__ void logits_group(int grp, const bf16* xb, const bf16* wt, bf16* proj) {
    const int tid = opaque_tid(), lane = tid & 63, wid = tid >> 6, g = lane >> 4, ln = lane & 15;
    const bf16* ap = xb + ((size_t)grp * 128 + wid * 16 + ln) * DMODEL + 8 * g;
    const bf16* bp = wt + (size_t)(3584 + ln) * DMODEL + 8 * g;
    f32x4 acc0 = (f32x4){0.f, 0.f, 0.f, 0.f}, acc1 = acc0;
#pragma unroll 1
    for (int k16 = 0; k16 < 2; ++k16) {
        bf16x8 fa[16], fb[16];
#pragma unroll
        for (int kk = 0; kk < 16; ++kk) { const int ko = (k16 * 16 + kk) * 32; fa[kk] = *(const bf16x8*)(ap + ko); fb[kk] = *(const bf16x8*)(bp + ko); }
#pragma unroll
        for (int kk = 0; kk < 16; kk += 2) { acc0 = mfma16(fa[kk], fb[kk], acc0); acc1 = mfma16(fa[kk + 1], fb[kk + 1], acc1); }
    }
    const f32x4 acc = acc0 + acc1;
    if (ln < 8) {
#pragma unroll
        for (int j = 0; j < 4; ++j) proj[((size_t)grp * 128 + wid * 16 + 4 * g + j) * NINP + 3584 + ln] = (bf16)f2bf(acc[j]);
    }
}

__device__ __forceinline__ void moba_prep_item(bf16* proj, float* kmean, const float* rope, int item, unsigned char* lds) {
    const int tid = opaque_tid(); const int j = item & 15, h = (item >> 4) & 7, b = item >> 7;
    const int r = tid >> 1, part = tid & 1;
    float* tile = (float*)lds;
    float* psum = (float*)(lds + 256 * 65 * 4);
    const int pos = 256 * j + r;
    bf16* qp = proj + ((size_t)b * SEQL + pos) * NINP + C_QB + h * 64 + 32 * part;
    bf16* kp = proj + ((size_t)b * SEQL + pos) * NINP + C_KB + h * 64 + 32 * part;
    float q[32], k[32];
#pragma unroll
    for (int v = 0; v < 4; ++v) { const v4u a = *(const v4u*)(qp + 8 * v), c = *(const v4u*)(kp + 8 * v);
#pragma unroll
        for (int e = 0; e < 4; ++e) { q[8 * v + 2 * e] = bf2f((unsigned short)(a[e] & 0xffffu)); q[8 * v + 2 * e + 1] = bf2f((unsigned short)(a[e] >> 16));
                                      k[8 * v + 2 * e] = bf2f((unsigned short)(c[e] & 0xffffu)); k[8 * v + 2 * e + 1] = bf2f((unsigned short)(c[e] >> 16)); } }
    if (part == 0) {
#pragma unroll
        for (int i = 0; i < 8; ++i) {
            const pg8::f32x2 t2 = ((const pg8::f32x2*)rope)[pos * 8 + i]; const float cs = t2.x, sn = t2.y;
            const float q1 = q[i], q2 = q[i + 8], k1 = k[i], k2 = k[i + 8];
            q[i] = q1 * cs - q2 * sn; q[i + 8] = q2 * cs + q1 * sn; k[i] = k1 * cs - k2 * sn; k[i + 8] = k2 * cs + k1 * sn;
        }
    }
    const float C2 = 0.125f * 1.4426950408889634f;
#pragma unroll
    for (int v = 0; v < 4; ++v) { v4u a, c;
#pragma unroll
        for (int e = 0; e < 4; ++e) { a[e] = pk2(q[8 * v + 2 * e] * C2, q[8 * v + 2 * e + 1] * C2); c[e] = pk2(k[8 * v + 2 * e], k[8 * v + 2 * e + 1]); }
        *(v4u*)(qp + 8 * v) = a; *(v4u*)(kp + 8 * v) = c; }
#pragma unroll
    for (int i = 0; i < 32; ++i) tile[r * 65 + 32 * part + i] = k[i];
    __syncthreads();
    { const int d = tid & 63, seg = tid >> 6; float s = 0.f;
#pragma unroll 8
      for (int rr = 0; rr < 32; ++rr) s += tile[(seg * 32 + rr) * 65 + d];
      psum[seg * 64 + d] = s; }
    __syncthreads();
    if (tid < 64) { float s = 0.f;
#pragma unroll
        for (int w = 0; w < 8; ++w) s += psum[w * 64 + tid];
        const float mv = s * (1.0f / 256.0f); const unsigned hb = pk2(mv, 0.f) & 0xffffu; const float hf = __uint_as_float(hb << 16);
        bf16* kmh = (bf16*)kmean; const size_t ix = ((size_t)(b * 8 + h) * 16 + j) * 64 + tid;
        kmh[ix] = (bf16)hb; kmh[ix + 65536] = (bf16)pk2(mv - hf, 0.f); }
    __syncthreads();
}

constexpr int GSC_OFF = 98304;
__device__ __forceinline__ void moba_select(int b, int h, int qb, const bf16* proj, const bf16* kmh_bh, unsigned char* lds) {
    const int tid = opaque_tid(), lane = tid & 63, wid = tid >> 6, g = lane >> 4, ln = lane & 15;
    const bf16* qp = proj + ((size_t)b * SEQL + qb * 256 + wid * 32 + ln) * NINP + C_QB + h * 64 + 8 * g;
    bf16x8 fa[2][2], fh[2], fl[2];
#pragma unroll
    for (int mt = 0; mt < 2; ++mt)
#pragma unroll
        for (int kk = 0; kk < 2; ++kk) fa[mt][kk] = *(const bf16x8*)(qp + (size_t)mt * 16 * NINP + 32 * kk);
#pragma unroll
    for (int kk = 0; kk < 2; ++kk) { fh[kk] = *(const bf16x8*)(kmh_bh + ln * 64 + 32 * kk + 8 * g); fl[kk] = *(const bf16x8*)(kmh_bh + 65536 + ln * 64 + 32 * kk + 8 * g); }
    float* gsc = (float*)(lds + GSC_OFF) + wid * (32 * 17);
#pragma unroll
    for (int mt = 0; mt < 2; ++mt) {
        f32x4 a = (f32x4){0.f, 0.f, 0.f, 0.f};
#pragma unroll
        for (int kk = 0; kk < 2; ++kk) { a = mfma16(fa[mt][kk], fl[kk], a); a = mfma16(fa[mt][kk], fh[kk], a); }
#pragma unroll
        for (int j = 0; j < 4; ++j) gsc[(16 * mt + 4 * g + j) * 17 + ln] = a[j];
    }
    asm volatile("s_waitcnt lgkmcnt(0)" ::: "memory");
    if (lane < 32) {
        float gate[16];
#pragma unroll
        for (int j = 0; j < 16; ++j) gate[j] = gsc[lane * 17 + j];
        unsigned selmask = 0u;
#pragma unroll
        for (int rk = 0; rk < 3; ++rk) { float best = -INFINITY; int bi = -1;
#pragma unroll
            for (int j = 0; j < 16; ++j) { const bool ok = (j < qb) && !((selmask >> j) & 1u) && (gate[j] > best); if (ok) { best = gate[j]; bi = j; } }
            if (bi >= 0) selmask |= (1u << bi); }
        ((unsigned*)(lds + attn_body::SEL_OFF))[wid * 32 + lane] = selmask;
    }
}
namespace gdn {
constexpr int LQD = 0, LQN = 17408, LKN = 34816, LVBT = 52224, LKBG = 70656, LKDT = 89088, LAF = 107520, LTINV = 124928, LATT = 134144, LGATE = 143360, LSLOT5 = 144384;
constexpr int SLOT0 = LQN, SLOT1 = LQN + 9216, SLOT2 = LQN + 18432;
constexpr int SQ = 136, ST = 72, SA = 68;
__device__ __forceinline__ bf16x8 ld16(const unsigned char* p) { return *(const bf16x8*)p; }

__device__ __forceinline__ void prep_load(v4u (&X)[3][4][2], float& al, float& bl, const bf16* proj, int it, int tid) {
    const int n = it & 63, h = (it >> 6) & 3, b = it >> 8; const int t0 = n * 64; const size_t rowb = (size_t)b * SEQL;
    const int r = tid >> 3, part = tid & 7;
#pragma unroll
    for (int sec = 0; sec < 3; ++sec)
#pragma unroll
        for (int off = 0; off < 4; ++off) {
            const int t = t0 + r - 3 + off; const int tc = t < 0 ? 0 : t;
            const bf16* xp = proj + (rowb + tc) * NINP + sec * 512 + h * 128 + part * 16;
            X[sec][off][0] = *(const v4u*)xp; X[sec][off][1] = *(const v4u*)(xp + 8);
        }
    const bf16* pr = proj + (rowb + t0 + (tid & 63)) * NINP;
    al = bf2f(pr[C_AL + h]); bl = bf2f(pr[C_BL + h]);
}
__device__ __forceinline__ void prep_item(v4u (&X)[3][4][2], float& al_in, float& bl_in, int nit, const float (&wreg)[3], const bf16* proj, unsigned char* rec, float* glast_out, float a_log_h, float dt_bias_h, int b, int h, int n, unsigned char* lds) {
    const int tid = opaque_tid(), lane = tid & 63, wid = tid >> 6, g = lane >> 4, ln = lane & 15;
    bf16* Qn = (bf16*)(lds + LQN); bf16* Qd = (bf16*)(lds + LQD); bf16* Kn = (bf16*)(lds + LKN);
    bf16* VbT = (bf16*)(lds + LVBT); bf16* KbgT = (bf16*)(lds + LKBG); bf16* KdT = (bf16*)(lds + LKDT);
    float* Af = (float*)(lds + LAF); bf16* Wl = (bf16*)(lds + LAF); bf16* Tinv = (bf16*)(lds + SLOT0);     bf16* Att = (bf16*)(lds + LATT);
    float* gcum = (float*)(lds + LGATE); float* beta = gcum + 64; float* expg = gcum + 128; float* kdf = gcum + 192;
    const int t0 = n * 64; const size_t rowb = (size_t)b * SEQL;
    {
        float* wl = (float*)(lds + LAF);
#pragma unroll
        for (int k = 0; k < 3; ++k) wl[tid + 512 * k] = wreg[k];
    }
    if (wid == 0) {
        const float al = al_in, bl = bl_in;
        const float xx = al + dt_bias_h; const float sp = (xx > 20.f) ? xx : __logf(1.0f + __expf(xx));
        float gv = -__expf(a_log_h) * sp;
#pragma unroll
        for (int o = 1; o < 64; o <<= 1) { const float t = __shfl_up(gv, o); if (lane >= o) gv += t; }
        const float gl = __shfl(gv, 63);
        gcum[lane] = gv; beta[lane] = 1.0f / (1.0f + __expf(-bl)); expg[lane] = __expf(gv); kdf[lane] = __expf(gl - gv);
        if (lane == 0) *glast_out = gl;
    }
    __syncthreads();
    for (int rpa_ = 0; rpa_ < ((PROBE_MASK & 1024) ? 2 : 1); ++rpa_)
    {
        const int r = tid >> 3, part = tid & 7;
        if (n == 0 && r < 3) {
#pragma unroll
            for (int sec = 0; sec < 3; ++sec)
#pragma unroll
                for (int off = 0; off < 3; ++off) if (r - 3 + off < 0) { X[sec][off][0] = (v4u){0u, 0u, 0u, 0u}; X[sec][off][1] = X[sec][off][0]; }
        }
        const float be = beta[r], eg = expg[r], kd = kdf[r];
#pragma unroll
        for (int sec = 0; sec < 3; ++sec) {
            float y[16];
#pragma unroll
            for (int i = 0; i < 16; ++i) y[i] = 0.f;
#pragma unroll
            for (int off = 0; off < 4; ++off) {
                const v4u x0 = X[sec][off][0], x1 = X[sec][off][1];
                const float* wp = (const float*)(lds + LAF) + (sec * 4 + off) * 128 + part * 16;
#pragma unroll
                for (int v = 0; v < 4; ++v) { const f32x4 w4 = *(const f32x4*)(wp + 4 * v);
                    const unsigned ua = (v < 2) ? x0[2 * v] : x1[2 * v - 4], ub = (v < 2) ? x0[2 * v + 1] : x1[2 * v - 3];
                    y[4 * v + 0] += w4[0] * bf2f((unsigned short)(ua & 0xffffu)); y[4 * v + 1] += w4[1] * bf2f((unsigned short)(ua >> 16));
                    y[4 * v + 2] += w4[2] * bf2f((unsigned short)(ub & 0xffffu)); y[4 * v + 3] += w4[3] * bf2f((unsigned short)(ub >> 16)); }
            }
            float ssq = 0.f;
#pragma unroll
            for (int i = 0; i < 16; ++i) { y[i] = y[i] * __builtin_amdgcn_rcpf(1.0f + __expf(-y[i])); ssq += y[i] * y[i]; }
            if (sec < 2) { ssq += __shfl_xor(ssq, 1); ssq += __shfl_xor(ssq, 2); ssq += __shfl_xor(ssq, 4); }
            const float rs = rsqrtf(ssq + NORM_EPS);
            if (sec == 0) {
                const float sc = rs * 0.08838834764831845f;
                v4u a0, a1, d0, d1;
#pragma unroll
                for (int e = 0; e < 4; ++e) { a0[e] = pk2(y[2 * e] * sc, y[2 * e + 1] * sc); a1[e] = pk2(y[8 + 2 * e] * sc, y[9 + 2 * e] * sc);
                                              d0[e] = pk2(y[2 * e] * sc * eg, y[2 * e + 1] * sc * eg); d1[e] = pk2(y[8 + 2 * e] * sc * eg, y[9 + 2 * e] * sc * eg); }
                *(v4u*)(Qn + r * SQ + part * 16) = a0; *(v4u*)(Qn + r * SQ + part * 16 + 8) = a1;
                *(v4u*)(Qd + r * SQ + part * 16) = d0; *(v4u*)(Qd + r * SQ + part * 16 + 8) = d1;
            } else if (sec == 1) {
                v4u a0, a1;
#pragma unroll
                for (int e = 0; e < 4; ++e) { a0[e] = pk2(y[2 * e] * rs, y[2 * e + 1] * rs); a1[e] = pk2(y[8 + 2 * e] * rs, y[9 + 2 * e] * rs); }
                *(v4u*)(Kn + r * SQ + part * 16) = a0; *(v4u*)(Kn + r * SQ + part * 16 + 8) = a1;
                const int rsw = ((((r >> 3) ^ part) & 7) << 3) | (r & 7);
#pragma unroll
                for (int i = 0; i < 16; ++i) { const float kn = y[i] * rs; const int d = part * 16 + i;
                    KbgT[d * ST + rsw] = (bf16)f2bf(kn * be * eg); KdT[d * ST + rsw] = (bf16)f2bf(kn * kd); }
            } else {
                const int rsw = ((((r >> 3) ^ part) & 7) << 3) | (r & 7);
#pragma unroll
                for (int i = 0; i < 16; ++i) VbT[(part * 16 + i) * ST + rsw] = (bf16)f2bf(y[i] * be);
            }
        }
    }
    prep_load(X, al_in, bl_in, proj, nit, tid);
    __syncthreads();
    {
        const int Ti = wid >> 1;
        f32x4 aK[2], aQ[2];
#pragma unroll
        for (int tt = 0; tt < 2; ++tt) {
            const int Tj = 2 * (wid & 1) + tt;
            aK[tt] = (f32x4){0.f, 0.f, 0.f, 0.f}; aQ[tt] = aK[tt];
            if (Tj <= Ti) {
#pragma unroll
                for (int kk = 0; kk < 4; ++kk) {
                    const bf16x8 fk = ld16((const unsigned char*)(Kn + (16 * Ti + ln) * SQ + 32 * kk + 8 * g));
                    const bf16x8 fq = ld16((const unsigned char*)(Qn + (16 * Ti + ln) * SQ + 32 * kk + 8 * g));
                    const bf16x8 fb = ld16((const unsigned char*)(Kn + (16 * Tj + ln) * SQ + 32 * kk + 8 * g));
                    aK[tt] = mfma16(fk, fb, aK[tt]); aQ[tt] = mfma16(fq, fb, aQ[tt]);
                }
            }
        }
        __syncthreads();
        bf16* Prow[2] = {(bf16*)(lds + SLOT0), (bf16*)(lds + SLOT2)}; bf16* Ptr[2] = {(bf16*)(lds + SLOT1), (bf16*)(lds + LAF)};
        bf16* Rtr[2] = {(bf16*)(lds + LSLOT5), (bf16*)(lds + LTINV)};
        f32x4 racc[2];
#pragma unroll
        for (int tt = 0; tt < 2; ++tt) {
            const int Tj = 2 * (wid & 1) + tt; const int jj = 16 * Tj + ln; const float gj = gcum[jj];
            f32x4 nv4;
#pragma unroll
            for (int j = 0; j < 4; ++j) { const int i = 16 * Ti + 4 * g + j; const float dcy = __expf(fminf(gcum[i] - gj, 0.f));
                const float nv = (i > jj) ? -(beta[i] * aK[tt][j] * dcy) : 0.f;
                Att[i * ST + jj] = (bf16)f2bf((i >= jj) ? aQ[tt][j] * dcy : 0.f);
                racc[tt][j] = nv + ((i == jj) ? 1.f : 0.f); nv4[j] = nv; }
            const unsigned w0 = pk2(nv4[0], nv4[1]), w1 = pk2(nv4[2], nv4[3]);
            Prow[0][(16 * Ti + 4 * g + 0) * ST + jj] = (bf16)(w0 & 0xffffu); Prow[0][(16 * Ti + 4 * g + 1) * ST + jj] = (bf16)(w0 >> 16);
            Prow[0][(16 * Ti + 4 * g + 2) * ST + jj] = (bf16)(w1 & 0xffffu); Prow[0][(16 * Ti + 4 * g + 3) * ST + jj] = (bf16)(w1 >> 16);
            v2u tw; tw[0] = w0; tw[1] = w1; *(v2u*)(Ptr[0] + jj * ST + 16 * Ti + 4 * g) = tw;
            v2u rw; rw[0] = pk2(racc[tt][0], racc[tt][1]); rw[1] = pk2(racc[tt][2], racc[tt][3]); *(v2u*)(Rtr[0] + jj * ST + 16 * Ti + 4 * g) = rw;
        }
        __syncthreads();
#pragma unroll
        for (int k = 1; k <= 6; ++k) {
            const int pb = (k - 1) & 1, pdst = k & 1;
            const int rb = (k & 1), rdst = (k + 1) & 1;
            const int rsrc = (k <= 2) ? 0 : rb;
            const int rwr = (k <= 2) ? 1 : rdst;
            bf16x8 fa[2];
#pragma unroll
            for (int kk = 0; kk < 2; ++kk) fa[kk] = ld16((const unsigned char*)(Prow[pb] + (16 * Ti + ln) * ST + 32 * kk + 8 * g));
#pragma unroll
            for (int tt = 0; tt < 2; ++tt) {
                const int Tj = 2 * (wid & 1) + tt; const int jj = 16 * Tj + ln;
                if (k <= 5) {
                    f32x4 a = (f32x4){0.f, 0.f, 0.f, 0.f};
#pragma unroll
                    for (int kk = 0; kk < 2; ++kk) a = mfma16(fa[kk], ld16((const unsigned char*)(Ptr[pb] + (16 * Tj + ln) * ST + 32 * kk + 8 * g)), a);
                    const unsigned w0 = pk2(a[0], a[1]), w1 = pk2(a[2], a[3]);
                    Prow[pdst][(16 * Ti + 4 * g + 0) * ST + jj] = (bf16)(w0 & 0xffffu); Prow[pdst][(16 * Ti + 4 * g + 1) * ST + jj] = (bf16)(w0 >> 16);
                    Prow[pdst][(16 * Ti + 4 * g + 2) * ST + jj] = (bf16)(w1 & 0xffffu); Prow[pdst][(16 * Ti + 4 * g + 3) * ST + jj] = (bf16)(w1 >> 16);
                    v2u tw; tw[0] = w0; tw[1] = w1; *(v2u*)(Ptr[pdst] + jj * ST + 16 * Ti + 4 * g) = tw;
                }
                if (k >= 2) {
                    f32x4 a = racc[tt];
#pragma unroll
                    for (int kk = 0; kk < 2; ++kk) a = mfma16(fa[kk], ld16((const unsigned char*)(Rtr[rsrc] + (16 * Tj + ln) * ST + 32 * kk + 8 * g)), a);
                    racc[tt] = a;
                    const unsigned w0 = pk2(a[0], a[1]), w1 = pk2(a[2], a[3]);
                    if (k < 6) { v2u rw; rw[0] = w0; rw[1] = w1; *(v2u*)(Rtr[rwr] + jj * ST + 16 * Ti + 4 * g) = rw; }
                    else { bf16* Rf = Prow[0];
                        Rf[(16 * Ti + 4 * g + 0) * ST + jj] = (bf16)(w0 & 0xffffu); Rf[(16 * Ti + 4 * g + 1) * ST + jj] = (bf16)(w0 >> 16);
                        Rf[(16 * Ti + 4 * g + 2) * ST + jj] = (bf16)(w1 & 0xffffu); Rf[(16 * Ti + 4 * g + 3) * ST + jj] = (bf16)(w1 >> 16); }
                }
            }
            __syncthreads();
        }
    }
    for (int rpe_ = 0; rpe_ < ((PROBE_MASK & 2048) ? 2 : 1); ++rpe_) {
    {
        f32x4 aU[4], aW[4];
#pragma unroll
        for (int T = 0; T < 4; ++T) { aU[T] = (f32x4){0.f, 0.f, 0.f, 0.f}; aW[T] = aU[T]; }
#pragma unroll
        for (int kk = 0; kk < 2; ++kk) {
            const bf16x8 bU = ld16((const unsigned char*)(VbT + (16 * wid + ln) * ST + (((4 * kk + g) ^ wid) & 7) * 8));
            const bf16x8 bW = ld16((const unsigned char*)(KbgT + (16 * wid + ln) * ST + (((4 * kk + g) ^ wid) & 7) * 8));
#pragma unroll
            for (int T = 0; T < 4; ++T) { const bf16x8 a = ld16((const unsigned char*)(Tinv + (16 * T + ln) * ST + 32 * kk + 8 * g)); aU[T] = mfma16(a, bU, aU[T]); aW[T] = mfma16(a, bW, aW[T]); }
        }
        v4u u0, u1;
        u0[0] = pk2(aU[0][0], aU[0][1]); u0[1] = pk2(aU[0][2], aU[0][3]); u0[2] = pk2(aU[1][0], aU[1][1]); u0[3] = pk2(aU[1][2], aU[1][3]);
        u1[0] = pk2(aU[2][0], aU[2][1]); u1[1] = pk2(aU[2][2], aU[2][3]); u1[2] = pk2(aU[3][0], aU[3][1]); u1[3] = pk2(aU[3][2], aU[3][3]);
        *(v4u*)(rec + (wid * 64 + lane) * 32) = u0; *(v4u*)(rec + (wid * 64 + lane) * 32 + 16) = u1;
#pragma unroll
        for (int T = 0; T < 4; ++T)
#pragma unroll
            for (int j = 0; j < 4; ++j) Wl[(16 * T + 4 * g + j) * SQ + 16 * wid + ln] = (bf16)f2bf(aW[T][j]);
    }
    __syncthreads();
#pragma unroll
    for (int it = 0; it < 7; ++it) {
        const int p = tid + 512 * it;
        const bf16* src; int stride, T, kk, idx; int dst;
        if (p < 1024) { idx = p; src = Wl; stride = SQ; T = idx >> 8; kk = (idx >> 6) & 3; dst = 16384 + idx * 16; }
        else if (p < 2048) { idx = p - 1024; src = Qd; stride = SQ; T = idx >> 8; kk = (idx >> 6) & 3; dst = 32768 + idx * 16; }
        else if (p < 2560) { idx = p - 2048; src = Att; stride = ST; T = idx >> 7; kk = (idx >> 6) & 1; dst = 49152 + idx * 16; }
        else { idx = p - 2560; src = KdT; stride = ST; T = idx >> 7; kk = (idx >> 6) & 1; dst = 57344 + idx * 16; }
        const int l = idx & 63, gg = l >> 4, m = l & 15;
        const int sw = (p >= 2560) ? (T & 7) : 0;
        const bf16* sp = src + (16 * T + m) * stride + 4 * (gg & 1);
        const v2u lo = *(const v2u*)(sp + (((4 * kk + (gg >> 1)) ^ sw) << 3)), hi = *(const v2u*)(sp + (((4 * kk + 2 + (gg >> 1)) ^ sw) << 3));
        v4u o; o[0] = lo[0]; o[1] = lo[1]; o[2] = hi[0]; o[3] = hi[1];
        *(v4u*)(rec + dst) = o;
    }
    __syncthreads();
    }
}

constexpr int SZ = 272;
__device__ __forceinline__ bf16x8 packS(const f32x4& a, const f32x4& b) {
    v4u r; r[0] = pg8::cvt_pk_bf16(a[0], a[1]); r[1] = pg8::cvt_pk_bf16(a[2], a[3]); r[2] = pg8::cvt_pk_bf16(b[0], b[1]); r[3] = pg8::cvt_pk_bf16(b[2], b[3]);
    return __builtin_bit_cast(bf16x8, r);
}
__device__ __forceinline__ float row16_sum(float v) {
    v += __builtin_bit_cast(float, __builtin_amdgcn_update_dpp(0, __builtin_bit_cast(int, v), 0x128, 0xf, 0xf, false));
    v += __builtin_bit_cast(float, __builtin_amdgcn_update_dpp(0, __builtin_bit_cast(int, v), 0x124, 0xf, 0xf, false));
    v += __builtin_bit_cast(float, __builtin_amdgcn_update_dpp(0, __builtin_bit_cast(int, v), 0x122, 0xf, 0xf, false));
    v += __builtin_bit_cast(float, __builtin_amdgcn_update_dpp(0, __builtin_bit_cast(int, v), 0x121, 0xf, 0xf, false));
    return v;
}
constexpr int SB2 = 32768;
__device__ __forceinline__ void scan_bh(int bh, unsigned char* gdnbase, const float* glast, unsigned char* lds) {
    const int tid = opaque_tid(), lane = tid & 63, wid = tid >> 6;
    f32x4 S[8];
#pragma unroll
    for (int T = 0; T < 8; ++T) S[T] = (f32x4){0.f, 0.f, 0.f, 0.f};
    unsigned char* rec0 = gdnbase + (size_t)bh * 64 * CHUNK_REC;
    v4u st[4];
#pragma unroll
    for (int i = 0; i < 2; ++i) { st[i] = *(const v4u*)(rec0 + 16384 + (size_t)(tid + 512 * i) * 16); st[2 + i] = *(const v4u*)(rec0 + 57344 + (size_t)(tid + 512 * i) * 16); }
    v4u u0 = *(const v4u*)(rec0 + (wid * 64 + lane) * 32), u1 = *(const v4u*)(rec0 + (wid * 64 + lane) * 32 + 16);
    float gl = glast[bh * 64];
#pragma unroll
    for (int i = 0; i < 2; ++i) { *(v4u*)(lds + (tid + 512 * i) * 16) = st[i]; *(v4u*)(lds + 16384 + (tid + 512 * i) * 16) = st[2 + i]; }
    __syncthreads();
    for (int c = 0; c < 64; ++c) {
        unsigned char* buf = lds + (c & 1) * SB2;
        unsigned char* obuf = lds + ((c + 1) & 1) * SB2;
        const int cn = (c + 1 < 64) ? c + 1 : 63;
        unsigned char* rec = rec0 + (size_t)c * CHUNK_REC;
        const unsigned char* recn = rec0 + (size_t)cn * CHUNK_REC;
        const float gln = glast[bh * 64 + cn];
#pragma unroll
        for (int i = 0; i < 2; ++i) { st[i] = *(const v4u*)(recn + 16384 + (size_t)(tid + 512 * i) * 16); st[2 + i] = *(const v4u*)(recn + 57344 + (size_t)(tid + 512 * i) * 16); }
        const v4u un0 = *(const v4u*)(recn + (wid * 64 + lane) * 32), un1 = *(const v4u*)(recn + (wid * 64 + lane) * 32 + 16);
        const float dec = __expf(gl);
        bf16x8 bS[4];
#pragma unroll
        for (int kk = 0; kk < 4; ++kk) { bS[kk] = packS(S[2 * kk], S[2 * kk + 1]); *(bf16x8*)(rec + ((wid * 4 + kk) * 64 + lane) * 16) = bS[kk]; }
        f32x4 Vn[4];
#pragma unroll
        for (int T = 0; T < 4; ++T) {
            f32x4 p = (f32x4){0.f, 0.f, 0.f, 0.f};
#pragma unroll
            for (int kk = 0; kk < 4; ++kk) p = mfma16(ld16(buf + ((T * 4 + kk) * 64 + lane) * 16), bS[kk], p);
            const unsigned ua = (T < 2) ? u0[2 * T] : u1[2 * T - 4], ub = (T < 2) ? u0[2 * T + 1] : u1[2 * T - 3];
            Vn[T][0] = __uint_as_float(ua << 16) - p[0]; Vn[T][1] = __uint_as_float(ua & 0xffff0000u) - p[1];
            Vn[T][2] = __uint_as_float(ub << 16) - p[2]; Vn[T][3] = __uint_as_float(ub & 0xffff0000u) - p[3];
        }
        bf16x8 bV[2];
        bV[0] = packS(Vn[0], Vn[1]); bV[1] = packS(Vn[2], Vn[3]);
        *(bf16x8*)(rec + 57344 + ((wid * 2 + 0) * 64 + lane) * 16) = bV[0]; *(bf16x8*)(rec + 57344 + ((wid * 2 + 1) * 64 + lane) * 16) = bV[1];
#pragma unroll
        for (int T = 0; T < 8; ++T) {
            f32x4 a = S[T] * dec;
#pragma unroll
            for (int kk = 0; kk < 2; ++kk) a = mfma16(ld16(buf + 16384 + ((T * 2 + kk) * 64 + lane) * 16), bV[kk], a);
            S[T] = a;
        }
#pragma unroll
        for (int i = 0; i < 2; ++i) { *(v4u*)(obuf + (tid + 512 * i) * 16) = st[i]; *(v4u*)(obuf + 16384 + (tid + 512 * i) * 16) = st[2 + i]; }
        asm volatile("s_waitcnt vmcnt(0)" ::: "memory");
        __syncthreads();
        u0 = un0; u1 = un1; gl = gln;
    }
}
constexpr int OQ = 0, OAT = 16384, OZ = 24576, ORED = OZ + 64 * SZ;
struct OutRegs { v4u q0, q1, a0, z0, z1; bf16x8 bS[4], bV[2]; };
__device__ __forceinline__ void out_load(OutRegs& R, int it, const unsigned char* gdnbase, const bf16* proj, int tid) {
    const int lane = tid & 63, wid = tid >> 6; const int n = it & 63, h = (it >> 6) & 3, b = it >> 8;
    const unsigned char* rec = gdnbase + (size_t)it * CHUNK_REC; const size_t tokb = (size_t)b * SEQL + n * 64; const int zr0 = tid >> 4, zs = tid & 15;
    R.q0 = *(const v4u*)(rec + 32768 + (size_t)tid * 16); R.q1 = *(const v4u*)(rec + 32768 + (size_t)(tid + 512) * 16); R.a0 = *(const v4u*)(rec + 49152 + (size_t)tid * 16);
    const bf16* zp = proj + (tokb + zr0) * NINP + C_Z + h * 128 + zs * 8;
    R.z0 = *(const v4u*)zp; R.z1 = *(const v4u*)(zp + (size_t)32 * NINP);
#pragma unroll
    for (int kk = 0; kk < 4; ++kk) R.bS[kk] = *(const bf16x8*)(rec + ((wid * 4 + kk) * 64 + lane) * 16);
#pragma unroll
    for (int kk = 0; kk < 2; ++kk) R.bV[kk] = *(const bf16x8*)(rec + 57344 + ((wid * 2 + kk) * 64 + lane) * 16);
}
__device__ __forceinline__ void out_phase(const unsigned char* gdnbase, const bf16* proj, bf16* concat, const float* normg, int G, unsigned char* lds) {
    const int tid = opaque_tid(), lane = tid & 63, wid = tid >> 6, g = lane >> 4, ln = lane & 15;
    const int zr0 = tid >> 4, zs = tid & 15;
    const float ng = normg[16 * wid + ln];
    if ((int)blockIdx.x >= 2048) return;
    OutRegs R; out_load(R, (int)blockIdx.x, gdnbase, proj, tid);
    for (int it = blockIdx.x; it < 2048; it += G) {
        const int n = it & 63, h = (it >> 6) & 3, b = it >> 8;
        const size_t tokb = (size_t)b * SEQL + n * 64;
        *(v4u*)(lds + OQ + tid * 16) = R.q0; *(v4u*)(lds + OQ + (tid + 512) * 16) = R.q1; *(v4u*)(lds + OAT + tid * 16) = R.a0;
        *(v4u*)(lds + OZ + zr0 * SZ + zs * 16) = R.z0; *(v4u*)(lds + OZ + (zr0 + 32) * SZ + zs * 16) = R.z1;
        bf16x8 bS[4], bV[2];
#pragma unroll
        for (int kk = 0; kk < 4; ++kk) bS[kk] = R.bS[kk];
#pragma unroll
        for (int kk = 0; kk < 2; ++kk) bV[kk] = R.bV[kk];
        __syncthreads();
        out_load(R, (it + G < 2048) ? it + G : it, gdnbase, proj, tid);
        f32x4 O[4];
#pragma unroll
        for (int T = 0; T < 4; ++T) {
            f32x4 a = (f32x4){0.f, 0.f, 0.f, 0.f};
#pragma unroll
            for (int kk = 0; kk < 4; ++kk) a = mfma16(ld16(lds + OQ + ((T * 4 + kk) * 64 + lane) * 16), bS[kk], a);
#pragma unroll
            for (int kk = 0; kk < 2; ++kk) a = mfma16(ld16(lds + OAT + ((T * 2 + kk) * 64 + lane) * 16), bV[kk], a);
            O[T] = a;
        }
        float* red = (float*)(lds + ORED);
#pragma unroll
        for (int T = 0; T < 4; ++T)
#pragma unroll
            for (int j = 0; j < 4; ++j) { const float s = row16_sum(O[T][j] * O[T][j]); if (ln == 0) red[(16 * T + 4 * g + j) * 8 + wid] = s; }
        __syncthreads();
        bf16* zt = (bf16*)(lds + OZ);
#pragma unroll
        for (int T = 0; T < 4; ++T)
#pragma unroll
            for (int j = 0; j < 4; ++j) { const int row = 16 * T + 4 * g + j;
                const f32x4 r0 = *(const f32x4*)(red + row * 8), r1 = *(const f32x4*)(red + row * 8 + 4);
                const float tot = ((r0[0] + r0[1]) + (r0[2] + r0[3])) + ((r1[0] + r1[1]) + (r1[2] + r1[3]));
                const float rstd = rsqrtf(tot * (1.0f / 128.0f) + NORM_EPS);
                bf16* zp = zt + row * (SZ / 2) + 16 * wid + ln;
                const float z = bf2f(*zp);
                const float val = O[T][j] * rstd * ng * z * __builtin_amdgcn_rcpf(1.0f + __expf(-z));
                *zp = (bf16)f2bf(val); }
        __syncthreads();
        {
            const v4u o0 = *(const v4u*)(lds + OZ + zr0 * SZ + zs * 16), o1 = *(const v4u*)(lds + OZ + (zr0 + 32) * SZ + zs * 16);
            bf16* od = concat + (tokb + zr0) * DMODEL + h * 128 + zs * 8;
            *(v4u*)od = o0; *(v4u*)(od + (size_t)32 * DMODEL) = o1;
        }
        __syncthreads();
    }
}
}
#define GAS __attribute__((address_space(1)))
#define LAS __attribute__((address_space(3)))
typedef unsigned short bf16;
typedef unsigned v4u __attribute__((ext_vector_type(4)));
typedef float f32x4 __attribute__((ext_vector_type(4)));
typedef short bf16x8 __attribute__((ext_vector_type(8)));
typedef GAS unsigned gu32;
typedef GAS unsigned long long gu64;
#define RLX_AGENT __ATOMIC_RELAXED, __HIP_MEMORY_SCOPE_AGENT
#define LDS_WAIT() asm volatile("s_waitcnt lgkmcnt(0)" ::: "memory")
#define VM_WAIT() asm volatile("s_waitcnt vmcnt(0)" ::: "memory")
__device__ __forceinline__ unsigned long long rt() { return __builtin_amdgcn_s_memrealtime(); }
#define XB_TMO      128
#define XB_XCNT(j)  (256  + 64 * (j))
#define XB_XSUB(j)  (1280 + 64 * (j))
#define XB_XGEN(j)  (2304 + 64 * (j))
#define XB_TOP      3328
#define XB_TOPGEN   3392
#define XCD_BAR_WORDS 3456
#define XB_SPIN_CAP (1u << 18)

__device__ __forceinline__ unsigned xb_ld(unsigned* p)              { return __hip_atomic_load(p, __ATOMIC_RELAXED, __HIP_MEMORY_SCOPE_AGENT); }
__device__ __forceinline__ unsigned xb_add(unsigned* p, unsigned v) { return __hip_atomic_fetch_add(p, v, __ATOMIC_RELAXED, __HIP_MEMORY_SCOPE_AGENT); }
__device__ __forceinline__ unsigned xb_xcc_id() { return (unsigned)__builtin_amdgcn_s_getreg((3 << 11) | 20) & 0xFu; }
#define XB_SPIN(cond, bar) do { unsigned _sp = 0; while (cond) { __builtin_amdgcn_s_sleep(1); \
    if ((++_sp & 255u) == 0u) { if (xb_ld(&(bar)[XB_TMO])) break; if (_sp > XB_SPIN_CAP) { atomicAdd(&(bar)[XB_TMO], 1u); break; } } } } while (0)

struct XcdBarrier {
    unsigned* bar; unsigned x;
    volatile LAS unsigned* st;
};

__device__ __forceinline__ XcdBarrier xcd_barrier_post(unsigned* bar, volatile LAS unsigned* st) {
    XcdBarrier b; b.bar = bar; b.x = xb_xcc_id(); b.st = st;
    if (threadIdx.x == 0) (void)xb_add(&bar[XB_XCNT(b.x)], 1u);
    return b;
}
__device__ __forceinline__ void xcd_barrier_complete(unsigned* bar, unsigned x, unsigned& nloc, unsigned& nx) {
    const unsigned G = gridDim.x * gridDim.y * gridDim.z;
    unsigned sum, cnt, mine, sp = 0u;
    for (;;) {
        sum = 0u; cnt = 0u; mine = 0u;
#pragma unroll
        for (unsigned j = 0; j < 16; ++j) { const unsigned c = xb_ld(&bar[XB_XCNT(j)]); sum += c; cnt += (c > 0u) ? 1u : 0u; mine = (j == x) ? c : mine; }
        if (sum == G) break;
        __builtin_amdgcn_s_sleep(1);
        if ((++sp & 255u) == 0u) { if (xb_ld(&bar[XB_TMO])) break; if (sp > XB_SPIN_CAP) { atomicAdd(&bar[XB_TMO], 1u); break; } }
    }
    nloc = mine > 0u ? mine : 1u; nx = cnt > 0u ? cnt : 1u;
}

__device__ __forceinline__ void xcd_barrier(const XcdBarrier& b) {
    asm volatile("s_waitcnt vmcnt(0)" ::: "memory");
    __syncthreads();
    if (threadIdx.x == 0) {
        unsigned* bar = b.bar;
        __builtin_amdgcn_s_waitcnt(0);
        unsigned nloc = b.st[0], nx = b.st[1];
        if (nloc == 0u) { xcd_barrier_complete(bar, b.x, nloc, nx); b.st[0] = nloc; b.st[1] = nx; }
        const unsigned old = xb_add(&bar[XB_XSUB(b.x)], 1u);
        const unsigned gen = old / nloc;
        if (old + 1u == (gen + 1u) * nloc) {
            __builtin_amdgcn_fence(__ATOMIC_RELEASE, "agent");
            asm volatile("s_waitcnt vmcnt(0)" ::: "memory");
            const unsigned og = xb_add(&bar[XB_TOP], 1u);
            const unsigned tg = og / nx;
            if (og + 1u == (tg + 1u) * nx) xb_add(&bar[XB_TOPGEN], 1u);
            else XB_SPIN(xb_ld(&bar[XB_TOPGEN]) == tg, bar);
            __builtin_amdgcn_fence(__ATOMIC_ACQUIRE, "agent");
            xb_add(&bar[XB_XGEN(b.x)], 1u);
            asm volatile("s_waitcnt vmcnt(0)" ::: "memory");
        } else {
            XB_SPIN(xb_ld(&bar[XB_XGEN(b.x)]) == gen, bar);
            __builtin_amdgcn_fence(__ATOMIC_ACQUIRE, "agent");
            asm volatile("s_waitcnt vmcnt(0)" ::: "memory");
        }
    }
    __syncthreads();
}

constexpr int CW_BAR = 4096, BAR_LDS_OFF = LDS_BYTES - 64;
struct Args { Ptrs p; int pad0, pad1; };
#define LP() (&args.p)
#define WSP(off) (LP()->ws + (off))
#define GSYNC() xcd_barrier(bar)
template <int l> __device__ __forceinline__ void layer_body(const Args& args, const XcdBarrier& bar, unsigned char* lds, PG8_LAS unsigned char* ldsl, const int G) {
        { pg8::Gemm gm{(const bf16*)WSP(WS_XBF), (const bf16*)(WSP(WS_W) + (size_t)l * W_LAYER + W_IN), MTOK, 3584, DMODEL}; pg8::StaticOrder S; S.init(MTOK, 3584, G, (int)blockIdx.x);
          pg8::EpiBf16 E{(bf16*)WSP(WS_PROJ), NINP};
          pg8::gemm_phase<pg8::EpiBf16, pg8::StaticOrder, true, true>(ldsl, gm, S, E);
          if (PROBE_MASK & 1) { __syncthreads(); pg8::gemm_phase<pg8::EpiBf16, pg8::StaticOrder, true, true>(ldsl, gm, S, E); } }
        for (int grp = blockIdx.x; grp < MTOK / 128; grp += G) logits_group(grp, (const bf16*)WSP(WS_XBF), (const bf16*)(WSP(WS_W) + (size_t)l * W_LAYER + W_IN), (bf16*)WSP(WS_PROJ));
        GSYNC();
        if (blockIdx.x == 0 && threadIdx.x == 0) { ((unsigned*)WSP(WS_CTL))[64 + l] = 0u; ((unsigned*)WSP(WS_CTL))[80 + l] = 0u; }
        for (int rep_ = 0; rep_ < ((PROBE_MASK & 2) ? 2 : 1); ++rep_)
        if ((int)blockIdx.x < 2048) {
            const Ptrs* pp = LP(); const bf16* projc = (const bf16*)(pp->ws + WS_PROJ);
            const int tid_ = opaque_tid(); const int h0 = ((int)blockIdx.x >> 6) & 3;
            float wreg[3];
#pragma unroll
            for (int k = 0; k < 3; ++k) { const int idx = tid_ + 512 * k, sec = idx >> 9, off = (idx >> 7) & 3, ch = idx & 127; wreg[k] = pp->conv_w[(size_t)l * 4 * 1536 + off * 1536 + sec * 512 + h0 * 128 + ch]; }
            v4u X[3][4][2]; float alr, blr;
            gdn::prep_load(X, alr, blr, projc, (int)blockIdx.x, tid_);
            for (int it = blockIdx.x; it < 2048; it += G) {
                const int n = it & 63, h = (it >> 6) & 3, b = it >> 8;
                const int nit = (it + G < 2048) ? it + G : it;
                gdn::prep_item(X, alr, blr, nit, wreg, projc, pp->ws + WS_GDN + (size_t)it * CHUNK_REC, (float*)(pp->ws + WS_GLAST) + it, pp->a_log[l * 4 + h], pp->dt_bias[l * 4 + h], b, h, n, lds);
            }
        }
        for (int it = blockIdx.x; it < 1024; it += G) moba_prep_item((bf16*)WSP(WS_PROJ), (float*)WSP(WS_KMEAN), (const float*)WSP(WS_ROPE), it, lds);
        GSYNC();
        for (int rep_ = 0; rep_ < ((PROBE_MASK & (4 | 64 | 128)) ? 2 : 1); ++rep_) {
        if (blockIdx.x < 32 && (rep_ == 0 || (PROBE_MASK & (4 | 64)))) { const Ptrs* pp = LP(); gdn::scan_bh((int)blockIdx.x, pp->ws + WS_GDN, (const float*)(pp->ws + WS_GLAST), lds); }
        {
            volatile unsigned* sh_u = (volatile unsigned*)(lds + 90112);
            if (rep_ == 0 || (PROBE_MASK & (4 | 128))) for (;;) {
                __syncthreads();
                if (threadIdx.x == 0) *sh_u = atomicAdd((unsigned*)WSP(WS_CTL) + 64 + 16 * rep_ + l, 1u);
                __syncthreads();
                const unsigned u = (unsigned)__builtin_amdgcn_readfirstlane((int)*sh_u);
                if (u >= 1024u) break;
                const int qb = 15 - (int)(u >> 6), bh = (int)(u & 63u), b = bh >> 3, h = bh & 7;
                const bf16* proj = (const bf16*)WSP(WS_PROJ);
                moba_select(b, h, qb, proj, (const bf16*)WSP(WS_KMEAN) + (size_t)bh * 16 * 64, lds);
                if (PROBE_MASK & 4096) { __syncthreads(); moba_select(b, h, qb, proj, (const bf16*)WSP(WS_KMEAN) + (size_t)bh * 16 * 64, lds); }
                __syncthreads();
                attn_body::attn_unit<8>(b, h, qb, (const attn_body::bf16*)(proj + C_QB), (const attn_body::bf16*)(proj + C_KB), (const attn_body::bf16*)(proj + C_VB),
                                        (attn_body::bf16*)((bf16*)WSP(WS_XBF) + 512), (char*)lds);
            }
        }
        }
        GSYNC();
        for (int rep_ = 0; rep_ < ((PROBE_MASK & 512) ? 2 : 1); ++rep_)
        { const Ptrs* pp = LP(); gdn::out_phase(pp->ws + WS_GDN, (const bf16*)(pp->ws + WS_PROJ), (bf16*)(pp->ws + WS_XBF), pp->norm_g + l * 128, G, lds); }
        GSYNC();
        { const Ptrs* pp = LP();
          pg8::Gemm gm{(const bf16*)(pp->ws + WS_XBF), (const bf16*)(pp->ws + WS_W + (size_t)l * W_LAYER + W_OUT), MTOK, DMODEL, DMODEL}; pg8::StaticOrder S; S.init(MTOK, DMODEL, G, (int)blockIdx.x);
          typedef pg8::EpiResBf<(l > 0)> EpiD;
          EpiD E{pp->x, (const bf16*)pp->out, (bf16*)(pp->ws + WS_YX), (const float*)(pp->ws + WS_STAT), pp->ln2_g + (l > 0 ? l - 1 : 0) * DMODEL, pp->ln2_b + (l > 0 ? l - 1 : 0) * DMODEL};
          pg8::gemm_phase<EpiD, pg8::StaticOrder, true, true>(ldsl, gm, S, E);
          if (PROBE_MASK & 16) { __syncthreads(); pg8::gemm_phase<EpiD, pg8::StaticOrder, true, true>(ldsl, gm, S, E); } }
        GSYNC();
        { const Ptrs* pp = LP(); ln_phase((const bf16*)(pp->ws + WS_YX), nullptr, (bf16*)(pp->ws + WS_XBF), (float*)(pp->ws + WS_STAT), pp->ln1_g + l * DMODEL, pp->ln1_b + l * DMODEL, G); }
        GSYNC();
        { const Ptrs* pp = LP();
          pg8::Gemm gm{(const bf16*)(pp->ws + WS_XBF), (const bf16*)(pp->ws + WS_W + (size_t)l * W_LAYER + W_UP), MTOK, NUP, DMODEL}; pg8::StaticOrder S; S.init(MTOK, NUP, G, (int)blockIdx.x);
          pg8::EpiUpConv E{(bf16*)(pp->ws + WS_ACT), (float*)(pp->ws + WS_EDGE), pp->fconv_w + (size_t)l * 3 * NUP, pp->fconv_b + (size_t)l * NUP};
          pg8::gemm_phase<pg8::EpiUpConv, pg8::StaticOrder, true, true>(ldsl, gm, S, E);
          if (PROBE_MASK & 8) { __syncthreads(); pg8::gemm_phase<pg8::EpiUpConv, pg8::StaticOrder, true, true>(ldsl, gm, S, E); } }
        GSYNC();
        { const Ptrs* pp = LP(); fix_phase((const float*)(pp->ws + WS_EDGE), (bf16*)(pp->ws + WS_ACT), pp->fconv_w + (size_t)l * 3 * NUP, pp->fconv_b + (size_t)l * NUP, G); }
        GSYNC();
        { const Ptrs* pp = LP();
          pg8::Gemm gm{(const bf16*)(pp->ws + WS_ACT), (const bf16*)(pp->ws + WS_W + (size_t)l * W_LAYER + W_DOWN), MTOK, DMODEL, DFF}; pg8::StaticOrder S; S.init(MTOK, DMODEL, G, (int)blockIdx.x);
          pg8::EpiResBf<true> E{nullptr, (const bf16*)(pp->ws + WS_YX), (l + 1 < NLAYER) ? (bf16*)pp->out : (bf16*)(pp->ws + WS_YX), (const float*)(pp->ws + WS_STAT), pp->ln1_g + l * DMODEL, pp->ln1_b + l * DMODEL};
          pg8::gemm_phase<pg8::EpiResBf<true>, pg8::StaticOrder, true, true>(ldsl, gm, S, E); }
        GSYNC();
        { const Ptrs* pp = LP();
          if (l + 1 < NLAYER) ln_phase((const bf16*)pp->out, nullptr, (bf16*)(pp->ws + WS_XBF), (float*)(pp->ws + WS_STAT), pp->ln2_g + l * DMODEL, pp->ln2_b + l * DMODEL, G);
          else ln_phase((const bf16*)(pp->ws + WS_YX), pp->out, nullptr, nullptr, pp->ln2_g + l * DMODEL, pp->ln2_b + l * DMODEL, G); }
        if (PROBE_MASK & 256) { for (int q_ = 0; q_ < 8; ++q_) GSYNC(); }
        if (l + 1 < NLAYER) GSYNC();
}
__global__ void __launch_bounds__(NTHREADS, 2) hybrid_fwd(Args args) {
    extern __shared__ __attribute__((aligned(16))) unsigned char lds[];
    cg::grid_group grid = cg::this_grid();
    const int G = gridDim.x;
    PG8_LAS unsigned char* ldsl = (PG8_LAS unsigned char*)lds;

    if (threadIdx.x < 16) ((volatile LAS unsigned*)(ldsl + BAR_LDS_OFF))[threadIdx.x] = 0u;
    __syncthreads();
    const XcdBarrier bar = xcd_barrier_post((unsigned*)WSP(WS_CTL) + CW_BAR, (volatile LAS unsigned*)(ldsl + BAR_LDS_OFF));
    { const Ptrs P = *LP(); p0_prologue(P, lds, G); }
    if (args.pad0 != 0) grid.sync();
    xcd_barrier(bar);

    layer_body<0>(args, bar, lds, ldsl, G);
    layer_body<1>(args, bar, lds, ldsl, G);
}

extern "C" void kernel_launch(void* const* d_in, const int* in_sizes, int n_in, void* d_out, int out_size, void* d_ws, size_t ws_size, hipStream_t stream) {
    static int grid = 0;
    if (grid == 0) {
        if (n_in != 15 || ws_size < WS_END) { fprintf(stderr, "kernel_launch: unexpected inputs (n_in %d, ws %zu)\n", n_in, ws_size); grid = -1; return; }
        int dev = 0, cus = 0, per_cu = 0;
        hipGetDevice(&dev); hipDeviceGetAttribute(&cus, hipDeviceAttributeMultiprocessorCount, dev);
        if (hipFuncSetAttribute((const void*)hybrid_fwd, hipFuncAttributeMaxDynamicSharedMemorySize, LDS_BYTES) != hipSuccess) { fprintf(stderr, "kernel_launch: hipFuncSetAttribute failed\n"); grid = -1; return; }
        if (hipOccupancyMaxActiveBlocksPerMultiprocessor(&per_cu, (const void*)hybrid_fwd, NTHREADS, LDS_BYTES) != hipSuccess || per_cu < 1) { fprintf(stderr, "kernel_launch: occupancy query says %d\n", per_cu); per_cu = 1; }
        (void)hipGetLastError();
        grid = 256;
    }
    if (grid < 0) return;
    if (hipMemsetAsync(d_ws, 0, 65536, stream) != hipSuccess) { fprintf(stderr, "kernel_launch: hipMemsetAsync failed\n"); return; }
    Args a{};
    const float* const* in = (const float* const*)d_in;
    a.p.x = in[0]; a.p.w_in = in[1]; a.p.conv_w = in[2]; a.p.a_log = in[3]; a.p.dt_bias = in[4]; a.p.norm_g = in[5]; a.p.w_out = in[6];
    a.p.ln1_g = in[7]; a.p.ln1_b = in[8]; a.p.w_up = in[9]; a.p.fconv_w = in[10]; a.p.fconv_b = in[11]; a.p.w_down = in[12]; a.p.ln2_g = in[13]; a.p.ln2_b = in[14];
    a.p.out = (float*)d_out; a.p.ws = (unsigned char*)d_ws;
    void* kargs[] = {&a};
    hipError_t e = hipLaunchCooperativeKernel((const void*)hybrid_fwd, dim3(grid), dim3(NTHREADS), kargs, LDS_BYTES, stream);
    if (e != hipSuccess) fprintf(stderr, "kernel_launch: cooperative launch failed: %s (grid %d)\n", hipGetErrorString(e), grid);
}
```
